# Optimizing an MI355X kernel written in HIP

```python
import jax, jax.numpy as jnp
from jax import lax
import numpy as np

D_MODEL = 4096
BATCH = 4
SEQ = 2048
DEPTH = 1

CONV_DIM = 2048
CONV_WIDTH = 3
N_HEADS = 16
HEAD_DIM = 128
ATTN_DIM = N_HEADS * HEAD_DIM
MOBA_BLOCK = 256
MOBA_TOPK = 3
Q_CHUNK = 16
N_BRANCH = 2
SPLIT_SIZES = [CONV_DIM] * 3 + [ATTN_DIM] * 3 + [D_MODEL] * N_BRANCH
SPLIT_IDX = [int(i) for i in np.cumsum(SPLIT_SIZES)[:-1]]
IN_COLS = int(sum(SPLIT_SIZES))
PEER_HEADS = 8
N_KEYS = 128
N_EXPERTS = N_KEYS * N_KEYS
PEER_KEY_DIM = 256
PEER_HALF = PEER_KEY_DIM // 2
PEER_TOPK = 16
TOKEN_CHUNK = 128
EPS = 1e-6

kernel_name = "hybrid_conv_moba_peer_block"


def rms_norm(x, g):
    xf = x.astype(jnp.float32)
    y = xf * lax.rsqrt(jnp.mean(xf * xf, axis=-1, keepdims=True) + EPS)
    return (y * g.astype(jnp.float32)).astype(x.dtype)


def short_conv_mixer(b_gate, c_gate, u, conv_w, w_out):
    z = c_gate * u
    z = lax.conv_general_dilated(
        z, conv_w[:, None, :].astype(z.dtype), window_strides=(1,),
        padding=[(CONV_WIDTH - 1, 0)], dimension_numbers=("NWC", "WIO", "NWC"),
        feature_group_count=CONV_DIM)
    return (b_gate * z) @ w_out


def moba_attention(q, k, v, w_out):
    b_, s_, h_, hd = q.shape
    f32 = jnp.float32
    n_blk = -(-s_ // MOBA_BLOCK)
    sp = n_blk * MOBA_BLOCK
    pad = [(0, 0), (0, sp - s_), (0, 0), (0, 0)]
    q, k, v = [jnp.pad(t, pad).transpose(0, 2, 1, 3) for t in (q, k, v)]
    k_blk = k.reshape(b_, h_, n_blk, MOBA_BLOCK, hd)
    v_blk = v.reshape(b_, h_, n_blk, MOBA_BLOCK, hd)
    k_mean = jnp.mean(k_blk.astype(f32), axis=3)
    q_blk_id = jnp.arange(sp) // MOBA_BLOCK
    gate = jnp.einsum("bhsd,bhnd->bhsn", q.astype(f32), k_mean)
    past = jnp.arange(n_blk)[None, :] < q_blk_id[:, None]
    gate = jnp.where(past, gate, -jnp.inf)
    n_sel = min(MOBA_TOPK, n_blk)
    _, sel = lax.top_k(gate, n_sel)
    sel_valid = sel < q_blk_id[:, None]
    n_chunk = sp // Q_CHUNK
    scale = HEAD_DIM ** -0.5
    bi = jnp.arange(b_)[:, None, None, None]
    hi = jnp.arange(h_)[None, :, None, None]

    def chunk(args):
        qc, selc, validc, c = args
        start = c * Q_CHUNK
        own = start // MOBA_BLOCK
        k_own = lax.dynamic_index_in_dim(k_blk, own, axis=2, keepdims=False)
        v_own = lax.dynamic_index_in_dim(v_blk, own, axis=2, keepdims=False)
        q_pos = start + jnp.arange(Q_CHUNK)
        k_pos = own * MOBA_BLOCK + jnp.arange(MOBA_BLOCK)
        s_own = jnp.einsum("bhqd,bhkd->bhqk", qc, k_own).astype(f32) * scale
        s_own = jnp.where(k_pos[None, :] <= q_pos[:, None], s_own, -jnp.inf)
        k_sel = k_blk[bi, hi, selc]
        v_sel = v_blk[bi, hi, selc]
        s_sel = jnp.einsum("bhqd,bhqnkd->bhqnk", qc, k_sel).astype(f32) * scale
        s_sel = jnp.where(validc[..., None], s_sel, -jnp.inf)
        logits = jnp.concatenate([s_own, s_sel.reshape(b_, h_, Q_CHUNK, -1)], axis=-1)
        p = jax.nn.softmax(logits, axis=-1).astype(qc.dtype)
        p_own = p[..., :MOBA_BLOCK]
        p_sel = p[..., MOBA_BLOCK:].reshape(b_, h_, Q_CHUNK, n_sel, MOBA_BLOCK)
        return (jnp.einsum("bhqk,bhkd->bhqd", p_own, v_own)
                + jnp.einsum("bhqnk,bhqnkd->bhqd", p_sel, v_sel))

    qs = q.reshape(b_, h_, n_chunk, Q_CHUNK, hd).transpose(2, 0, 1, 3, 4)
    sels = sel.reshape(b_, h_, n_chunk, Q_CHUNK, n_sel).transpose(2, 0, 1, 3, 4)
    vals = sel_valid.reshape(b_, h_, n_chunk, Q_CHUNK, n_sel).transpose(2, 0, 1, 3, 4)
    out = lax.map(chunk, (qs, sels, vals, jnp.arange(n_chunk)))
    out = out.transpose(1, 0, 3, 2, 4).reshape(b_, sp, h_ * hd)[:, :s_]
    return out @ w_out


def peer_ffn(x, w_q, sub_keys, u_emb, v_emb):
    b_, s_, d_ = x.shape
    xt = x.reshape(-1, d_)
    t_ = xt.shape[0]
    q = (xt @ w_q).reshape(t_, PEER_HEADS, 2, PEER_HALF)
    s = jnp.einsum("thcd,hckd->thck", q, sub_keys).astype(jnp.float32)
    top_s, top_i = lax.top_k(s, PEER_TOPK)
    cand_s = top_s[:, :, 0, :, None] + top_s[:, :, 1, None, :]
    cand_i = top_i[:, :, 0, :, None] * N_KEYS + top_i[:, :, 1, None, :]
    best_s, best_j = lax.top_k(cand_s.reshape(t_, PEER_HEADS, -1), PEER_TOPK)
    expert = jnp.take_along_axis(cand_i.reshape(t_, PEER_HEADS, -1), best_j, axis=-1)
    g = jax.nn.softmax(best_s, axis=-1).astype(x.dtype)
    n_chunk = t_ // TOKEN_CHUNK

    def chunk(args):
        xc, ec, gc = args
        hid = jax.nn.gelu(jnp.einsum("td,thkd->thk", xc, u_emb[ec]), approximate=False) * gc
        return jnp.einsum("thk,thkd->td", hid, v_emb[ec])

    out = lax.map(chunk, (xt.reshape(n_chunk, TOKEN_CHUNK, d_),
                          expert.reshape(n_chunk, TOKEN_CHUNK, PEER_HEADS, PEER_TOPK),
                          g.reshape(n_chunk, TOKEN_CHUNK, PEER_HEADS, PEER_TOPK)))
    return out.reshape(b_, s_, d_)


def setup_inputs(seed: int = 0) -> dict:
    key = jax.random.key(seed)
    ks = jax.random.split(key, 16)
    nrm = jax.random.normal
    f32 = jnp.float32
    return {
        "x": nrm(ks[0], (BATCH, SEQ, D_MODEL), f32),
        "norm_mix": 1.0 + 0.02 * nrm(ks[1], (DEPTH, D_MODEL), f32),
        "w_in": nrm(ks[2], (DEPTH, D_MODEL, IN_COLS), f32) * D_MODEL ** -0.5,
        "b_gate": 0.02 * nrm(ks[3], (DEPTH, N_BRANCH * D_MODEL), f32),
        "conv_w": nrm(ks[4], (DEPTH, CONV_WIDTH, CONV_DIM), f32) * CONV_WIDTH ** -0.5,
        "w_conv_out": nrm(ks[5], (DEPTH, CONV_DIM, D_MODEL), f32) * CONV_DIM ** -0.5,
        "w_attn_out": nrm(ks[6], (DEPTH, ATTN_DIM, D_MODEL), f32) * ATTN_DIM ** -0.5,
        "w_o": nrm(ks[7], (DEPTH, D_MODEL, D_MODEL), f32) * D_MODEL ** -0.5,
        "norm_ffn": 1.0 + 0.02 * nrm(ks[8], (DEPTH, D_MODEL), f32),
        "w_peer_q": nrm(ks[9], (DEPTH, D_MODEL, PEER_HEADS * PEER_KEY_DIM), f32) * D_MODEL ** -0.5,
        "sub_keys": nrm(ks[10], (DEPTH, PEER_HEADS, 2, N_KEYS, PEER_HALF), f32) * PEER_HALF ** -0.5,
        "u_emb": nrm(ks[11], (DEPTH, N_EXPERTS, D_MODEL), f32) * D_MODEL ** -0.5,
        "v_emb": nrm(ks[12], (DEPTH, N_EXPERTS, D_MODEL), f32) * PEER_HEADS ** -0.5,
        "norm_final": 1.0 + 0.02 * nrm(ks[13], (D_MODEL,), f32),
    }


def reference(x, norm_mix, w_in, b_gate, conv_w, w_conv_out, w_attn_out, w_o,
              norm_ffn, w_peer_q, sub_keys, u_emb, v_emb, norm_final):
    h = x
    b_, s_, _ = x.shape
    for l in range(DEPTH):
        hn = rms_norm(h, norm_mix[l])
        z = hn @ w_in[l]
        bc, cc, uc, q, k, v, gc, ga = jnp.split(z, SPLIT_IDX, axis=-1)
        bias_c, bias_a = jnp.split(b_gate[l], 2)
        y_conv = short_conv_mixer(bc, cc, uc, conv_w[l], w_conv_out[l])
        y_attn = moba_attention(q.reshape(b_, s_, N_HEADS, HEAD_DIM),
                                k.reshape(b_, s_, N_HEADS, HEAD_DIM),
                                v.reshape(b_, s_, N_HEADS, HEAD_DIM), w_attn_out[l])
        merged = jax.nn.sigmoid(gc + bias_c) * y_conv + jax.nn.sigmoid(ga + bias_a) * y_attn
        h = h + merged @ w_o[l]
        h = h + peer_ffn(rms_norm(h, norm_ffn[l]), w_peer_q[l], sub_keys[l], u_emb[l], v_emb[l])
    return rms_norm(h, norm_final)
```

```cpp
#include <hip/hip_runtime.h>
#include <cstdio>
#include <cstdint>
namespace pg8 {
#define PG8_LAS __attribute__((address_space(3)))
typedef unsigned short bf16_t;
typedef short bf16x8 __attribute__((ext_vector_type(8)));
typedef float f32x4 __attribute__((ext_vector_type(4)));
typedef unsigned u32x4 __attribute__((ext_vector_type(4)));
constexpr int BM = 256, BK = 64, HALF = 128, HTB = HALF * BK * 2  , STAGE_BYTES = 8 * HTB, NXCD = 8, WGM = 8;

__host__ __device__ __forceinline__ int lds_byte(int r, int c) { const int st = (r >> 4) * 2 + (c >> 5), rr = r & 15, cc = c & 31, ob = rr * 64 + cc * 2; return st * 1024 + (ob ^ (((ob >> 9) & 1) << 5)); }
__host__ __device__ __forceinline__ void stage_rc(int b, int& R, int& C) { const int st = b / 1024, sb = b % 1024, swz = sb ^ (((sb >> 9) & 1) << 5); R = (st >> 1) * 16 + swz / 64; C = (st & 1) * 32 + (swz % 64) / 2; }
__host__ __device__ __forceinline__ int perm32(int rho) { const int n = rho >> 4, i = rho & 15; return 8 * (i >> 2) + 4 * n + (i & 3); }

struct Unit { int pm, pn; };
struct Gemm { const bf16_t* A; const bf16_t* Bt; int M, N, K; };

struct StaticOrder {
    int nM, nN, nwg, G, c;
    __host__ __device__ void init(int M, int N, int G_, int c_) { nM = M / BM; nN = N / BM; nwg = nM * nN; G = G_; c = c_; }
    __host__ __device__ bool next(int i, Unit& u) const {
        const long L = (long)i * G + c; if (L >= nwg) return false;
        int wgid = (int)L; { const int q = nwg / NXCD, r = nwg % NXCD, xcd = wgid % NXCD, off = wgid / NXCD; wgid = (xcd < r ? xcd * (q + 1) : r * (q + 1) + (xcd - r) * q) + off; }
        const int nig = WGM * nN, gid = wgid / nig, fm = gid * WGM, gsz = (nM - fm) < WGM ? (nM - fm) : WGM;
        u.pm = fm + ((wgid % nig) % gsz); u.pn = (wgid % nig) / gsz; return true;
    }
    __device__ __forceinline__ void a_ready(const Unit&) const {}
    __device__ __forceinline__ void done(const Unit&) const {}
};
__device__ __forceinline__ unsigned cvt_pk_bf16(float lo, float hi) { unsigned r; asm volatile("v_cvt_pk_bf16_f32 %0, %1, %2" : "=v"(r) : "v"(lo), "v"(hi)); return r; }
typedef float f32x2 __attribute__((ext_vector_type(2)));
__device__ __forceinline__ float bf_lo(unsigned w) { return __uint_as_float(w << 16); }
__device__ __forceinline__ float bf_hi(unsigned w) { return __uint_as_float(w & 0xffff0000u); }
__device__ __forceinline__ float sigm(float x) { return __builtin_amdgcn_rcpf(1.0f + __builtin_amdgcn_exp2f(-1.4426950408889634f * x)); }
constexpr int ZLD = 20480;
constexpr int ZGATE0 = 12288;
struct EpiZ {
    static constexpr bool PERM = true, AFTER_DRAIN = false;
    bf16_t* Z; const float* bgate;
    __device__ __forceinline__ void operator()(const f32x4 (&acc)[2][2][4][2], const Unit& u, int wr, int wc, int fr, int fq) const {
        const int row0 = u.pm * BM + wr * 64 + fr, col0 = u.pn * BM + wc * 32 + 8 * fq;
        const bool gate = u.pn >= (ZGATE0 / BM);
        f32x4 bv[2][2];
#pragma unroll
        for (int bj = 0; bj < 2; ++bj)
#pragma unroll
            for (int n = 0; n < 2; ++n) bv[bj][n] = gate ? *(const f32x4*)(bgate + (col0 - ZGATE0) + bj * HALF + 4 * n) : (f32x4){0.f, 0.f, 0.f, 0.f};
#pragma unroll
        for (int ai = 0; ai < 2; ++ai)
#pragma unroll
            for (int m = 0; m < 4; ++m) { bf16_t* rowp = Z + (size_t)(row0 + ai * HALF + m * 16) * ZLD + col0;
#pragma unroll
                for (int bj = 0; bj < 2; ++bj) { f32x4 v0 = acc[ai][bj][m][0] + bv[bj][0], v1 = acc[ai][bj][m][1] + bv[bj][1];
                    if (gate) {
#pragma unroll
                        for (int j = 0; j < 4; ++j) { v0[j] = sigm(v0[j]); v1[j] = sigm(v1[j]); } }
                    u32x4 w; w.x = cvt_pk_bf16(v0[0], v0[1]); w.y = cvt_pk_bf16(v0[2], v0[3]); w.z = cvt_pk_bf16(v1[0], v1[1]); w.w = cvt_pk_bf16(v1[2], v1[3]);
                    *(u32x4*)(rowp + bj * HALF) = w; } }
    }
};
template <int MODE> struct EpiGate {
    static constexpr bool PERM = true, AFTER_DRAIN = false;
    bf16_t* O; const bf16_t* Zg;
    __device__ __forceinline__ void operator()(const f32x4 (&acc)[2][2][4][2], const Unit& u, int wr, int wc, int fr, int fq) const {
        const int row0 = u.pm * BM + wr * 64 + fr, col0 = u.pn * BM + wc * 32 + 8 * fq;
#pragma unroll
        for (int ai = 0; ai < 2; ++ai)
#pragma unroll
            for (int m = 0; m < 4; ++m) { const size_t r = (size_t)(row0 + ai * HALF + m * 16); bf16_t* rowp = O + r * 4096 + col0; const bf16_t* gp = Zg + r * ZLD + col0;
#pragma unroll
                for (int bj = 0; bj < 2; ++bj) { const u32x4 g = *(const u32x4*)(gp + bj * HALF); const f32x4 v0 = acc[ai][bj][m][0], v1 = acc[ai][bj][m][1];
                    float o0 = v0[0] * bf_lo(g.x), o1 = v0[1] * bf_hi(g.x), o2 = v0[2] * bf_lo(g.y), o3 = v0[3] * bf_hi(g.y);
                    float o4 = v1[0] * bf_lo(g.z), o5 = v1[1] * bf_hi(g.z), o6 = v1[2] * bf_lo(g.w), o7 = v1[3] * bf_hi(g.w);
                    if (MODE == 1) { const u32x4 p = *(const u32x4*)(rowp + bj * HALF);
                        o0 += bf_lo(p.x); o1 += bf_hi(p.x); o2 += bf_lo(p.y); o3 += bf_hi(p.y); o4 += bf_lo(p.z); o5 += bf_hi(p.z); o6 += bf_lo(p.w); o7 += bf_hi(p.w); }
                    u32x4 w; w.x = cvt_pk_bf16(o0, o1); w.y = cvt_pk_bf16(o2, o3); w.z = cvt_pk_bf16(o4, o5); w.w = cvt_pk_bf16(o6, o7);
                    *(u32x4*)(rowp + bj * HALF) = w; } }
    }
};
struct EpiF32R {
    static constexpr bool PERM = false, AFTER_DRAIN = false;
    float* C; int ldc; const float* R;
    __device__ __forceinline__ void operator()(const f32x4 (&acc)[2][2][4][2], const Unit& u, int wr, int wc, int fr, int fq) const {
        const int row0 = u.pm * BM + wr * 64 + fr, col0 = u.pn * BM + wc * 32 + 4 * fq;
#pragma unroll
        for (int ai = 0; ai < 2; ++ai)
#pragma unroll
            for (int m = 0; m < 4; ++m) { const size_t off = (size_t)(row0 + ai * HALF + m * 16) * ldc + col0;
#pragma unroll
                for (int bj = 0; bj < 2; ++bj)
#pragma unroll
                    for (int n = 0; n < 2; ++n) { f32x4 v = acc[ai][bj][m][n]; if (R) v += *(const f32x4*)(R + off + bj * HALF + n * 16); *(f32x4*)(C + off + bj * HALF + n * 16) = v; } }
    }
};

template <class Epi, class Sched, bool ALIGN_EPI = false, bool SP2 = false>
__device__ __forceinline__ void gemm_phase(PG8_LAS unsigned char* lds, const Gemm g, const Sched& S, const Epi& E) {
    const int tid = threadIdx.x, wid = __builtin_amdgcn_readfirstlane(tid >> 6), lane = tid & 63, wr = wid >> 2, wc = wid & 3, fr = lane & 15, fq = lane >> 4;
    const int K = g.K, nt = K / BK;
    unsigned voffA[2], voffB[2];
#pragma unroll
    for (int i = 0; i < 2; ++i) { int R, C; stage_rc(tid * 16 + i * 8192, R, C); const int Rb = Epi::PERM ? ((R & ~31) + perm32(R & 31)) : R;
        voffA[i] = (unsigned)(R * K + C) * 2u; voffB[i] = (unsigned)(Rb * K + C) * 2u; }
    const size_t kstep = (size_t)(BK * 2);
    const size_t hstep = (size_t)HALF * K * 2;
    const size_t tstep = 2 * hstep;
    const unsigned ldsw = (unsigned)wid * 1024u;
    const int aoff = lds_byte(wr * 64 + fr, fq * 8), boff = lds_byte(wc * 32 + fr, fq * 8);
#define PG8_SA(b, h) (((b) * 2 + (h)) * HTB)
#define PG8_SB(b, h) ((4 + (b) * 2 + (h)) * HTB)
#define PG8_STAGE(bufoff, gbase, voff) do { _Pragma("unroll") for (int _i = 0; _i < 2; ++_i) \
        __builtin_amdgcn_global_load_lds((const unsigned*)((const char*)(gbase) + (voff)[_i]), (PG8_LAS unsigned*)(lds + (bufoff) + ldsw + _i * 8192), 16, 0, 0); } while (0)
#define PG8_LDA(dst, b, h) do { _Pragma("unroll") for (int m = 0; m < 4; ++m) _Pragma("unroll") for (int k = 0; k < 2; ++k) dst[m][k] = *(const PG8_LAS bf16x8*)(lds + PG8_SA(b, h) + aoff + m * 2048 + k * 1024); } while (0)
#define PG8_LDB(dst, b, h) do { _Pragma("unroll") for (int n = 0; n < 2; ++n) _Pragma("unroll") for (int k = 0; k < 2; ++k) dst[n][k] = *(const PG8_LAS bf16x8*)(lds + PG8_SB(b, h) + boff + n * 2048 + k * 1024); } while (0)
#define PG8_MMA(ai, bj, At, Bt) do { __builtin_amdgcn_s_setprio(1); _Pragma("unroll") for (int m = 0; m < 4; ++m) _Pragma("unroll") for (int n = 0; n < 2; ++n) _Pragma("unroll") for (int k = 0; k < 2; ++k) \
        acc[ai][bj][m][n] = __builtin_amdgcn_mfma_f32_16x16x32_bf16(Bt[n][k], At[m][k], acc[ai][bj][m][n], 0, 0, 0); __builtin_amdgcn_s_setprio(0); } while (0)
#define PG8_WAIT_V(n) asm volatile("s_waitcnt vmcnt(" #n ")" ::: "memory")
#define PG8_WAIT_L(n) asm volatile("s_waitcnt lgkmcnt(" #n ")" ::: "memory")
#define PG8_BAR __builtin_amdgcn_s_barrier()
#define PG8_SCHED __builtin_amdgcn_sched_barrier(0)
    Unit cur, nxt; int ui = 0;
    if (!S.next(0, cur)) return;
    f32x4 acc[2][2][4][2];
#pragma unroll
    for (int a = 0; a < 2; ++a)
#pragma unroll
        for (int b = 0; b < 2; ++b)
#pragma unroll
            for (int m = 0; m < 4; ++m)
#pragma unroll
                for (int n = 0; n < 2; ++n) acc[a][b][m][n] = (f32x4){0.f, 0.f, 0.f, 0.f};
    bf16x8 At[4][2], B0[2][2], B1[2][2];
    const char* cA = (const char*)g.A + (size_t)cur.pm * tstep; const char* cB = (const char*)g.Bt + (size_t)cur.pn * tstep;
    S.a_ready(cur);
    if constexpr (SP2) {
        PG8_STAGE(PG8_SB(0, 0), cB, voffB); PG8_STAGE(PG8_SB(0, 1), cB + hstep, voffB); PG8_STAGE(PG8_SA(0, 0), cA, voffA); PG8_STAGE(PG8_SA(0, 1), cA + hstep, voffA);
        if (wr == 1) PG8_BAR;
        PG8_WAIT_V(2); PG8_BAR;
        PG8_STAGE(PG8_SB(1, 0), cB + kstep, voffB); PG8_STAGE(PG8_SA(1, 0), cA + kstep, voffA); PG8_STAGE(PG8_SB(1, 1), cB + hstep + kstep, voffB);
        PG8_WAIT_V(6); PG8_BAR;
    } else {
        PG8_STAGE(PG8_SB(0, 0), cB, voffB); PG8_STAGE(PG8_SA(0, 0), cA, voffA); PG8_STAGE(PG8_SB(0, 1), cB + hstep, voffB); PG8_STAGE(PG8_SA(0, 1), cA + hstep, voffA);
        if (wr == 1) PG8_BAR;
        PG8_WAIT_V(4); PG8_BAR;
        PG8_STAGE(PG8_SB(1, 0), cB + kstep, voffB); PG8_STAGE(PG8_SA(1, 0), cA + kstep, voffA); PG8_STAGE(PG8_SB(1, 1), cB + hstep + kstep, voffB);
        PG8_WAIT_V(6); PG8_BAR;
    }
    for (;;) {
        const bool has_next = S.next(ui + 1, nxt);
        const char* nA = has_next ? (const char*)g.A + (size_t)nxt.pm * tstep : cA; const char* nB = has_next ? (const char*)g.Bt + (size_t)nxt.pn * tstep : cB;
        for (int t = 0; t < nt; t += 2) {
            const bool last = (t == nt - 2);
            const char* a1 = cA + (size_t)(t + 1) * kstep;
            const char* a2 = last ? nA : cA + (size_t)(t + 2) * kstep; const char* b2 = last ? nB : cB + (size_t)(t + 2) * kstep;
            const char* a3 = a2 + kstep; const char* b3 = b2 + kstep;
            if (last && has_next) S.a_ready(nxt);
            if constexpr (SP2) {
            PG8_LDB(B0, 0, 0); PG8_LDB(B1, 0, 1); PG8_SCHED; PG8_LDA(At, 0, 0); PG8_STAGE(PG8_SA(1, 1), a1 + hstep, voffA);
            PG8_WAIT_V(8); PG8_WAIT_L(0); PG8_BAR; PG8_MMA(0, 0, At, B0); PG8_MMA(0, 1, At, B1); PG8_BAR; PG8_SCHED;
            PG8_LDA(At, 0, 1); PG8_STAGE(PG8_SB(0, 0), b2, voffB); PG8_STAGE(PG8_SB(0, 1), b2 + hstep, voffB); PG8_STAGE(PG8_SA(0, 0), a2, voffA);
            PG8_WAIT_V(8); PG8_WAIT_L(0); PG8_BAR; PG8_MMA(1, 0, At, B0); PG8_MMA(1, 1, At, B1); PG8_BAR; PG8_SCHED;
            PG8_LDB(B0, 1, 0); PG8_LDB(B1, 1, 1); PG8_SCHED; PG8_LDA(At, 1, 0); PG8_STAGE(PG8_SA(0, 1), a2 + hstep, voffA);
            PG8_WAIT_V(8); PG8_WAIT_L(0); PG8_BAR; PG8_MMA(0, 0, At, B0); PG8_MMA(0, 1, At, B1); PG8_BAR; PG8_SCHED;
            PG8_LDA(At, 1, 1); PG8_STAGE(PG8_SB(1, 0), b3, voffB); PG8_STAGE(PG8_SB(1, 1), b3 + hstep, voffB); PG8_STAGE(PG8_SA(1, 0), a3, voffA);
            PG8_WAIT_V(8); PG8_WAIT_L(0); PG8_BAR; PG8_MMA(1, 0, At, B0); PG8_MMA(1, 1, At, B1); PG8_BAR; PG8_SCHED;
            } else {
            PG8_LDB(B0, 0, 0); PG8_SCHED; PG8_LDA(At, 0, 0); PG8_STAGE(PG8_SA(1, 1), a1 + hstep, voffA);
            PG8_WAIT_L(8); PG8_BAR; PG8_WAIT_L(0); PG8_MMA(0, 0, At, B0); PG8_BAR; PG8_SCHED;
            PG8_LDB(B1, 0, 1); PG8_STAGE(PG8_SB(0, 0), b2, voffB);
            PG8_BAR; PG8_WAIT_L(0); PG8_MMA(0, 1, At, B1); PG8_BAR;
            PG8_LDA(At, 0, 1); PG8_STAGE(PG8_SA(0, 0), a2, voffA);
            PG8_BAR; PG8_WAIT_L(0); PG8_MMA(1, 0, At, B0); PG8_BAR; PG8_SCHED;
            PG8_STAGE(PG8_SB(0, 1), b2 + hstep, voffB);
            PG8_WAIT_V(6); PG8_BAR; PG8_MMA(1, 1, At, B1); PG8_BAR;
            PG8_LDB(B0, 1, 0); PG8_SCHED; PG8_LDA(At, 1, 0); PG8_STAGE(PG8_SA(0, 1), a2 + hstep, voffA);
            PG8_WAIT_L(8); PG8_BAR; PG8_WAIT_L(0); PG8_MMA(0, 0, At, B0); PG8_BAR; PG8_SCHED;
            PG8_LDB(B1, 1, 1); PG8_STAGE(PG8_SB(1, 0), b3, voffB);
            PG8_BAR; PG8_WAIT_L(0); PG8_MMA(0, 1, At, B1); PG8_BAR;
            PG8_LDA(At, 1, 1); PG8_STAGE(PG8_SA(1, 0), a3, voffA);
            PG8_BAR; PG8_WAIT_L(0); PG8_MMA(1, 0, At, B0); PG8_BAR; PG8_SCHED;
            PG8_STAGE(PG8_SB(1, 1), b3 + hstep, voffB);
            PG8_WAIT_V(6); PG8_BAR; PG8_MMA(1, 1, At, B1); PG8_BAR;
            }
        }
        if constexpr (ALIGN_EPI) { if (wr == 0) PG8_BAR; }
        if constexpr (!Epi::AFTER_DRAIN) { E(acc, cur, wr, wc, fr, fq); S.done(cur); }
        if (!has_next) break;
#pragma unroll
        for (int a = 0; a < 2; ++a)
#pragma unroll
            for (int b = 0; b < 2; ++b)
#pragma unroll
                for (int m = 0; m < 4; ++m)
#pragma unroll
                    for (int n = 0; n < 2; ++n) acc[a][b][m][n] = (f32x4){0.f, 0.f, 0.f, 0.f};
        cur = nxt; cA = nA; cB = nB; ++ui;
        if constexpr (ALIGN_EPI) { if (wr == 1) PG8_BAR; }
    }
    PG8_WAIT_V(0);
    if constexpr (!ALIGN_EPI) { if (wr == 0) PG8_BAR; }
    PG8_BAR;
    if constexpr (Epi::AFTER_DRAIN) { E.fused(acc, cur, wr, wc, fr, fq, lds, wid, lane); S.done(cur); }
#undef PG8_SA
#undef PG8_SB
#undef PG8_STAGE
#undef PG8_LDA
#undef PG8_LDB
#undef PG8_MMA
#undef PG8_WAIT_V
#undef PG8_WAIT_L
#undef PG8_BAR
#undef PG8_SCHED
}
}
namespace moba {
typedef unsigned short bf16;
constexpr int   D = 128, NW = 8, QBLK = 32, KVBLK = 64;
constexpr float SCALE = 0.088388347648318440f;
constexpr float THR = 8.f;
constexpr int SDEPTH = 1;
constexpr int LDQ = 20480, LDK = 20480, LDO = 2048;
constexpr size_t SHM_V = KVBLK * D * 2, SHM_K = KVBLK * D * 2, SHM_ATTN = 2 * SHM_V + 2 * SHM_K + NW * 64 * 4;
constexpr float NEG = -1e30f;
using bf16x8 = __attribute__((ext_vector_type(8))) short;
using s16x4  = __attribute__((ext_vector_type(4))) short;
using f32x16 = __attribute__((ext_vector_type(16))) float;
using f32x8  = __attribute__((ext_vector_type(8))) float;
using u32x4  = __attribute__((ext_vector_type(4))) unsigned;
#define KSWZ(row, colB) ((row) * 256 + ((colB) ^ (((row) & 7) << 4)))
#define SBAR() __builtin_amdgcn_sched_barrier(0)
__device__ __forceinline__ int crow(int r, int hi) { return (r & 3) + 8 * (r >> 2) + 4 * hi; }
__device__ __forceinline__ unsigned cvtpk(float lo, float hi) {
  unsigned r; asm volatile("v_cvt_pk_bf16_f32 %0, %1, %2" : "=v"(r) : "v"(lo), "v"(hi)); return r;
}
template <typename TIn> struct Stage;
template <> struct Stage<bf16>  { using T = bf16x8;
  __device__ static __forceinline__ T ld8(const bf16* p) { return *reinterpret_cast<const bf16x8*>(p); }
  __device__ static __forceinline__ bf16x8 tobf(T x) { return x; } };

__device__ __forceinline__ void partialSM(f32x16& p0, f32x16& p1, float& m_reg, float& mn, float& alpha) {
  constexpr float C = SCALE * 1.4426950408889634f;
  float pmax = p0[0]; for (int r = 1; r < 16; ++r) pmax = fmaxf(pmax, p0[r]); for (int r = 0; r < 16; ++r) pmax = fmaxf(pmax, p1[r]);
  { auto rr = __builtin_amdgcn_permlane32_swap(__float_as_uint(pmax), __float_as_uint(pmax), false, false);
    pmax = fmaxf(__uint_as_float(rr[0]), __uint_as_float(rr[1])); }
  if (__builtin_expect(__all(pmax - m_reg <= THR / SCALE), 1)) { mn = m_reg; alpha = 1.f; }
  else { mn = fmaxf(m_reg, pmax); alpha = __builtin_amdgcn_exp2f((m_reg - mn) * C); m_reg = mn; }
  float mnC = -mn * C;
  for (int r = 0; r < 16; ++r) p0[r] = fmaf(p0[r], C, mnC); for (int r = 0; r < 16; ++r) p1[r] = fmaf(p1[r], C, mnC);
  for (int r = 0; r < 16; ++r) p0[r] = __builtin_amdgcn_exp2f(p0[r]);
}
__device__ __forceinline__ void finishSM(f32x16& p0, f32x16& p1, float alpha, float& l_reg, bf16x8& pa0, bf16x8& pa1, bf16x8& pa2, bf16x8& pa3) {
  for (int r = 0; r < 16; ++r) p1[r] = __builtin_amdgcn_exp2f(p1[r]);
  float ps = 0; for (int r = 0; r < 16; ++r) ps += p0[r]; for (int r = 0; r < 16; ++r) ps += p1[r];
  { auto rr = __builtin_amdgcn_permlane32_swap(__float_as_uint(ps), __float_as_uint(ps), false, false);
    ps = __uint_as_float(rr[0]) + __uint_as_float(rr[1]); }
  l_reg = l_reg * alpha + ps;
#define PK4(P, BASE, OUT) do { unsigned a0 = cvtpk(P[BASE + 0], P[BASE + 1]), a1 = cvtpk(P[BASE + 2], P[BASE + 3]);   \
    unsigned b0 = cvtpk(P[BASE + 4], P[BASE + 5]), b1 = cvtpk(P[BASE + 6], P[BASE + 7]);                              \
    auto r0 = __builtin_amdgcn_permlane32_swap(a0, b0, false, false); auto r1 = __builtin_amdgcn_permlane32_swap(a1, b1, false, false); \
    u32x4 w = {r0[0], r1[0], r0[1], r1[1]}; OUT = *reinterpret_cast<bf16x8*>(&w); } while (0)
  PK4(p0, 0, pa0); PK4(p0, 8, pa1); PK4(p1, 0, pa2); PK4(p1, 8, pa3);
#undef PK4
}
__device__ __forceinline__ void qkt(f32x16& p0, f32x16& p1, const bf16* Ks, const bf16x8* qr, int r32, int hi) {
  p0 = f32x16{}; p1 = f32x16{};
  for (int d0 = 0; d0 < 8; ++d0) { int cb = (d0 * 16 + hi * 8) * 2;
    bf16x8 b0 = *reinterpret_cast<const bf16x8*>((const char*)Ks + KSWZ(r32, cb));
    bf16x8 b1 = *reinterpret_cast<const bf16x8*>((const char*)Ks + KSWZ(32 + r32, cb));
    p0 = __builtin_amdgcn_mfma_f32_32x32x16_bf16(b0, qr[d0], p0, 0, 0, 0);
    p1 = __builtin_amdgcn_mfma_f32_32x32x16_bf16(b1, qr[d0], p1, 0, 0, 0); }
}
__device__ __forceinline__ int v_st(int k, int c) { const int kk = (k & ~0xC) | ((k & 4) << 1) | ((k & 8) >> 1); return ((kk >> 3) * 4 + (c >> 5)) * 512 + ((kk & 7) * 32 + (c & 31)) * 2; }
__device__ __forceinline__ int v_rd_base(int lane) { return ((lane & 3) << 3) | (((lane >> 2) & 3) << 6) | (((lane >> 4) & 1) << 5) | (((lane >> 5) & 1) << 8); }
constexpr int v_rd_off(int d0, int ks, int half) { return d0 * 512 + ks * 4096 + half * 2048; }
template <int OFF> __device__ __forceinline__ s16x4 tr_read(int vb) {
  s16x4 r; asm volatile("ds_read_b64_tr_b16 %0, %1 offset:%2" : "=&v"(r) : "v"(vb), "i"(OFF) : "memory"); return r;
}
template <int D0> __device__ __forceinline__ void pv_one(f32x16& od, int vb, bf16x8 pa0, bf16x8 pa1, bf16x8 pa2, bf16x8 pa3) {
  const s16x4 l0 = tr_read<v_rd_off(D0, 0, 0)>(vb), h0 = tr_read<v_rd_off(D0, 0, 1)>(vb), l1 = tr_read<v_rd_off(D0, 1, 0)>(vb), h1 = tr_read<v_rd_off(D0, 1, 1)>(vb);
  const s16x4 l2 = tr_read<v_rd_off(D0, 2, 0)>(vb), h2 = tr_read<v_rd_off(D0, 2, 1)>(vb), l3 = tr_read<v_rd_off(D0, 3, 0)>(vb), h3 = tr_read<v_rd_off(D0, 3, 1)>(vb);
  asm volatile("s_waitcnt lgkmcnt(0)" ::: "memory"); SBAR();
#define PK(L, H) (bf16x8){L[0], L[1], L[2], L[3], H[0], H[1], H[2], H[3]}
  od = __builtin_amdgcn_mfma_f32_32x32x16_bf16(pa0, PK(l0, h0), od, 0, 0, 0);
  od = __builtin_amdgcn_mfma_f32_32x32x16_bf16(pa1, PK(l1, h1), od, 0, 0, 0);
  od = __builtin_amdgcn_mfma_f32_32x32x16_bf16(pa2, PK(l2, h2), od, 0, 0, 0);
  od = __builtin_amdgcn_mfma_f32_32x32x16_bf16(pa3, PK(l3, h3), od, 0, 0, 0);
#undef PK
}
__device__ __forceinline__ void pv_d0(f32x16* o, int vb, bf16x8 pa0, bf16x8 pa1, bf16x8 pa2, bf16x8 pa3) {
  pv_one<0>(o[0], vb, pa0, pa1, pa2, pa3); pv_one<1>(o[1], vb, pa0, pa1, pa2, pa3); pv_one<2>(o[2], vb, pa0, pa1, pa2, pa3); pv_one<3>(o[3], vb, pa0, pa1, pa2, pa3);
}


__device__ __forceinline__ float bf2f(short s) { return __uint_as_float(((unsigned)(unsigned short)s) << 16); }
__device__ __forceinline__ int koff(int j, int qb) { return (j < 4) ? qb * 256 + j * 64 : (j - 4) * 64; }
__device__ __forceinline__ void init_tile(f32x16& p0, f32x16& p1, int j, unsigned selmask, int rowi, int wid, int hi) {
  if (j < 4) {
    if (64 * j + 63 <= wid * 32) {
#pragma unroll
      for (int r = 0; r < 16; ++r) { p0[r] = 0.f; p1[r] = 0.f; }
    } else if (64 * j > wid * 32 + 31) {
#pragma unroll
      for (int r = 0; r < 16; ++r) { p0[r] = NEG; p1[r] = NEG; }
    } else {
      int tz = threadIdx.x; asm volatile("" : "+v"(tz));
      const int limh = (tz >> 6) * 32 + (tz & 31) - 4 * ((tz >> 5) & 1) - 64 * j; const float neg = NEG;
#define MOBA_MSK(P, R, CONST) asm volatile("v_cmp_gt_i32 vcc, %2, %1\n\tv_cndmask_b32 %0, 0, %3, vcc" : "=v"(P[R]) : "v"(limh), "n"(CONST), "v"(neg) : "vcc")
#define MOBA_MSK2(R) MOBA_MSK(p0, R, ((R) & 3) + 8 * ((R) >> 2)); MOBA_MSK(p1, R, 32 + ((R) & 3) + 8 * ((R) >> 2))
      MOBA_MSK2(0); MOBA_MSK2(1); MOBA_MSK2(2); MOBA_MSK2(3); MOBA_MSK2(4); MOBA_MSK2(5); MOBA_MSK2(6); MOBA_MSK2(7);
      MOBA_MSK2(8); MOBA_MSK2(9); MOBA_MSK2(10); MOBA_MSK2(11); MOBA_MSK2(12); MOBA_MSK2(13); MOBA_MSK2(14); MOBA_MSK2(15);
#undef MOBA_MSK2
#undef MOBA_MSK
    }
  } else {
    const float iv = ((selmask >> ((j - 4) >> 2)) & 1u) ? 0.f : NEG;
#pragma unroll
    for (int r = 0; r < 16; ++r) { p0[r] = iv; p1[r] = iv; }
  }
}
__device__ __forceinline__ void qktm(f32x16& p0, f32x16& p1, const bf16* Ks, const bf16x8* qr, int r32, int hi, int j, unsigned selmask, int rowi, int wid) {
  init_tile(p0, p1, j, selmask, rowi, wid, hi);
  for (int d0 = 0; d0 < 8; ++d0) { int cb = (d0 * 16 + hi * 8) * 2;
    bf16x8 b0 = *reinterpret_cast<const bf16x8*>((const char*)Ks + KSWZ(r32, cb));
    bf16x8 b1 = *reinterpret_cast<const bf16x8*>((const char*)Ks + KSWZ(32 + r32, cb));
    p0 = __builtin_amdgcn_mfma_f32_32x32x16_bf16(b0, qr[d0], p0, 0, 0, 0);
    p1 = __builtin_amdgcn_mfma_f32_32x32x16_bf16(b1, qr[d0], p1, 0, 0, 0); }
}

__device__ __forceinline__ void moba_body(const bf16* __restrict__ Qb, const bf16* __restrict__ Kh, const bf16* __restrict__ Vh, const float* __restrict__ km,
                                          bf16* __restrict__ Ob, int qb, char* lds) {
  using St = Stage<bf16>;
  int tid = threadIdx.x; asm volatile("" : "+v"(tid));
  const int wid = tid >> 6, lane = tid & 63, r32 = lane & 31, hi = lane >> 5;
  bf16* V_lds = (bf16*)lds; bf16* K_lds = (bf16*)(lds + 2 * SHM_V);
  float* ws = (float*)(lds + 2 * SHM_V + 2 * SHM_K) + wid * 64; float* li_l = ws; float* al_l = ws + 32;
  float m_reg = -1e30f, l_reg = 0; f32x16 o[4] = {}; bf16x8 qr[8];
  __syncthreads();
  const bf16* Qw = Qb + (long)(wid * QBLK + r32) * LDQ + hi * 8;
#pragma unroll
  for (int d0 = 0; d0 < 8; ++d0) qr[d0] = St::ld8(Qw + d0 * 16);
  unsigned selmask = 0u;
  {
    float g[7];
#pragma unroll
    for (int n = 0; n < 7; ++n) {
      float s = 0.f;
      if (n < qb) {
        const float* kp = km + n * 128 + hi * 8;
#pragma unroll
        for (int d0 = 0; d0 < 8; ++d0) {
          const float4 k0 = *reinterpret_cast<const float4*>(kp + d0 * 16), k1 = *reinterpret_cast<const float4*>(kp + d0 * 16 + 4);
          s += bf2f(qr[d0][0]) * k0.x + bf2f(qr[d0][1]) * k0.y + bf2f(qr[d0][2]) * k0.z + bf2f(qr[d0][3]) * k0.w
             + bf2f(qr[d0][4]) * k1.x + bf2f(qr[d0][5]) * k1.y + bf2f(qr[d0][6]) * k1.z + bf2f(qr[d0][7]) * k1.w;
        }
        s += __shfl_xor(s, 32);
      }
      g[n] = (n < qb) ? s : -INFINITY;
    }
#pragma unroll
    for (int n = 0; n < 7; ++n) {
      int rank = 0;
#pragma unroll
      for (int m = 0; m < 7; ++m) if (m != n) rank += (g[m] > g[n] || (g[m] == g[n] && m < n)) ? 1 : 0;
      if (n < qb && rank < 3) selmask |= (1u << n);
    }
  }
  const int rowi = wid * QBLK + r32;
  const int sr = tid >> 4, sc = (tid & 15) * 8, vst0 = v_st(sr, sc), vst1 = v_st(32 + sr, sc);
  const int vb0 = (int)(uintptr_t)V_lds + v_rd_base(lane);
  struct { typename St::T vs0, vs1, ks0, ks1; } sr_[SDEPTH];
#define SLOAD(i, k0) do { sr_[i].vs0 = St::ld8(&Vh[(long)((k0) + sr) * LDK + sc]); sr_[i].vs1 = St::ld8(&Vh[(long)((k0) + 32 + sr) * LDK + sc]); \
    sr_[i].ks0 = St::ld8(&Kh[(long)((k0) + sr) * LDK + sc]); sr_[i].ks1 = St::ld8(&Kh[(long)((k0) + 32 + sr) * LDK + sc]); } while (0)
#define SWRITE(b, i) do { *(bf16x8*)((char*)V_lds + (b) * SHM_V + vst0) = St::tobf(sr_[i].vs0);          \
    *(bf16x8*)((char*)V_lds + (b) * SHM_V + vst1) = St::tobf(sr_[i].vs1); int kc = sc * 2;               \
    *(bf16x8*)((char*)K_lds + (b) * SHM_K + KSWZ(sr, kc)) = St::tobf(sr_[i].ks0);                       \
    *(bf16x8*)((char*)K_lds + (b) * SHM_K + KSWZ(32 + sr, kc)) = St::tobf(sr_[i].ks1); } while (0)
#define SWAIT() do { if constexpr (SDEPTH == 2) asm volatile("s_waitcnt vmcnt(4)" ::: "memory"); else asm volatile("s_waitcnt vmcnt(0)" ::: "memory"); } while (0)
#define RESC(a) do { if (__any((a) < 1.f)) { if (hi == 0) al_l[r32] = (a); asm volatile("s_waitcnt lgkmcnt(0)" ::: "memory"); \
    for (int d = 0; d < 4; ++d) for (int r = 0; r < 16; ++r) o[d][r] *= al_l[crow(r, hi)]; } } while (0)
  f32x16 pA0, pA1, pB0, pB1; float mnA, mnB, alA, alB; bf16x8 pa0, pa1, pa2, pa3; const int NT = 4 * (qb + 1);
  constexpr int SE = 0, SO = SDEPTH - 1;
  SLOAD(SE, koff(0, qb)); asm volatile("s_waitcnt vmcnt(0)" ::: "memory"); SWRITE(0, SE); __syncthreads();
  qktm(pA0, pA1, K_lds, qr, r32, hi, 0, selmask, rowi, wid); partialSM(pA0, pA1, m_reg, mnA, alA);
  SLOAD(SO, koff(1, qb)); if constexpr (SDEPTH == 2) { SLOAD(SE, koff(2, qb)); }
  SWAIT(); SWRITE(1, SO); __syncthreads();
  for (int j = 1; j + 1 < NT; j += 2) {
    SBAR(); qktm(pB0, pB1, (bf16*)((char*)K_lds + SHM_K), qr, r32, hi, j, selmask, rowi, wid);
    finishSM(pA0, pA1, alA, l_reg, pa0, pa1, pa2, pa3); SBAR();
    SLOAD(SO, koff(j + SDEPTH, qb)); SBAR();
    pv_d0(o, vb0, pa0, pa1, pa2, pa3); partialSM(pB0, pB1, m_reg, mnB, alB);
    __syncthreads(); SWAIT(); SWRITE(0, SE);
    RESC(alB); __syncthreads();
    SBAR(); qktm(pA0, pA1, K_lds, qr, r32, hi, j + 1, selmask, rowi, wid);
    finishSM(pB0, pB1, alB, l_reg, pa0, pa1, pa2, pa3); SBAR();
    if (SDEPTH == 1 || j + 3 < NT) SLOAD(SE, koff(j + 1 + SDEPTH, qb)); SBAR();
    pv_d0(o, vb0 + (int)SHM_V, pa0, pa1, pa2, pa3); partialSM(pA0, pA1, m_reg, mnA, alA);
    __syncthreads(); SWAIT(); SWRITE(1, SO);
    RESC(alA); __syncthreads();
  }
  SBAR(); qktm(pB0, pB1, (bf16*)((char*)K_lds + SHM_K), qr, r32, hi, NT - 1, selmask, rowi, wid);
  finishSM(pA0, pA1, alA, l_reg, pa0, pa1, pa2, pa3); SBAR();
  pv_d0(o, vb0, pa0, pa1, pa2, pa3); partialSM(pB0, pB1, m_reg, mnB, alB);
  __syncthreads(); RESC(alB);
  finishSM(pB0, pB1, alB, l_reg, pa0, pa1, pa2, pa3); SBAR();
  pv_d0(o, vb0 + (int)SHM_V, pa0, pa1, pa2, pa3);
  if (hi == 0) li_l[r32] = l_reg; asm volatile("s_waitcnt lgkmcnt(0)" ::: "memory");
  float rli[16];
#pragma unroll
  for (int r = 0; r < 16; ++r) rli[r] = __builtin_amdgcn_rcpf(li_l[crow(r, hi)]);
  bf16* Ow = Ob + (long)(wid * QBLK) * LDO;
#pragma unroll
  for (int r = 0; r < 16; ++r) { int orow = crow(r, hi);
    for (int d0 = 0; d0 < 4; ++d0) { const float v = o[d0][r] * rli[r]; unsigned u = __float_as_uint(v); u = (u + 0x7fffu + ((u >> 16) & 1u)) >> 16; Ow[(long)orow * LDO + d0 * 32 + r32] = (bf16)u; } }
#undef SLOAD
#undef SWRITE
#undef SWAIT
#undef RESC
}
#undef KSWZ
#undef SBAR
}
constexpr int NWAVES = 8;
constexpr int T_ = 8192, DM = 4096, INC = 20480, CD = 2048, AD = 2048, NH = 16, HD = 128, SEQ = 2048, NBATCH = 4, NBLK = 8;
constexpr int PH = 8, NKEYS = 128, NEXP = 16384, PTOPK = 16, NSEL = PH * PTOPK;
constexpr float EPS = 1e-6f;
enum { I_X = 0, I_NMIX, I_WIN, I_BGATE, I_CONVW, I_WCO, I_WAO, I_WO, I_NFFN, I_WPQ, I_SUBK, I_UEMB, I_VEMB, I_NFIN, N_IN };
constexpr int ZC_B = 0, ZC_C = 2048, ZC_U = 4096, ZC_Q = 6144, ZC_K = 8192, ZC_V = 10240, ZC_GC = 12288, ZC_GA = 16384;

constexpr size_t MiB = 1u << 20;
constexpr size_t WS_CTL = 0, CTL_ZERO_BYTES = 1 * MiB;
constexpr size_t WS_KMEAN = 1 * MiB;
constexpr size_t WS_WINT = 2 * MiB;
constexpr size_t WS_WCOT = 162 * MiB;
constexpr size_t WS_WAOT = 178 * MiB;
constexpr size_t WS_WOT  = 194 * MiB;
constexpr size_t WS_WPQF = 226 * MiB;
constexpr size_t WS_HN   = 242 * MiB;
constexpr size_t WS_Z    = 306 * MiB;
constexpr size_t WS_BZ   = 626 * MiB;
constexpr size_t WS_ATT  = 658 * MiB;
constexpr size_t WS_MRG  = 690 * MiB;
constexpr size_t WS_XN   = 754 * MiB;
constexpr size_t WS_ST   = 818 * MiB;
constexpr size_t WS_EXP  = 882 * MiB;
constexpr size_t WS_GATE = 886 * MiB;
constexpr size_t WS_UB   = 890 * MiB;
constexpr size_t WS_VB   = 1018 * MiB;
constexpr size_t WS_END  = 1146 * MiB;
constexpr int CW_TMO = 0, CW_CODE = 1, CW_BAR = 4096;

constexpr int RING_OFF = 0, RING_BYTES = 131072;
constexpr int LDSCTL_OFF = RING_BYTES, MISC_OFF = LDSCTL_OFF + 320;
constexpr int LDS_BYTES = 147456;
static_assert(MISC_OFF + 128 <= LDS_BYTES, "LDS map");
#define GAS __attribute__((address_space(1)))
#define LAS __attribute__((address_space(3)))
typedef unsigned short bf16;
typedef unsigned v4u __attribute__((ext_vector_type(4)));
typedef float f32x4 __attribute__((ext_vector_type(4)));
typedef short bf16x8 __attribute__((ext_vector_type(8)));
typedef GAS unsigned gu32;
typedef GAS unsigned long long gu64;
#define RLX_AGENT __ATOMIC_RELAXED, __HIP_MEMORY_SCOPE_AGENT
#define LDS_WAIT() asm volatile("s_waitcnt lgkmcnt(0)" ::: "memory")
#define VM_WAIT() asm volatile("s_waitcnt vmcnt(0)" ::: "memory")
__device__ __forceinline__ unsigned long long rt() { return __builtin_amdgcn_s_memrealtime(); }
__device__ __forceinline__ unsigned f2bf(float f) { unsigned u = __builtin_bit_cast(unsigned, f); return (u + 0x7fffu + ((u >> 16) & 1u)) >> 16; }
__device__ __forceinline__ unsigned pk2(float lo, float hi) { return f2bf(lo) | (f2bf(hi) << 16); }
#define XB_TMO      128
#define XB_XCNT(j)  (256  + 64 * (j))
#define XB_XSUB(j)  (1280 + 64 * (j))
#define XB_XGEN(j)  (2304 + 64 * (j))
#define XB_TOP      3328
#define XB_TOPGEN   3392
#define XCD_BAR_WORDS 3456
#define XB_SPIN_CAP (1u << 18)

__device__ __forceinline__ unsigned xb_ld(unsigned* p)              { return __hip_atomic_load(p, __ATOMIC_RELAXED, __HIP_MEMORY_SCOPE_AGENT); }
__device__ __forceinline__ unsigned xb_add(unsigned* p, unsigned v) { return __hip_atomic_fetch_add(p, v, __ATOMIC_RELAXED, __HIP_MEMORY_SCOPE_AGENT); }
__device__ __forceinline__ unsigned xb_xcc_id() { return (unsigned)__builtin_amdgcn_s_getreg((3 << 11) | 20) & 0xFu; }
#define XB_SPIN(cond, bar) do { unsigned _sp = 0; while (cond) { __builtin_amdgcn_s_sleep(1); \
    if ((++_sp & 255u) == 0u) { if (xb_ld(&(bar)[XB_TMO])) break; if (_sp > XB_SPIN_CAP) { atomicAdd(&(bar)[XB_TMO], 1u); break; } } } } while (0)

struct XcdBarrier {
    unsigned* bar; unsigned x;
    volatile LAS unsigned* st;
};

__device__ __forceinline__ XcdBarrier xcd_barrier_post(unsigned* bar, volatile LAS unsigned* st) {
    XcdBarrier b; b.bar = bar; b.x = xb_xcc_id(); b.st = st;
    if (threadIdx.x == 0) (void)xb_add(&bar[XB_XCNT(b.x)], 1u);
    return b;
}
__device__ __forceinline__ void xcd_barrier_complete(unsigned* bar, unsigned x, unsigned& nloc, unsigned& nx) {
    const unsigned G = gridDim.x * gridDim.y * gridDim.z;
    unsigned sum, cnt, mine, sp = 0u;
    for (;;) {
        sum = 0u; cnt = 0u; mine = 0u;
#pragma unroll
        for (unsigned j = 0; j < 16; ++j) { const unsigned c = xb_ld(&bar[XB_XCNT(j)]); sum += c; cnt += (c > 0u) ? 1u : 0u; mine = (j == x) ? c : mine; }
        if (sum == G) break;
        __builtin_amdgcn_s_sleep(1);
        if ((++sp & 255u) == 0u) { if (xb_ld(&bar[XB_TMO])) break; if (sp > XB_SPIN_CAP) { atomicAdd(&bar[XB_TMO], 1u); break; } }
    }
    nloc = mine > 0u ? mine : 1u; nx = cnt > 0u ? cnt : 1u;
}

__device__ __forceinline__ void xcd_barrier(const XcdBarrier& b) {
    asm volatile("s_waitcnt vmcnt(0)" ::: "memory");
    __syncthreads();
    if (threadIdx.x == 0) {
        unsigned* bar = b.bar;
        __builtin_amdgcn_s_waitcnt(0);
        unsigned nloc = b.st[0], nx = b.st[1];
        if (nloc == 0u) { xcd_barrier_complete(bar, b.x, nloc, nx); b.st[0] = nloc; b.st[1] = nx; }
        const unsigned old = xb_add(&bar[XB_XSUB(b.x)], 1u);
        const unsigned gen = old / nloc;
        if (old + 1u == (gen + 1u) * nloc) {
            __builtin_amdgcn_fence(__ATOMIC_RELEASE, "agent");
            asm volatile("s_waitcnt vmcnt(0)" ::: "memory");
            const unsigned og = xb_add(&bar[XB_TOP], 1u);
            const unsigned tg = og / nx;
            if (og + 1u == (tg + 1u) * nx) xb_add(&bar[XB_TOPGEN], 1u);
            else XB_SPIN(xb_ld(&bar[XB_TOPGEN]) == tg, bar);
            __builtin_amdgcn_fence(__ATOMIC_ACQUIRE, "agent");
            xb_add(&bar[XB_XGEN(b.x)], 1u);
            asm volatile("s_waitcnt vmcnt(0)" ::: "memory");
        } else {
            XB_SPIN(xb_ld(&bar[XB_XGEN(b.x)]) == gen, bar);
            __builtin_amdgcn_fence(__ATOMIC_ACQUIRE, "agent");
            asm volatile("s_waitcnt vmcnt(0)" ::: "memory");
        }
    }
    __syncthreads();
}
typedef unsigned u32x2 __attribute__((ext_vector_type(2)));
typedef __bf16 bfx2 __attribute__((ext_vector_type(2)));
struct Frame {
    LAS unsigned char* lds;
    volatile LAS unsigned* MISC;
    gu32* ctl;
    int tid, lane, wave;
    int vcu, G;
    const float* in[N_IN]; float* out; unsigned char* ws;
};
__device__ __forceinline__ float wave_sum(float v) {
#pragma unroll
    for (int o = 1; o < 64; o <<= 1) v += __shfl_xor(v, o);
    return v;
}
__device__ __forceinline__ float bflo(unsigned w) { return __uint_as_float(w << 16); }
__device__ __forceinline__ float bfhi(unsigned w) { return __uint_as_float(w & 0xffff0000u); }
__device__ __forceinline__ void p0_transpose_item(const float* W, int K, int N, bf16* WT, int row_off, LAS float* scr, int item, int lane) {
    const int nblk = N / 32, kb = item / nblk, nb = item % nblk, k0 = 64 * kb, n0 = 32 * nb;
#pragma unroll 8
    for (int i = 0; i < 32; ++i) { const int kk = 2 * i + (lane >> 5); scr[kk * 33 + (lane & 31)] = W[(size_t)(k0 + kk) * N + n0 + (lane & 31)]; }
    LDS_WAIT(); asm volatile("" ::: "memory");
    const int c = lane & 7;
#pragma unroll
    for (int j = 0; j < 4; ++j) { const int n = (lane >> 3) + 8 * j; const LAS float* s = scr + (8 * c) * 33 + n;
        v4u o; o.x = pk2(s[0 * 33], s[1 * 33]); o.y = pk2(s[2 * 33], s[3 * 33]); o.z = pk2(s[4 * 33], s[5 * 33]); o.w = pk2(s[6 * 33], s[7 * 33]);
        *(GAS v4u*)(WT + (size_t)(row_off + n0 + n) * K + k0 + 8 * c) = o; }
    LDS_WAIT(); asm volatile("" ::: "memory");
}
__device__ __forceinline__ void rms_row_to_bf16(const float* xrow, const float* gain, bf16* orow, int lane) {
    const GAS f32x4* xr = (const GAS f32x4*)xrow + lane;
    f32x4 v[16]; float s = 0.f;
#pragma unroll
    for (int i = 0; i < 16; ++i) { v[i] = xr[64 * i]; s += (v[i].x * v[i].x + v[i].y * v[i].y) + (v[i].z * v[i].z + v[i].w * v[i].w); }
    const float rs = 1.0f / sqrtf(wave_sum(s) * (1.0f / DM) + EPS);
    const GAS f32x4* gr = (const GAS f32x4*)gain + lane;
    GAS u32x2* o8 = (GAS u32x2*)orow + lane;
#pragma unroll
    for (int i = 0; i < 16; ++i) { const f32x4 g = gr[64 * i]; u32x2 w; w.x = pk2(v[i].x * rs * g.x, v[i].y * rs * g.y); w.y = pk2(v[i].z * rs * g.z, v[i].w * rs * g.w); o8[64 * i] = w; }
}
__device__ __forceinline__ bf16x8 cvt8(const float* p) {
    const f32x4 a = *(const GAS f32x4*)p, b = *(const GAS f32x4*)(p + 4);
    v4u w; w.x = pk2(a.x, a.y); w.y = pk2(a.z, a.w); w.z = pk2(b.x, b.y); w.w = pk2(b.z, b.w);
    return __builtin_bit_cast(bf16x8, w);
}
__device__ __forceinline__ void p0_prologue(Frame& F) {
    LAS float* scr = (LAS float*)(F.lds + RING_OFF + F.wave * 16384);
    const int gw = F.vcu * NWAVES + F.wave, NGW = F.G * NWAVES;
    bf16* WINT = (bf16*)(F.ws + WS_WINT); bf16* WCOT = (bf16*)(F.ws + WS_WCOT); bf16* WAOT = (bf16*)(F.ws + WS_WAOT); bf16* WOT = (bf16*)(F.ws + WS_WOT);
    constexpr int I_1 = (DM / 64) * (INC / 32), I_2 = (CD / 64) * (DM / 32), I_3 = (AD / 64) * (DM / 32), I_4 = (DM / 64) * (DM / 32);
    constexpr int NITEMS = I_1 + I_2 + I_3 + I_4;
    for (int it = gw; it < NITEMS; it += NGW) {
        int r = it;
        if (r < I_1) { p0_transpose_item(F.in[I_WIN], DM, INC, WINT, 0, scr, r, F.lane); continue; } r -= I_1;
        if (r < I_2) { p0_transpose_item(F.in[I_WCO], CD, DM, WCOT, 0, scr, r, F.lane); continue; } r -= I_2;
        if (r < I_3) { p0_transpose_item(F.in[I_WAO], AD, DM, WAOT, 0, scr, r, F.lane); continue; } r -= I_3;
        p0_transpose_item(F.in[I_WO], DM, DM, WOT, 0, scr, r, F.lane);
    }
    bf16* HN = (bf16*)(F.ws + WS_HN);
    for (int m = gw; m < T_; m += NGW) rms_row_to_bf16(F.in[I_X] + (size_t)m * DM, F.in[I_NMIX], HN + (size_t)m * DM, F.lane);
    {
        bf16* WF = (bf16*)(F.ws + WS_WPQF); const float* SK = F.in[I_SUBK]; const float* WQ = F.in[I_WPQ];
        const int l15 = F.lane & 15, l4 = F.lane >> 4;
        for (int task = gw; task < 2048; task += NGW) {
            const int combo = task & 127, kr = task >> 7, hc = combo >> 3, kt = combo & 7, n0 = hc * 128 + kt * 16;
            bf16x8 bfr[4];
#pragma unroll
            for (int ds = 0; ds < 4; ++ds) bfr[ds] = cvt8(SK + (size_t)(n0 + l15) * 128 + ds * 32 + 8 * l4);
            for (int kk = 0; kk < 16; ++kk) {
                const int k0 = kr * 256 + kk * 16;
                pg8::f32x4 acc = {0.f, 0.f, 0.f, 0.f};
#pragma unroll
                for (int ds = 0; ds < 4; ++ds) { const bf16x8 a = cvt8(WQ + (size_t)(k0 + l15) * 2048 + hc * 128 + ds * 32 + 8 * l4);
                    acc = __builtin_amdgcn_mfma_f32_16x16x32_bf16(a, bfr[ds], acc, 0, 0, 0); }
                u32x2 w; w.x = pk2(acc[0], acc[1]); w.y = pk2(acc[2], acc[3]);
                *(GAS u32x2*)(WF + (size_t)(n0 + l15) * DM + k0 + 4 * l4) = w;
            }
        }
    }
    {
        const size_t n8 = (size_t)NEXP * DM / 8; const size_t gt = (size_t)F.vcu * (NWAVES * 64) + F.tid, nth = (size_t)F.G * (NWAVES * 64);
        bf16* UB = (bf16*)(F.ws + WS_UB); bf16* VB = (bf16*)(F.ws + WS_VB);
        for (size_t i = gt; i < 2 * n8; i += nth) { const bool isu = i < n8; const size_t j = isu ? i : i - n8;
            const bf16x8 w = cvt8((isu ? F.in[I_UEMB] : F.in[I_VEMB]) + j * 8); *(GAS bf16x8*)((isu ? UB : VB) + j * 8) = w; }
    }
}
__device__ __forceinline__ void p2_conv_kmean(Frame& F) {
    const bf16* Z = (const bf16*)(F.ws + WS_Z);
    float* KM = (float*)(F.ws + WS_KMEAN);
    LAS float* red = (LAS float*)(F.lds + RING_OFF);
    for (int u = F.vcu; u < 128; u += F.G) {
        const int bn = u >> 2, cg = u & 3, b = bn >> 3, n = bn & 7;
        const bf16* kp = Z + (size_t)(b * SEQ + n * 256 + F.wave * 32) * INC + ZC_K + cg * 512 + F.lane * 8;
        float s[8];
#pragma unroll
        for (int e = 0; e < 8; ++e) s[e] = 0.f;
#pragma unroll 8
        for (int t = 0; t < 32; ++t) { const v4u w = *(const GAS v4u*)(kp + (size_t)t * INC);
            s[0] += bflo(w.x); s[1] += bfhi(w.x); s[2] += bflo(w.y); s[3] += bfhi(w.y); s[4] += bflo(w.z); s[5] += bfhi(w.z); s[6] += bflo(w.w); s[7] += bfhi(w.w); }
        __syncthreads();
#pragma unroll
        for (int e = 0; e < 8; ++e) red[F.wave * 512 + F.lane * 8 + e] = s[e];
        __syncthreads();
        { float a = 0.f;
#pragma unroll
          for (int w = 0; w < 8; ++w) a += red[w * 512 + F.tid];
          const int col = cg * 512 + F.tid, h = col >> 7, d = col & 127;
          KM[((size_t)(b * NH + h) * NBLK + n) * HD + d] = a * (1.0f / 256.0f); }
    }
    const int gw = F.vcu * NWAVES + F.wave, NGW = F.G * NWAVES;
    bf16* BZ = (bf16*)(F.ws + WS_BZ); const float* CW = F.in[I_CONVW];
    for (int u = gw; u < (T_ / 16) * 4; u += NGW) {
        const int ch = u >> 2, cg = u & 3, t0 = ch * 16, c0 = cg * 512 + F.lane * 8;
        float w0[8], w1[8], w2[8];
#pragma unroll
        for (int e = 0; e < 8; ++e) { w0[e] = CW[c0 + e]; w1[e] = CW[CD + c0 + e]; w2[e] = CW[2 * CD + c0 + e]; }
        float p2[8], p1[8];
        const bool first = (t0 % SEQ) == 0;
#pragma unroll
        for (int e = 0; e < 8; ++e) { p2[e] = 0.f; p1[e] = 0.f; }
        if (!first) {
            const bf16* zr2 = Z + (size_t)(t0 - 2) * INC + c0; const bf16* zr1 = Z + (size_t)(t0 - 1) * INC + c0;
            const v4u c2 = *(const GAS v4u*)(zr2 + ZC_C), u2 = *(const GAS v4u*)(zr2 + ZC_U), c1 = *(const GAS v4u*)(zr1 + ZC_C), u1 = *(const GAS v4u*)(zr1 + ZC_U);
            p2[0] = bflo(c2.x) * bflo(u2.x); p2[1] = bfhi(c2.x) * bfhi(u2.x); p2[2] = bflo(c2.y) * bflo(u2.y); p2[3] = bfhi(c2.y) * bfhi(u2.y);
            p2[4] = bflo(c2.z) * bflo(u2.z); p2[5] = bfhi(c2.z) * bfhi(u2.z); p2[6] = bflo(c2.w) * bflo(u2.w); p2[7] = bfhi(c2.w) * bfhi(u2.w);
            p1[0] = bflo(c1.x) * bflo(u1.x); p1[1] = bfhi(c1.x) * bfhi(u1.x); p1[2] = bflo(c1.y) * bflo(u1.y); p1[3] = bfhi(c1.y) * bfhi(u1.y);
            p1[4] = bflo(c1.z) * bflo(u1.z); p1[5] = bfhi(c1.z) * bfhi(u1.z); p1[6] = bflo(c1.w) * bflo(u1.w); p1[7] = bfhi(c1.w) * bfhi(u1.w);
        }
#pragma unroll 4
        for (int t = 0; t < 16; ++t) {
            const bf16* zr = Z + (size_t)(t0 + t) * INC + c0;
            const v4u cc = *(const GAS v4u*)(zr + ZC_C), uu = *(const GAS v4u*)(zr + ZC_U), bb = *(const GAS v4u*)(zr + ZC_B);
            float p0[8], bg[8], o[8];
            p0[0] = bflo(cc.x) * bflo(uu.x); p0[1] = bfhi(cc.x) * bfhi(uu.x); p0[2] = bflo(cc.y) * bflo(uu.y); p0[3] = bfhi(cc.y) * bfhi(uu.y);
            p0[4] = bflo(cc.z) * bflo(uu.z); p0[5] = bfhi(cc.z) * bfhi(uu.z); p0[6] = bflo(cc.w) * bflo(uu.w); p0[7] = bfhi(cc.w) * bfhi(uu.w);
            bg[0] = bflo(bb.x); bg[1] = bfhi(bb.x); bg[2] = bflo(bb.y); bg[3] = bfhi(bb.y); bg[4] = bflo(bb.z); bg[5] = bfhi(bb.z); bg[6] = bflo(bb.w); bg[7] = bfhi(bb.w);
#pragma unroll
            for (int e = 0; e < 8; ++e) { o[e] = bg[e] * (w0[e] * p2[e] + w1[e] * p1[e] + w2[e] * p0[e]); p2[e] = p1[e]; p1[e] = p0[e]; }
            v4u w; w.x = pk2(o[0], o[1]); w.y = pk2(o[2], o[3]); w.z = pk2(o[4], o[5]); w.w = pk2(o[6], o[7]);
            *(GAS v4u*)(BZ + (size_t)(t0 + t) * CD + c0) = w;
        }
    }
}
__device__ __forceinline__ void p3_attention(Frame& F, char* lds) {
    const bf16* Z = (const bf16*)(F.ws + WS_Z); bf16* ATT = (bf16*)(F.ws + WS_ATT); const float* KM = (const float*)(F.ws + WS_KMEAN);
    for (int u = F.vcu; u < NBATCH * NH * 4; u += F.G) {
        const int bh = u >> 2, p = u & 3, b = bh / NH, h = bh % NH;
        const bf16* Kh = Z + (size_t)(b * SEQ) * INC + ZC_K + h * HD; const bf16* Vh = Z + (size_t)(b * SEQ) * INC + ZC_V + h * HD;
        const float* km = KM + (size_t)(b * NH + h) * NBLK * HD;
#pragma unroll 1
        for (int half = 0; half < 2; ++half) {
            const int qb = half == 0 ? 7 - p : p;
            const bf16* Qb = Z + (size_t)(b * SEQ + qb * 256) * INC + ZC_Q + h * HD;
            bf16* Ob = ATT + (size_t)(b * SEQ + qb * 256) * AD + h * HD;
            moba::moba_body(Qb, Kh, Vh, km, Ob, qb, lds);
        }
    }
}
__device__ __forceinline__ void p6_rms(Frame& F) {
    const int gw = F.vcu * NWAVES + F.wave, NGW = F.G * NWAVES; bf16* XN = (bf16*)(F.ws + WS_XN);
    for (int m = gw; m < T_; m += NGW) rms_row_to_bf16(F.out + (size_t)m * DM, F.in[I_NFFN], XN + (size_t)m * DM, F.lane);
}
__device__ __forceinline__ int fkey(float f) { const int b = __float_as_int(f); return b ^ ((b >> 31) & 0x7fffffff); }
__device__ __forceinline__ float kval(int k) { return __int_as_float(k ^ ((k >> 31) & 0x7fffffff)); }
__device__ __forceinline__ int imax(int a, int b) { return a > b ? a : b; }
__device__ __forceinline__ int imin(int a, int b) { return a < b ? a : b; }
__device__ __forceinline__ void sort16_desc(int (&v)[16]) {
#pragma unroll
    for (int k = 2; k <= 16; k <<= 1)
#pragma unroll
        for (int j = k >> 1; j > 0; j >>= 1)
#pragma unroll
            for (int i = 0; i < 16; ++i) { const int l = i ^ j; if (l > i) { const int a = v[i], b = v[l]; const int mx = imax(a, b), mn = imin(a, b); const bool desc = (i & k) == 0; v[i] = desc ? mx : mn; v[l] = desc ? mn : mx; } }
}
__device__ __forceinline__ void merge_top16(int (&run)[16], const int (&grp)[16]) {
#pragma unroll
    for (int i = 0; i < 16; ++i) run[i] = imax(run[i], grp[15 - i]);
#pragma unroll
    for (int j = 8; j > 0; j >>= 1)
#pragma unroll
        for (int i = 0; i < 16; ++i) { const int l = i ^ j; if (l > i) { const int a = run[i], b = run[l]; run[i] = imax(a, b); run[l] = imin(a, b); } }
}
__device__ __forceinline__ void topk128(const float* sp, int (&run)[16]) {
#pragma unroll
    for (int i = 0; i < 16; ++i) run[i] = (int)0x80000000;
#pragma unroll 1
    for (int g = 0; g < 8; ++g) {
        int grp[16];
#pragma unroll
        for (int i = 0; i < 16; ++i) grp[i] = (fkey(sp[(size_t)(g * 16 + i) * T_]) & ~0x7F) | (g * 16 + i);
        sort16_desc(grp);
        merge_top16(run, grp);
    }
}
struct CandTab { int a[64], b[64]; };
__host__ __device__ constexpr CandTab make_cand() { CandTab t{}; int n = 0; for (int a = 0; a < 16; ++a) for (int b = 0; b < 16; ++b) if ((a + 1) * (b + 1) <= 16) { t.a[n] = a; t.b[n] = b; ++n; }
    for (; n < 64; ++n) { t.a[n] = -1; t.b[n] = -1; } return t; }
__device__ __forceinline__ void p8_topk(Frame& F) {
    if (F.wave >= 4) return;
    constexpr CandTab CT = make_cand();
    const float* ST = (const float*)(F.ws + WS_ST); int* EXP = (int*)(F.ws + WS_EXP); float* GATE = (float*)(F.ws + WS_GATE);
    LAS int* tab = (LAS int*)(F.lds + RING_OFF + F.wave * 8192);
    for (int task = F.vcu * 4 + F.wave; task < (T_ / 64) * PH; task += F.G * 4) {
        const int tg = task >> 3, h = task & 7, t = tg * 64 + F.lane;
        int top0[16], top1[16];
        topk128(ST + (size_t)((h * 2 + 0) * 128) * T_ + t, top0);
        topk128(ST + (size_t)((h * 2 + 1) * 128) * T_ + t, top1);
        float s1[16], s2[16];
#pragma unroll
        for (int i = 0; i < 16; ++i) { s1[i] = kval(top0[i] & ~0x7F); s2[i] = kval(top1[i] & ~0x7F); tab[i * 64 + F.lane] = top0[i] & 0x7F; tab[(16 + i) * 64 + F.lane] = top1[i] & 0x7F; }
        int c0[16], c1[16], c2[16], c3[16];
#pragma unroll
        for (int i = 0; i < 16; ++i) {
            c0[i] = CT.a[i] < 0 ? (int)0x80000000 : ((fkey(s1[CT.a[i] < 0 ? 0 : CT.a[i]] + s2[CT.b[i] < 0 ? 0 : CT.b[i]]) & ~0xFF) | (CT.a[i] * 16 + CT.b[i]));
            c1[i] = CT.a[16 + i] < 0 ? (int)0x80000000 : ((fkey(s1[CT.a[16 + i] < 0 ? 0 : CT.a[16 + i]] + s2[CT.b[16 + i] < 0 ? 0 : CT.b[16 + i]]) & ~0xFF) | (CT.a[16 + i] * 16 + CT.b[16 + i]));
            c2[i] = CT.a[32 + i] < 0 ? (int)0x80000000 : ((fkey(s1[CT.a[32 + i] < 0 ? 0 : CT.a[32 + i]] + s2[CT.b[32 + i] < 0 ? 0 : CT.b[32 + i]]) & ~0xFF) | (CT.a[32 + i] * 16 + CT.b[32 + i]));
            c3[i] = CT.a[48 + i] < 0 ? (int)0x80000000 : ((fkey(s1[CT.a[48 + i] < 0 ? 0 : CT.a[48 + i]] + s2[CT.b[48 + i] < 0 ? 0 : CT.b[48 + i]]) & ~0xFF) | (CT.a[48 + i] * 16 + CT.b[48 + i]));
        }
        sort16_desc(c0); sort16_desc(c1); sort16_desc(c2); sort16_desc(c3);
        merge_top16(c0, c1); merge_top16(c2, c3); merge_top16(c0, c2);
        LDS_WAIT();
        int ex[16]; float gv[16]; float sum = 0.f; const float mx = kval(c0[0] & ~0xFF);
#pragma unroll
        for (int i = 0; i < 16; ++i) { const int ab = c0[i] & 0xFF, a = ab >> 4, b = ab & 15; const int i1 = tab[a * 64 + F.lane], i2 = tab[(16 + b) * 64 + F.lane];
            ex[i] = i1 * NKEYS + i2; gv[i] = __expf(kval(c0[i] & ~0xFF) - mx); sum += gv[i]; }
        const float inv = 1.0f / sum;
        int* ep = EXP + (size_t)t * NSEL + h * PTOPK; float* gp = GATE + (size_t)t * NSEL + h * PTOPK;
#pragma unroll
        for (int i = 0; i < 16; i += 4) { *(int4*)(ep + i) = make_int4(ex[i], ex[i + 1], ex[i + 2], ex[i + 3]); *(float4*)(gp + i) = make_float4(gv[i] * inv, gv[i + 1] * inv, gv[i + 2] * inv, gv[i + 3] * inv); }
        LDS_WAIT();
    }
}
__device__ __forceinline__ float dot2u(unsigned w, unsigned x, float acc) { return __builtin_amdgcn_fdot2_f32_bf16(__builtin_bit_cast(bfx2, w), __builtin_bit_cast(bfx2, x), acc, false); }
__device__ __forceinline__ float dot8(const v4u w, const v4u x, float s) { return dot2u(w.w, x.w, dot2u(w.z, x.z, dot2u(w.y, x.y, dot2u(w.x, x.x, s)))); }
__device__ __forceinline__ void p9_peer(Frame& F) {
    const int gw = F.vcu * NWAVES + F.wave, NGW = F.G * NWAVES, lane = F.lane;
    const bf16* XN = (const bf16*)(F.ws + WS_XN); const bf16* UB = (const bf16*)(F.ws + WS_UB); const bf16* VB = (const bf16*)(F.ws + WS_VB);
    const int* EXP = (const int*)(F.ws + WS_EXP); const float* GATE = (const float*)(F.ws + WS_GATE); const float* nf = F.in[I_NFIN];
    for (int t = gw; t < T_; t += NGW) {
        v4u xq[8];
#pragma unroll
        for (int i = 0; i < 8; ++i) xq[i] = *(const GAS v4u*)(XN + (size_t)t * DM + i * 512 + lane * 8);
        int ev[2]; float gvv[2], hid[2];
        ev[0] = EXP[(size_t)t * NSEL + lane]; ev[1] = EXP[(size_t)t * NSEL + 64 + lane]; gvv[0] = GATE[(size_t)t * NSEL + lane]; gvv[1] = GATE[(size_t)t * NSEL + 64 + lane];
#pragma unroll
        for (int hf = 0; hf < 2; ++hf) {
            float hacc = 0.f;
#pragma unroll 2
            for (int j = 0; j < 64; ++j) {
                const int e = __builtin_amdgcn_readlane(ev[hf], j);
                const GAS v4u* up = (const GAS v4u*)(UB + (size_t)e * DM) + lane;
                float s = 0.f;
#pragma unroll
                for (int i = 0; i < 8; ++i) s = dot8(up[i * 64], xq[i], s);
                s = wave_sum(s);
                const float hv = 0.5f * s * (1.0f + erff(s * 0.70710678118654752f));
                hacc = (lane == j) ? hv : hacc;
            }
            hid[hf] = hacc * gvv[hf];
        }
        float acc[8][8];
#pragma unroll
        for (int i = 0; i < 8; ++i)
#pragma unroll
            for (int k = 0; k < 8; ++k) acc[i][k] = 0.f;
#pragma unroll
        for (int hf = 0; hf < 2; ++hf) {
#pragma unroll 2
            for (int j = 0; j < 64; ++j) {
                const int e = __builtin_amdgcn_readlane(ev[hf], j);
                const float hv = __builtin_bit_cast(float, __builtin_amdgcn_readlane(__builtin_bit_cast(int, hid[hf]), j));
                const GAS v4u* vp = (const GAS v4u*)(VB + (size_t)e * DM) + lane;
#pragma unroll
                for (int i = 0; i < 8; ++i) { const v4u w = vp[i * 64];
                    acc[i][0] += hv * bflo(w.x); acc[i][1] += hv * bfhi(w.x); acc[i][2] += hv * bflo(w.y); acc[i][3] += hv * bfhi(w.y);
                    acc[i][4] += hv * bflo(w.z); acc[i][5] += hv * bfhi(w.z); acc[i][6] += hv * bflo(w.w); acc[i][7] += hv * bfhi(w.w); }
            }
        }
        float* orow = F.out + (size_t)t * DM; float ss = 0.f;
#pragma unroll
        for (int i = 0; i < 8; ++i) { const f32x4 h0 = *(const GAS f32x4*)(orow + i * 512 + lane * 8), h1 = *(const GAS f32x4*)(orow + i * 512 + lane * 8 + 4);
            acc[i][0] += h0.x; acc[i][1] += h0.y; acc[i][2] += h0.z; acc[i][3] += h0.w; acc[i][4] += h1.x; acc[i][5] += h1.y; acc[i][6] += h1.z; acc[i][7] += h1.w;
#pragma unroll
            for (int k = 0; k < 8; ++k) ss += acc[i][k] * acc[i][k]; }
        const float rs = 1.0f / sqrtf(wave_sum(ss) * (1.0f / DM) + EPS);
#pragma unroll
        for (int i = 0; i < 8; ++i) { const f32x4 n0 = *(const GAS f32x4*)(nf + i * 512 + lane * 8), n1 = *(const GAS f32x4*)(nf + i * 512 + lane * 8 + 4);
            f32x4 o0, o1; o0.x = acc[i][0] * rs * n0.x; o0.y = acc[i][1] * rs * n0.y; o0.z = acc[i][2] * rs * n0.z; o0.w = acc[i][3] * rs * n0.w;
            o1.x = acc[i][4] * rs * n1.x; o1.y = acc[i][5] * rs * n1.y; o1.z = acc[i][6] * rs * n1.z; o1.w = acc[i][7] * rs * n1.w;
            *(GAS f32x4*)(orow + i * 512 + lane * 8) = o0; *(GAS f32x4*)(orow + i * 512 + lane * 8 + 4) = o1; }
    }
}

struct Args { const float* in[N_IN]; float* out; unsigned char* ws; int ph_lo, ph_hi; };
static_assert(sizeof(Args) == N_IN * 8 + 8 + 8 + 8, "Args has no padding");
constexpr int N_PHASES = 10;
#ifndef MK_PER_PHASE
#define MK_PER_PHASE 0
#endif
__global__ void __launch_bounds__(NWAVES * 64, 2) fwd(Args args) {
    extern __shared__ __attribute__((aligned(16))) unsigned char lds[];
    Frame F;
    F.lds = (LAS unsigned char*)lds;
    F.MISC = (volatile LAS unsigned*)(F.lds + MISC_OFF);
    F.tid = threadIdx.x; F.lane = F.tid & 63; F.wave = __builtin_amdgcn_readfirstlane(F.tid >> 6);
    F.G = gridDim.x; { const int bx = blockIdx.x; F.vcu = (F.G % 8 == 0) ? (bx % 8) * (F.G / 8) + bx / 8 : bx; }
    F.ws = args.ws; F.out = args.out; F.ctl = (gu32*)(args.ws + WS_CTL);
#pragma unroll
    for (int i = 0; i < N_IN; ++i) F.in[i] = args.in[i];
    for (int u = F.tid; u < (LDS_BYTES - LDSCTL_OFF) / 4; u += NWAVES * 64) ((LAS unsigned*)(F.lds + LDSCTL_OFF))[u] = 0u;
    __syncthreads();
    XcdBarrier bar; bar.bar = (unsigned*)(F.ctl + CW_BAR); bar.x = 0; bar.st = nullptr;
    if (!MK_PER_PHASE) bar = xcd_barrier_post((unsigned*)(F.ctl + CW_BAR), F.MISC + 8);
    const int lo = args.ph_lo, hi = args.ph_hi;
#define IN(k) (lo <= (k) && (k) < hi)
#define SEAM(k) do { if (IN(k) && IN((k) + 1)) xcd_barrier(bar); } while (0)
    bf16* const HN = (bf16*)(F.ws + WS_HN); bf16* const Z = (bf16*)(F.ws + WS_Z); bf16* const BZ = (bf16*)(F.ws + WS_BZ); bf16* const ATT = (bf16*)(F.ws + WS_ATT);
    bf16* const MRG = (bf16*)(F.ws + WS_MRG); bf16* const XN = (bf16*)(F.ws + WS_XN); float* const ST = (float*)(F.ws + WS_ST);

    if (IN(0)) { p0_prologue(F); } SEAM(0);
    if (IN(1)) {
        pg8::Gemm g{HN, (const bf16*)(F.ws + WS_WINT), T_, INC, DM}; pg8::StaticOrder S; S.init(T_, INC, F.G, (int)blockIdx.x);
        pg8::EpiZ E{Z, F.in[I_BGATE]};
        pg8::gemm_phase<pg8::EpiZ, pg8::StaticOrder, true, true>(F.lds + RING_OFF, g, S, E);
    } SEAM(1);
    if (IN(2)) { p2_conv_kmean(F); } SEAM(2);
    if (IN(3)) { p3_attention(F, (char*)lds + RING_OFF); } SEAM(3);
    if (IN(4)) {
        { pg8::Gemm g{BZ, (const bf16*)(F.ws + WS_WCOT), T_, DM, CD}; pg8::StaticOrder S; S.init(T_, DM, F.G, (int)blockIdx.x);
          pg8::EpiGate<0> E{MRG, Z + ZC_GC};
          pg8::gemm_phase<pg8::EpiGate<0>, pg8::StaticOrder, true, true>(F.lds + RING_OFF, g, S, E); }
        __syncthreads();
        { pg8::Gemm g{ATT, (const bf16*)(F.ws + WS_WAOT), T_, DM, AD}; pg8::StaticOrder S; S.init(T_, DM, F.G, (int)blockIdx.x);
          pg8::EpiGate<1> E{MRG, Z + ZC_GA};
          pg8::gemm_phase<pg8::EpiGate<1>, pg8::StaticOrder, true, true>(F.lds + RING_OFF, g, S, E); }
    } SEAM(4);
    if (IN(5)) {
        pg8::Gemm g{MRG, (const bf16*)(F.ws + WS_WOT), T_, DM, DM}; pg8::StaticOrder S; S.init(T_, DM, F.G, (int)blockIdx.x);
        pg8::EpiF32R E{F.out, DM, F.in[I_X]};
        pg8::gemm_phase<pg8::EpiF32R, pg8::StaticOrder, true, true>(F.lds + RING_OFF, g, S, E);
    } SEAM(5);
    if (IN(6)) { p6_rms(F); } SEAM(6);
    if (IN(7)) {
        pg8::Gemm g{(const bf16*)(F.ws + WS_WPQF), XN, 2048, T_, DM}; pg8::StaticOrder S; S.init(2048, T_, F.G, (int)blockIdx.x);
        pg8::EpiF32R E{ST, T_, nullptr};
        pg8::gemm_phase<pg8::EpiF32R, pg8::StaticOrder, true, true>(F.lds + RING_OFF, g, S, E);
    } SEAM(7);
    if (IN(8)) { p8_topk(F); } SEAM(8);
    if (IN(9)) { p9_peer(F); }
#undef IN
#undef SEAM
}

extern "C" void kernel_launch(void* const* d_in, const int* in_sizes, int n_in, void* d_out, int out_size, void* d_ws, size_t ws_size, hipStream_t stream) {
    static int grid = 0;
    if (grid == 0) {
        if (n_in != N_IN || in_sizes[0] != T_ * DM || out_size != T_ * DM || ws_size < WS_END) { fprintf(stderr, "kernel_launch: shape mismatch (n_in %d in0 %d out %d ws %zu)\n", n_in, n_in > 0 ? in_sizes[0] : -1, out_size, ws_size); grid = -1; return; }
        int dev = 0, cus = 0, per_cu = 0;
        if (hipGetDevice(&dev) != hipSuccess || hipDeviceGetAttribute(&cus, hipDeviceAttributeMultiprocessorCount, dev) != hipSuccess) { grid = -1; return; }
        if (hipFuncSetAttribute((const void*)fwd, hipFuncAttributeMaxDynamicSharedMemorySize, LDS_BYTES) != hipSuccess) { fprintf(stderr, "kernel_launch: hipFuncSetAttribute failed\n"); grid = -1; return; }
        if (hipOccupancyMaxActiveBlocksPerMultiprocessor(&per_cu, (const void*)fwd, NWAVES * 64, LDS_BYTES) != hipSuccess || per_cu < 1)
            fprintf(stderr, "kernel_launch: note: occupancy query reports %d workgroups per CU\n", per_cu);
        (void)hipGetLastError();
        grid = cus;
    }
    if (grid < 0) return;
    if (hipMemsetAsync((char*)d_ws + WS_CTL, 0, CTL_ZERO_BYTES, stream) != hipSuccess) return;
    Args a{};
    for (int i = 0; i < N_IN; ++i) a.in[i] = (const float*)d_in[i];
    a.out = (float*)d_out; a.ws = (unsigned char*)d_ws;
#if MK_PER_PHASE
    for (int p = 0; p < N_PHASES; ++p) { a.ph_lo = p; a.ph_hi = p + 1; hipLaunchKernelGGL(fwd, dim3(grid), dim3(NWAVES * 64), LDS_BYTES, stream, a); }
#else
    a.ph_lo = 0; a.ph_hi = N_PHASES;
    hipLaunchKernelGGL(fwd, dim3(grid), dim3(NWAVES * 64), LDS_BYTES, stream, a);
#endif
    const hipError_t le = hipPeekAtLastError();
    if (le != hipSuccess) fprintf(stderr, "kernel_launch: launch failed: %s\n", hipGetErrorName(le));
}
```

```cpp
#include <hip/hip_runtime.h>
#include <cstdio>
#include <cstdint>
#ifndef RELAX_EPI
#define RELAX_EPI 0
#endif
namespace pg8 {
#define PG8_LAS __attribute__((address_space(3)))
typedef unsigned short bf16_t;
typedef short bf16x8 __attribute__((ext_vector_type(8)));
typedef float f32x4 __attribute__((ext_vector_type(4)));
typedef unsigned u32x4 __attribute__((ext_vector_type(4)));
constexpr int BM = 256, BK = 64, HALF = 128, HTB = HALF * BK * 2  , STAGE_BYTES = 8 * HTB, NXCD = 8, WGM = 8;

__host__ __device__ __forceinline__ int lds_byte(int r, int c) { const int st = (r >> 4) * 2 + (c >> 5), rr = r & 15, cc = c & 31, ob = rr * 64 + cc * 2; return st * 1024 + (ob ^ (((ob >> 9) & 1) << 5)); }
__host__ __device__ __forceinline__ void stage_rc(int b, int& R, int& C) { const int st = b / 1024, sb = b % 1024, swz = sb ^ (((sb >> 9) & 1) << 5); R = (st >> 1) * 16 + swz / 64; C = (st & 1) * 32 + (swz % 64) / 2; }
__host__ __device__ __forceinline__ int perm32(int rho) { const int n = rho >> 4, i = rho & 15; return 8 * (i >> 2) + 4 * n + (i & 3); }

struct Unit { int pm, pn; };
struct Gemm { const bf16_t* A; const bf16_t* Bt; int M, N, K, ld; };

struct StaticOrder {
    int nM, nN, nwg, G, c;
    __host__ __device__ void init(int M, int N, int G_, int c_) { nM = M / BM; nN = N / BM; nwg = nM * nN; G = G_; c = c_; }
    __host__ __device__ bool next(int i, Unit& u) const {
        const long L = (long)i * G + c; if (L >= nwg) return false;
        int wgid = (int)L; { const int q = nwg / NXCD, r = nwg % NXCD, xcd = wgid % NXCD, off = wgid / NXCD; wgid = (xcd < r ? xcd * (q + 1) : r * (q + 1) + (xcd - r) * q) + off; }
        const int nig = WGM * nN, gid = wgid / nig, fm = gid * WGM, gsz = (nM - fm) < WGM ? (nM - fm) : WGM;
        u.pm = fm + ((wgid % nig) % gsz); u.pn = (wgid % nig) / gsz; return true;
    }
    __device__ __forceinline__ void a_ready(const Unit&) const {}
    __device__ __forceinline__ void done(const Unit&) const {}
};

constexpr int HK_NCHUNK = 262144, HK_HALF = 131072; constexpr float HK_USCALE = 1024.0f, HK_VSCALE = 16.0f;
struct TblHook { const float* u; const float* v; unsigned char* ub; unsigned char* dummy; int gwave, ngw; };
constexpr int HK_LDS_OFF = 131584;
__device__ __forceinline__ void hook_issue(const TblHook& h, int it, int lane, PG8_LAS unsigned char* slot) {
    const int q = __builtin_amdgcn_readfirstlane(it * h.ngw + h.gwave); const int qq = q < HK_NCHUNK ? q : 0; const bool isu = qq < HK_HALF; const int j = isu ? qq : qq - HK_HALF;
    const __amdgpu_buffer_rsrc_t r = __builtin_amdgcn_make_buffer_rsrc((void*)(isu ? h.u : h.v), (short)0, 0x7fffffff, 0x00020000);
    const unsigned so = (unsigned)j * 2048u, l16 = (unsigned)lane * 16u;
    __builtin_amdgcn_raw_ptr_buffer_load_lds(r, (PG8_LAS void*)slot, 16, l16, so, 0, 0);
    __builtin_amdgcn_raw_ptr_buffer_load_lds(r, (PG8_LAS void*)(slot + 1024), 16, l16, so + 1024u, 0, 0);
}
__device__ __forceinline__ unsigned hook_u8(const f32x4 a) {
    const float lim = 127.0f / HK_USCALE; unsigned y[4];
#pragma unroll
    for (int i = 0; i < 4; ++i) y[i] = __float_as_uint(__builtin_fmaf(__builtin_amdgcn_fmed3f(a[i], -lim, lim), HK_USCALE, 12582912.0f));
    const unsigned lo = __builtin_amdgcn_perm(y[1], y[0], 0x0c0c0400u), hi = __builtin_amdgcn_perm(y[3], y[2], 0x04000c0cu);
    return lo | hi;
}
__device__ __forceinline__ unsigned hook_f8(const f32x4 a) { int w = __builtin_amdgcn_cvt_pk_fp8_f32(a[0] * HK_VSCALE, a[1] * HK_VSCALE, 0, false); return (unsigned)__builtin_amdgcn_cvt_pk_fp8_f32(a[2] * HK_VSCALE, a[3] * HK_VSCALE, w, true); }
__device__ __forceinline__ void hook_store(const TblHook& h, int it, int lane, const f32x4 a, const f32x4 b) {
    const int q = __builtin_amdgcn_readfirstlane(it * h.ngw + h.gwave); const bool act = q < HK_NCHUNK; const int qq = act ? q : 0;
    const bool isu = qq < HK_HALF; const int j = isu ? qq : qq - HK_HALF; const int e = j >> 3, c512 = j & 7, sl = c512 >> 1, c0 = (c512 & 1) * 512;
    unsigned char* dt = h.ub + (isu ? (size_t)0 : ((size_t)64 << 20)) + ((size_t)sl * 16384 + e) * 1024 + c0;
    unsigned char* d = act ? dt : h.dummy + (size_t)h.gwave * 512;
    const unsigned l4 = (unsigned)lane * 4u; unsigned w0, w1;
    if (isu) { w0 = hook_u8(a); w1 = hook_u8(b); } else { w0 = hook_f8(a); w1 = hook_f8(b); }
    *(unsigned*)(d + l4) = w0; *(unsigned*)(d + 256 + l4) = w1;
}
__device__ __forceinline__ unsigned cvt_pk_bf16(float lo, float hi) { unsigned r; asm volatile("v_cvt_pk_bf16_f32 %0, %1, %2" : "=v"(r) : "v"(lo), "v"(hi)); return r; }
typedef float f32x2 __attribute__((ext_vector_type(2)));
__device__ __forceinline__ float bf_lo(unsigned w) { return __uint_as_float(w << 16); }
__device__ __forceinline__ float bf_hi(unsigned w) { return __uint_as_float(w & 0xffff0000u); }
__device__ __forceinline__ float sigm(float x) { return __builtin_amdgcn_rcpf(1.0f + __builtin_amdgcn_exp2f(-1.4426950408889634f * x)); }
typedef int v8i32 __attribute__((ext_vector_type(8))); typedef int v4i32 __attribute__((ext_vector_type(4)));
__device__ __forceinline__ v8i32 cat8(bf16x8 a, bf16x8 b) { const v4i32 x = __builtin_bit_cast(v4i32, a), y = __builtin_bit_cast(v4i32, b); return (v8i32){x[0], x[1], x[2], x[3], y[0], y[1], y[2], y[3]}; }
constexpr int ZLD = 20480;
constexpr int ZGATE0 = 12288;
struct EpiZ {
    static constexpr bool PERM = true, AFTER_DRAIN = false, HAS_MID = false; static constexpr int NSTORE = 16;
    bf16_t* Z; const float* bgate; int col_off; float scale;
    __device__ __forceinline__ void operator()(const f32x4 (&acc)[2][2][4][2], const Unit& u, int wr, int wc, int fr, int fq) const {
        const int row0 = u.pm * BM + wr * 64 + fr, col0 = col_off + u.pn * BM + wc * 32 + 8 * fq;
        const bool gate = (col_off + u.pn * BM) >= ZGATE0;
        f32x4 bv[2][2];
#pragma unroll
        for (int bj = 0; bj < 2; ++bj)
#pragma unroll
            for (int n = 0; n < 2; ++n) bv[bj][n] = gate ? *(const f32x4*)(bgate + (col0 - ZGATE0) + bj * HALF + 4 * n) : (f32x4){0.f, 0.f, 0.f, 0.f};
#pragma unroll
        for (int ai = 0; ai < 2; ++ai)
#pragma unroll
            for (int m = 0; m < 4; ++m) { bf16_t* rowp = Z + (size_t)(row0 + ai * HALF + m * 16) * ZLD + col0;
#pragma unroll
                for (int bj = 0; bj < 2; ++bj) { f32x4 v0 = acc[ai][bj][m][0] * scale + bv[bj][0], v1 = acc[ai][bj][m][1] * scale + bv[bj][1];
                    if (gate) {
#pragma unroll
                        for (int j = 0; j < 4; ++j) { v0[j] = sigm(v0[j]); v1[j] = sigm(v1[j]); } }
                    u32x4 w; w.x = cvt_pk_bf16(v0[0], v0[1]); w.y = cvt_pk_bf16(v0[2], v0[3]); w.z = cvt_pk_bf16(v1[0], v1[1]); w.w = cvt_pk_bf16(v1[2], v1[3]);
                    *(u32x4*)(rowp + bj * HALF) = w; } }
    }
};
template <int MODE, int ldo, int ldo8, int ACC_SHIFT, int OUT_SHIFT> struct EpiGate {
    static constexpr bool PERM = true, AFTER_DRAIN = false, HAS_MID = false; static constexpr int NSTORE = 16;
    static constexpr float scale = 1.0f / (float)(1 << ACC_SHIFT), oscale = (float)(1 << OUT_SHIFT);
    bf16_t* O; const bf16_t* Zg; unsigned char* O8;
    __device__ __forceinline__ void operator()(const f32x4 (&acc)[2][2][4][2], const Unit& u, int wr, int wc, int fr, int fq) const {
        const int row0 = u.pm * BM + wr * 64 + fr, col0 = u.pn * BM + wc * 32 + 8 * fq;
#pragma unroll
        for (int ai = 0; ai < 2; ++ai)
#pragma unroll
            for (int m = 0; m < 4; ++m) { const size_t r = (size_t)(row0 + ai * HALF + m * 16); bf16_t* rowp = O + r * ldo + col0; const bf16_t* gp = Zg + r * ZLD + col0;
#pragma unroll
                for (int bj = 0; bj < 2; ++bj) { const u32x4 g = *(const u32x4*)(gp + bj * HALF); const f32x4 v0 = acc[ai][bj][m][0] * scale, v1 = acc[ai][bj][m][1] * scale;
                    float o0 = v0[0] * bf_lo(g.x), o1 = v0[1] * bf_hi(g.x), o2 = v0[2] * bf_lo(g.y), o3 = v0[3] * bf_hi(g.y);
                    float o4 = v1[0] * bf_lo(g.z), o5 = v1[1] * bf_hi(g.z), o6 = v1[2] * bf_lo(g.w), o7 = v1[3] * bf_hi(g.w);
                    if (MODE >= 1) { const u32x4 p = *(const u32x4*)(rowp + bj * HALF);
                        o0 += bf_lo(p.x); o1 += bf_hi(p.x); o2 += bf_lo(p.y); o3 += bf_hi(p.y); o4 += bf_lo(p.z); o5 += bf_hi(p.z); o6 += bf_lo(p.w); o7 += bf_hi(p.w); }
                    if (MODE == 3) {
                        int q_[8]; const float ov_[8] = {o0, o1, o2, o3, o4, o5, o6, o7};
#pragma unroll
                        for (int j = 0; j < 8; ++j) { int q = __float2int_rn(ov_[j] * oscale); q_[j] = (q < -127 ? -127 : (q > 127 ? 127 : q)) & 0xff; }
                        typedef unsigned u32x2e __attribute__((ext_vector_type(2))); u32x2e w8; w8.x = (unsigned)(q_[0] | (q_[1] << 8) | (q_[2] << 16) | (q_[3] << 24)); w8.y = (unsigned)(q_[4] | (q_[5] << 8) | (q_[6] << 16) | (q_[7] << 24));
                        *(u32x2e*)(O8 + r * ldo8 + col0 + bj * HALF) = w8; }
                    if (MODE == 2) {
                        int w0 = __builtin_amdgcn_cvt_pk_fp8_f32(o0 * oscale, o1 * oscale, 0, false); w0 = __builtin_amdgcn_cvt_pk_fp8_f32(o2 * oscale, o3 * oscale, w0, true);
                        int w1 = __builtin_amdgcn_cvt_pk_fp8_f32(o4 * oscale, o5 * oscale, 0, false); w1 = __builtin_amdgcn_cvt_pk_fp8_f32(o6 * oscale, o7 * oscale, w1, true);
                        typedef unsigned u32x2e __attribute__((ext_vector_type(2))); u32x2e w8; w8.x = (unsigned)w0; w8.y = (unsigned)w1;
                        *(u32x2e*)(O8 + r * ldo8 + col0 + bj * HALF) = w8; }
                    if (MODE < 2) { u32x4 w; w.x = cvt_pk_bf16(o0, o1); w.y = cvt_pk_bf16(o2, o3); w.z = cvt_pk_bf16(o4, o5); w.w = cvt_pk_bf16(o6, o7);
                        *(u32x4*)(rowp + bj * HALF) = w; } } }
    }
};
struct EpiF32R {
    static constexpr bool PERM = false, AFTER_DRAIN = false, HAS_MID = false; static constexpr int NSTORE = 32;
    float* C; int ldc; const float* R; float scale;
    __device__ __forceinline__ void operator()(const f32x4 (&acc)[2][2][4][2], const Unit& u, int wr, int wc, int fr, int fq) const {
        const int row0 = u.pm * BM + wr * 64 + fr, col0 = u.pn * BM + wc * 32 + 4 * fq;
#pragma unroll
        for (int ai = 0; ai < 2; ++ai)
#pragma unroll
            for (int m = 0; m < 4; ++m) { const size_t off = (size_t)(row0 + ai * HALF + m * 16) * ldc + col0;
#pragma unroll
                for (int bj = 0; bj < 2; ++bj)
#pragma unroll
                    for (int n = 0; n < 2; ++n) { f32x4 v = acc[ai][bj][m][n] * scale; if (R) v += *(const f32x4*)(R + off + bj * HALF + n * 16); *(f32x4*)(C + off + bj * HALF + n * 16) = v; } }
    }
};

struct EpiHB {
    static constexpr bool PERM = false, AFTER_DRAIN = false, HAS_MID = false; static constexpr int NSTORE = 32;
    bf16_t* HB; const float* R; float scale;
    __device__ __forceinline__ void operator()(const f32x4 (&acc)[2][2][4][2], const Unit& u, int wr, int wc, int fr, int fq) const {
        const int row0 = u.pm * BM + wr * 64 + fr, col0 = u.pn * BM + wc * 32 + 4 * fq;
        typedef unsigned u32x2e __attribute__((ext_vector_type(2)));
#pragma unroll
        for (int ai = 0; ai < 2; ++ai)
#pragma unroll
            for (int m = 0; m < 4; ++m) { const size_t off = (size_t)(row0 + ai * HALF + m * 16) * 4096 + col0;
#pragma unroll
                for (int bj = 0; bj < 2; ++bj)
#pragma unroll
                    for (int n = 0; n < 2; ++n) { const f32x4 v = acc[ai][bj][m][n] * scale + *(const f32x4*)(R + off + bj * HALF + n * 16);
                        u32x2e w; w.x = cvt_pk_bf16(v[0], v[1]); w.y = cvt_pk_bf16(v[2], v[3]); *(u32x2e*)(HB + off + bj * HALF + n * 16) = w; } }
    }
};

__device__ __forceinline__ unsigned q8x4(const f32x4 a, const f32x4 g, float s) {
    unsigned y[4];
#pragma unroll
    for (int i = 0; i < 4; ++i) y[i] = __float_as_uint(__builtin_fmaf(__builtin_amdgcn_fmed3f(a[i] * g[i] * s, -127.0f, 127.0f), 1.0f, 12582912.0f));
    return __builtin_amdgcn_perm(y[1], y[0], 0x0c0c0400u) | __builtin_amdgcn_perm(y[3], y[2], 0x04000c0cu);
}
template <int HQS, int LDQ8  , size_t OFF_Q8, size_t OFF_SSQP> struct EpiHQ {
    static constexpr bool PERM = true, AFTER_DRAIN = false, HAS_MID = false; static constexpr int NSTORE = 32;
    bf16_t* HB; const float* R; const float* gain; unsigned char* ws; float scale;
    __device__ __forceinline__ void operator()(const f32x4 (&acc)[2][2][4][2], const Unit& u, int wr, int wc, int fr, int fq) const {
        const int row0 = u.pm * BM + wr * 64 + fr, col0 = u.pn * BM + wc * 32 + 8 * fq;
        typedef unsigned u32x2e __attribute__((ext_vector_type(2)));
        f32x4 gv[2][2];
#pragma unroll
        for (int bj = 0; bj < 2; ++bj)
#pragma unroll
            for (int n = 0; n < 2; ++n) gv[bj][n] = *(const f32x4*)(gain + col0 + bj * HALF + 4 * n);
        float* SSQP = (float*)(ws + OFF_SSQP); unsigned char* Q8 = ws + OFF_Q8;
#pragma unroll
        for (int ai = 0; ai < 2; ++ai)
#pragma unroll
            for (int mp = 0; mp < 4; mp += 2) {
                f32x4 xr[2][2][2];
#pragma unroll
                for (int mi = 0; mi < 2; ++mi)
#pragma unroll
                    for (int bj = 0; bj < 2; ++bj) { const size_t off = (size_t)(row0 + ai * HALF + (mp + mi) * 16) * 4096 + col0 + bj * HALF; xr[mi][bj][0] = *(const f32x4*)(R + off); xr[mi][bj][1] = *(const f32x4*)(R + off + 4); }
#pragma unroll
                for (int mi = 0; mi < 2; ++mi) { const int m = mp + mi; const size_t r = (size_t)(row0 + ai * HALF + m * 16); float ss = 0.f;
#pragma unroll
                    for (int bj = 0; bj < 2; ++bj) { const size_t off = r * 4096 + col0 + bj * HALF;
                        const f32x4 v0 = acc[ai][bj][m][0] * scale + xr[mi][bj][0], v1 = acc[ai][bj][m][1] * scale + xr[mi][bj][1];
                        ss += (v0[0] * v0[0] + v0[1] * v0[1]) + (v0[2] * v0[2] + v0[3] * v0[3]) + (v1[0] * v1[0] + v1[1] * v1[1]) + (v1[2] * v1[2] + v1[3] * v1[3]);
                        u32x4 w; w.x = cvt_pk_bf16(v0[0], v0[1]); w.y = cvt_pk_bf16(v0[2], v0[3]); w.z = cvt_pk_bf16(v1[0], v1[1]); w.w = cvt_pk_bf16(v1[2], v1[3]);
                        *(u32x4*)(HB + off) = w;
                        u32x2e q; q.x = q8x4(v0, gv[bj][0], (float)HQS); q.y = q8x4(v1, gv[bj][1], (float)HQS);
                        *(u32x2e*)(Q8 + r * LDQ8 + col0 + bj * HALF) = q; }
                    ss += __shfl_xor(ss, 16); ss += __shfl_xor(ss, 32);
                    if (fq == 0) SSQP[r * 64 + u.pn * 4 + wc] = ss; } }
    }
};

struct EpiMerge {
    static constexpr bool PERM = true, AFTER_DRAIN = false, HAS_MID = true; static constexpr int NSTORE = 16;
    const bf16_t* Zgc; unsigned char* O8;
    static constexpr int ldo8 = 4224;
    __device__ __forceinline__ void mid(f32x4 (&acc)[2][2][4][2], const Unit& u, int wr, int wc, int fr, int fq) const {
        asm volatile("" : "+v"(fr), "+v"(fq));
        const int row0 = u.pm * BM + wr * 64 + fr, col0 = u.pn * BM + wc * 32 + 8 * fq;
#pragma unroll
        for (int ai = 0; ai < 2; ++ai)
#pragma unroll
            for (int m = 0; m < 4; ++m) { const bf16_t* gp = Zgc + (size_t)(row0 + ai * HALF + m * 16) * ZLD + col0;
#pragma unroll
                for (int bj = 0; bj < 2; ++bj) { const u32x4 c = *(const u32x4*)(gp + bj * HALF), a = *(const u32x4*)(gp + 4096 + bj * HALF);
                    f32x4 r0, r1;
                    r0[0] = 4.0f * bf_lo(c.x) * __builtin_amdgcn_rcpf(bf_lo(a.x)); r0[1] = 4.0f * bf_hi(c.x) * __builtin_amdgcn_rcpf(bf_hi(a.x)); r0[2] = 4.0f * bf_lo(c.y) * __builtin_amdgcn_rcpf(bf_lo(a.y)); r0[3] = 4.0f * bf_hi(c.y) * __builtin_amdgcn_rcpf(bf_hi(a.y));
                    r1[0] = 4.0f * bf_lo(c.z) * __builtin_amdgcn_rcpf(bf_lo(a.z)); r1[1] = 4.0f * bf_hi(c.z) * __builtin_amdgcn_rcpf(bf_hi(a.z)); r1[2] = 4.0f * bf_lo(c.w) * __builtin_amdgcn_rcpf(bf_lo(a.w)); r1[3] = 4.0f * bf_hi(c.w) * __builtin_amdgcn_rcpf(bf_hi(a.w));
                    acc[ai][bj][m][0] *= r0; acc[ai][bj][m][1] *= r1; }
                if (m == 3) __builtin_amdgcn_sched_barrier(0); }
    }
    __device__ __forceinline__ void operator()(const f32x4 (&acc)[2][2][4][2], const Unit& u, int wr, int wc, int fr, int fq) const {
        const int row0 = u.pm * BM + wr * 64 + fr, col0 = u.pn * BM + wc * 32 + 8 * fq;
        typedef unsigned u32x2e __attribute__((ext_vector_type(2)));
#pragma unroll
        for (int ai = 0; ai < 2; ++ai)
#pragma unroll
            for (int m = 0; m < 4; ++m) { const size_t r = (size_t)(row0 + ai * HALF + m * 16); const bf16_t* gp = Zgc + r * ZLD + col0 + 4096;
                u32x4 ab[2];
#pragma unroll
                for (int bj = 0; bj < 2; ++bj) ab[bj] = *(const u32x4*)(gp + bj * HALF);
#pragma unroll
                for (int bj = 0; bj < 2; ++bj) { const u32x4 a = ab[bj];
                    const f32x4 g0 = {bf_lo(a.x), bf_hi(a.x), bf_lo(a.y), bf_hi(a.y)}, g1 = {bf_lo(a.z), bf_hi(a.z), bf_lo(a.w), bf_hi(a.w)};
                    u32x2e q; q.x = q8x4(acc[ai][bj][m][0], g0, 32.0f / 32768.0f); q.y = q8x4(acc[ai][bj][m][1], g1, 32.0f / 32768.0f);
                    *(u32x2e*)(O8 + r * ldo8 + col0 + bj * HALF) = q; } }
    }
};
template <class Epi, class Sched, bool ALIGN_EPI = false, bool SP2 = false, int FP8 = 0  , int HOOK = 0  >
__device__ __forceinline__ void gemm_phase(PG8_LAS unsigned char* lds, const Gemm g, const Sched& S, const Epi& E, const TblHook hk = TblHook{}) {
    const int tid = threadIdx.x, wid = __builtin_amdgcn_readfirstlane(tid >> 6), lane = tid & 63, wr = wid >> 2, wc = wid & 3, fr = lane & 15, fq = lane >> 4;
    const int K = g.K, nt = K / BK, LD = g.ld;
    unsigned voffA[2], voffB[2];
#pragma unroll
    for (int i = 0; i < 2; ++i) { int R, C; stage_rc(tid * 16 + i * 8192, R, C); const int Rb = Epi::PERM ? ((R & ~31) + perm32(R & 31)) : R;
        voffA[i] = (unsigned)(R * LD + C) * 2u; voffB[i] = (unsigned)(Rb * LD + C) * 2u; }
    const unsigned kstep = (unsigned)(BK * 2);
    const unsigned hstep = (unsigned)HALF * LD * 2;
    const unsigned tstep = 2 * hstep;
    const __amdgpu_buffer_rsrc_t rA = __builtin_amdgcn_make_buffer_rsrc((void*)g.A, (short)0, 0x7fffffff, 0x00020000), rB = __builtin_amdgcn_make_buffer_rsrc((void*)g.Bt, (short)0, 0x7fffffff, 0x00020000);
    const unsigned ldsw = (unsigned)wid * 1024u;
    const int aoff = lds_byte(wr * 64 + fr, fq * 8), boff = lds_byte(wc * 32 + fr, fq * 8);
#define PG8_SA(b, h) (((b) * 2 + (h)) * HTB)
#define PG8_SB(b, h) ((4 + (b) * 2 + (h)) * HTB)
#define PG8_STAGE(bufoff, rsrc, soff, voff) do { _Pragma("unroll") for (int _i = 0; _i < 2; ++_i) \
        __builtin_amdgcn_raw_ptr_buffer_load_lds(rsrc, (PG8_LAS void*)(lds + (bufoff) + ldsw + _i * 8192), 16, (voff)[_i], (soff), 0, 0); } while (0)
#define PG8_LDA(dst, b, h) do { _Pragma("unroll") for (int m = 0; m < 4; ++m) _Pragma("unroll") for (int k = 0; k < 2; ++k) dst[m][k] = *(const PG8_LAS bf16x8*)(lds + PG8_SA(b, h) + aoff + m * 2048 + k * 1024); } while (0)
#define PG8_LDB(dst, b, h) do { _Pragma("unroll") for (int n = 0; n < 2; ++n) _Pragma("unroll") for (int k = 0; k < 2; ++k) dst[n][k] = *(const PG8_LAS bf16x8*)(lds + PG8_SB(b, h) + boff + n * 2048 + k * 1024); } while (0)
#define PG8_MMA(ai, bj, At, Bt) do { __builtin_amdgcn_s_setprio(1); _Pragma("unroll") for (int m = 0; m < 4; ++m) _Pragma("unroll") for (int n = 0; n < 2; ++n) { \
        if constexpr (FP8 == 2) { _Pragma("unroll") for (int k = 0; k < 2; ++k) asm volatile("v_mfma_i32_16x16x64_i8 %0, %1, %2, %0" : "+v"(acc[ai][bj][m][n]) : "v"(Bt[n][k]), "v"(At[m][k]));   } \
        else if constexpr (FP8 == 1) { const v8i32 b8_ = cat8(Bt[n][0], Bt[n][1]), a8_ = cat8(At[m][0], At[m][1]);   \
            asm volatile("v_mfma_scale_f32_16x16x128_f8f6f4 %0, %1, %2, %0, %3, %3 op_sel_hi:[0,0,0]" : "+v"(acc[ai][bj][m][n]) : "v"(b8_), "v"(a8_), "v"(one_scale)); } \
        else { _Pragma("unroll") for (int k = 0; k < 2; ++k) asm volatile("v_mfma_f32_16x16x32_bf16 %0, %1, %2, %0" : "+v"(acc[ai][bj][m][n]) : "v"(Bt[n][k]), "v"(At[m][k])); } } __builtin_amdgcn_s_setprio(0); } while (0)
#define PG8_WAIT_V(n) asm volatile("s_waitcnt vmcnt(" #n ")" ::: "memory")
#define PG8_WAIT_VI(n) asm volatile("s_waitcnt vmcnt(%0)" :: "n"(n) : "memory")
#define PG8_WAIT_L(n) asm volatile("s_waitcnt lgkmcnt(" #n ")" ::: "memory")
#define PG8_BAR __builtin_amdgcn_s_barrier()
#define PG8_SCHED __builtin_amdgcn_sched_barrier(0)
    Unit cur, nxt; int ui = 0; int hit = 0;
#define PG8_HOOK_REST do { if constexpr (HOOK) { for (; hit * hk.ngw + hk.gwave < HK_NCHUNK; ++hit) { const int q_ = hit * hk.ngw + hk.gwave; const float* hp_ = (q_ < HK_HALF ? hk.u + (size_t)q_ * 512 : hk.v + (size_t)(q_ - HK_HALF) * 512) + lane * 4; \
        const f32x4 a_ = *(const f32x4*)hp_, b_ = *(const f32x4*)(hp_ + 256); hook_store(hk, hit, lane, a_, b_); } } } while (0)
    if (!S.next(0, cur)) { PG8_HOOK_REST; return; }
    const int one_scale = 0x7f7f7f7f;
    f32x4 acc[2][2][4][2];
#pragma unroll
    for (int a = 0; a < 2; ++a)
#pragma unroll
        for (int b = 0; b < 2; ++b)
#pragma unroll
            for (int m = 0; m < 4; ++m)
#pragma unroll
                for (int n = 0; n < 2; ++n) acc[a][b][m][n] = (f32x4){0.f, 0.f, 0.f, 0.f};
    bf16x8 At[4][2], B0[2][2], B1[2][2];
    unsigned cA = (unsigned)cur.pm * tstep, cB = (unsigned)cur.pn * tstep;
    S.a_ready(cur);
    if constexpr (SP2) {
        PG8_STAGE(PG8_SB(0, 0), rB, cB, voffB); PG8_STAGE(PG8_SB(0, 1), rB, cB + hstep, voffB); PG8_STAGE(PG8_SA(0, 0), rA, cA, voffA); PG8_STAGE(PG8_SA(0, 1), rA, cA + hstep, voffA);
        if (wr == 1) PG8_BAR;
        PG8_WAIT_V(2); PG8_BAR;
        PG8_STAGE(PG8_SB(1, 0), rB, cB + kstep, voffB); PG8_STAGE(PG8_SA(1, 0), rA, cA + kstep, voffA); PG8_STAGE(PG8_SB(1, 1), rB, cB + hstep + kstep, voffB);
        PG8_WAIT_V(6); PG8_BAR;
    } else {
        PG8_STAGE(PG8_SB(0, 0), rB, cB, voffB); PG8_STAGE(PG8_SA(0, 0), rA, cA, voffA); PG8_STAGE(PG8_SB(0, 1), rB, cB + hstep, voffB); PG8_STAGE(PG8_SA(0, 1), rA, cA + hstep, voffA);
        if (wr == 1) PG8_BAR;
        PG8_WAIT_V(4); PG8_BAR;
        PG8_STAGE(PG8_SB(1, 0), rB, cB + kstep, voffB); PG8_STAGE(PG8_SA(1, 0), rA, cA + kstep, voffA); PG8_STAGE(PG8_SB(1, 1), rB, cB + hstep + kstep, voffB);
        PG8_WAIT_V(6); PG8_BAR;
    }
    for (;;) {
        const bool has_next = S.next(ui + 1, nxt);
        const unsigned nA = has_next ? (unsigned)nxt.pm * tstep : cA, nB = has_next ? (unsigned)nxt.pn * tstep : cB;
        const bool hon = HOOK && ((hit + nt / 2 - 1) * hk.ngw + hk.gwave < HK_NCHUNK);
        for (int t = 0; t < nt; t += 2) {
            if constexpr (Epi::HAS_MID) { if (t == nt / 2) { asm volatile("s_nop 7\n\ts_nop 7\n\ts_nop 7" ::: "memory"); E.mid(acc, cur, wr, wc, fr, fq); } }
            const bool last = (t == nt - 2);
            const unsigned a1 = cA + (unsigned)(t + 1) * kstep;
            const unsigned a2 = last ? nA : cA + (unsigned)(t + 2) * kstep, b2 = last ? nB : cB + (unsigned)(t + 2) * kstep;
            const unsigned a3 = a2 + kstep, b3 = b2 + kstep;
            if (last && has_next) S.a_ready(nxt);
            constexpr int EPI_NS = Epi::NSTORE; const bool relax = RELAX_EPI && (t == 0) && (ui > 0);
            if constexpr (SP2) {
            PG8_LDB(B0, 0, 0); PG8_LDB(B1, 0, 1); PG8_SCHED; PG8_LDA(At, 0, 0); PG8_STAGE(PG8_SA(1, 1), rA, a1 + hstep, voffA);
            if constexpr (HOOK) { if (hon) hook_issue(hk, hit, lane, lds + HK_LDS_OFF + wid * 2048); }
            if (relax) PG8_WAIT_VI(8 + EPI_NS); else if (hon) PG8_WAIT_V(10); else PG8_WAIT_V(8);
            PG8_WAIT_L(0); PG8_BAR; PG8_MMA(0, 0, At, B0); PG8_MMA(0, 1, At, B1); PG8_BAR; PG8_SCHED;
            PG8_LDA(At, 0, 1); PG8_STAGE(PG8_SB(0, 0), rB, b2, voffB); PG8_STAGE(PG8_SB(0, 1), rB, b2 + hstep, voffB); PG8_STAGE(PG8_SA(0, 0), rA, a2, voffA);
            if (relax) PG8_WAIT_VI(8 + EPI_NS); else if (hon) PG8_WAIT_V(10); else PG8_WAIT_V(8);
            PG8_WAIT_L(0); PG8_BAR; PG8_MMA(1, 0, At, B0); PG8_MMA(1, 1, At, B1); PG8_BAR; PG8_SCHED;
            PG8_LDB(B0, 1, 0); PG8_LDB(B1, 1, 1); PG8_SCHED; PG8_LDA(At, 1, 0); PG8_STAGE(PG8_SA(0, 1), rA, a2 + hstep, voffA);
            if (hon) PG8_WAIT_V(10); else PG8_WAIT_V(8);
            PG8_WAIT_L(0); PG8_BAR; PG8_MMA(0, 0, At, B0); PG8_MMA(0, 1, At, B1); PG8_BAR; PG8_SCHED;
            PG8_LDA(At, 1, 1); PG8_STAGE(PG8_SB(1, 0), rB, b3, voffB); PG8_STAGE(PG8_SB(1, 1), rB, b3 + hstep, voffB); PG8_STAGE(PG8_SA(1, 0), rA, a3, voffA);
            PG8_WAIT_V(8); if constexpr (HOOK) { if (hon) { const PG8_LAS unsigned char* sl_ = lds + HK_LDS_OFF + wid * 2048; const f32x4 ha_ = *(const PG8_LAS f32x4*)(sl_ + lane * 16), hb_ = *(const PG8_LAS f32x4*)(sl_ + 1024 + lane * 16); hook_store(hk, hit, lane, ha_, hb_); ++hit; } }
            PG8_WAIT_L(0); PG8_BAR; PG8_MMA(1, 0, At, B0); PG8_MMA(1, 1, At, B1); PG8_BAR; PG8_SCHED;
            } else {
            PG8_LDB(B0, 0, 0); PG8_SCHED; PG8_LDA(At, 0, 0); PG8_STAGE(PG8_SA(1, 1), rA, a1 + hstep, voffA);
            PG8_WAIT_L(8); PG8_BAR; PG8_WAIT_L(0); PG8_MMA(0, 0, At, B0); PG8_BAR; PG8_SCHED;
            PG8_LDB(B1, 0, 1); PG8_STAGE(PG8_SB(0, 0), rB, b2, voffB);
            PG8_BAR; PG8_WAIT_L(0); PG8_MMA(0, 1, At, B1); PG8_BAR;
            PG8_LDA(At, 0, 1); PG8_STAGE(PG8_SA(0, 0), rA, a2, voffA);
            PG8_BAR; PG8_WAIT_L(0); PG8_MMA(1, 0, At, B0); PG8_BAR; PG8_SCHED;
            PG8_STAGE(PG8_SB(0, 1), rB, b2 + hstep, voffB);
            PG8_WAIT_V(6); PG8_BAR; PG8_MMA(1, 1, At, B1); PG8_BAR;
            PG8_LDB(B0, 1, 0); PG8_SCHED; PG8_LDA(At, 1, 0); PG8_STAGE(PG8_SA(0, 1), rA, a2 + hstep, voffA);
            PG8_WAIT_L(8); PG8_BAR; PG8_WAIT_L(0); PG8_MMA(0, 0, At, B0); PG8_BAR; PG8_SCHED;
            PG8_LDB(B1, 1, 1); PG8_STAGE(PG8_SB(1, 0), rB, b3, voffB);
            PG8_BAR; PG8_WAIT_L(0); PG8_MMA(0, 1, At, B1); PG8_BAR;
            PG8_LDA(At, 1, 1); PG8_STAGE(PG8_SA(1, 0), rA, a3, voffA);
            PG8_BAR; PG8_WAIT_L(0); PG8_MMA(1, 0, At, B0); PG8_BAR; PG8_SCHED;
            PG8_STAGE(PG8_SB(1, 1), rB, b3 + hstep, voffB);
            PG8_WAIT_V(6); PG8_BAR; PG8_MMA(1, 1, At, B1); PG8_BAR;
            }
        }
        asm volatile("s_nop 7\n\ts_nop 7\n\ts_nop 7" ::: "memory");
        if constexpr (FP8 == 2) {
#pragma unroll
            for (int a = 0; a < 2; ++a)
#pragma unroll
                for (int b = 0; b < 2; ++b)
#pragma unroll
                    for (int m = 0; m < 4; ++m)
#pragma unroll
                        for (int n = 0; n < 2; ++n) { const v4i32 q_ = __builtin_bit_cast(v4i32, acc[a][b][m][n]); acc[a][b][m][n] = (f32x4){(float)q_[0], (float)q_[1], (float)q_[2], (float)q_[3]}; } }
        if constexpr (ALIGN_EPI) { if (wr == 0) PG8_BAR; }
        if constexpr (!Epi::AFTER_DRAIN) { E(acc, cur, wr, wc, fr, fq); S.done(cur); }
        if (!has_next) break;
#pragma unroll
        for (int a = 0; a < 2; ++a)
#pragma unroll
            for (int b = 0; b < 2; ++b)
#pragma unroll
                for (int m = 0; m < 4; ++m)
#pragma unroll
                    for (int n = 0; n < 2; ++n) acc[a][b][m][n] = (f32x4){0.f, 0.f, 0.f, 0.f};
        cur = nxt; cA = nA; cB = nB; ++ui;
        if constexpr (ALIGN_EPI) { if (wr == 1) PG8_BAR; }
    }
    PG8_WAIT_V(0);
    if constexpr (!ALIGN_EPI) { if (wr == 0) PG8_BAR; }
    PG8_BAR;
    if constexpr (Epi::AFTER_DRAIN) { E.fused(acc, cur, wr, wc, fr, fq, lds, wid, lane); S.done(cur); }
    PG8_HOOK_REST;
#undef PG8_HOOK_REST
#undef PG8_SA
#undef PG8_SB
#undef PG8_STAGE
#undef PG8_LDA
#undef PG8_LDB
#undef PG8_MMA
#undef PG8_WAIT_V
#undef PG8_WAIT_L
#undef PG8_BAR
#undef PG8_SCHED
}
}
namespace moba {
typedef unsigned short bf16;
constexpr int   D = 128, NW = 8, QBLK = 32, KVBLK = 64;
constexpr float SCALE = 0.088388347648318440f;
constexpr float THR = 8.f;
constexpr int SDEPTH = 1;
#ifndef GEMM2_FUSED
#define GEMM2_FUSED 1
#endif
constexpr int LDQ = 20480, LDK = 20480, LDO = GEMM2_FUSED ? 4096 + 128 : 2048 + 128;
constexpr size_t SHM_V = KVBLK * D * 2, SHM_K = KVBLK * D * 2, SHM_ATTN = 2 * SHM_V + 2 * SHM_K + NW * 64 * 4;
constexpr float NEG = -1e30f;
constexpr float OSCALE = 64.0f;
using bf16x8 = __attribute__((ext_vector_type(8))) short;
using s16x4  = __attribute__((ext_vector_type(4))) short;
using f32x16 = __attribute__((ext_vector_type(16))) float;
using f32x8  = __attribute__((ext_vector_type(8))) float;
using u32x4  = __attribute__((ext_vector_type(4))) unsigned;
#define KSWZ(row, colB) ((row) * 256 + ((colB) ^ (((row) & 7) << 4)))
#define SBAR() __builtin_amdgcn_sched_barrier(0)
__device__ __forceinline__ int crow(int r, int hi) { return (r & 3) + 8 * (r >> 2) + 4 * hi; }
__device__ __forceinline__ unsigned cvtpk(float lo, float hi) {
  unsigned r; asm volatile("v_cvt_pk_bf16_f32 %0, %1, %2" : "=v"(r) : "v"(lo), "v"(hi)); return r;
}
template <typename TIn> struct Stage;
template <> struct Stage<bf16>  { using T = bf16x8;
  __device__ static __forceinline__ T ld8(const bf16* p) { return *reinterpret_cast<const bf16x8*>(p); }
  __device__ static __forceinline__ bf16x8 tobf(T x) { return x; } };

__device__ __forceinline__ void partialSM(f32x16& p0, f32x16& p1, float& m_reg, float& mn, float& alpha) {
  constexpr float C = SCALE * 1.4426950408889634f;
  float pmax = p0[0]; for (int r = 1; r < 16; ++r) pmax = fmaxf(pmax, p0[r]); for (int r = 0; r < 16; ++r) pmax = fmaxf(pmax, p1[r]);
  { auto rr = __builtin_amdgcn_permlane32_swap(__float_as_uint(pmax), __float_as_uint(pmax), false, false);
    pmax = fmaxf(__uint_as_float(rr[0]), __uint_as_float(rr[1])); }
  if (__builtin_expect(__all(pmax - m_reg <= THR / SCALE), 1)) { mn = m_reg; alpha = 1.f; }
  else { mn = fmaxf(m_reg, pmax); alpha = __builtin_amdgcn_exp2f((m_reg - mn) * C); m_reg = mn; }
  float mnC = -mn * C;
  for (int r = 0; r < 16; ++r) p0[r] = fmaf(p0[r], C, mnC); for (int r = 0; r < 16; ++r) p1[r] = fmaf(p1[r], C, mnC);
  for (int r = 0; r < 16; ++r) p0[r] = __builtin_amdgcn_exp2f(p0[r]);
}
__device__ __forceinline__ void finishSM(f32x16& p0, f32x16& p1, float alpha, float& l_reg, bf16x8& pa0, bf16x8& pa1, bf16x8& pa2, bf16x8& pa3) {
  for (int r = 0; r < 16; ++r) p1[r] = __builtin_amdgcn_exp2f(p1[r]);
  float ps = 0; for (int r = 0; r < 16; ++r) ps += p0[r]; for (int r = 0; r < 16; ++r) ps += p1[r];
  { auto rr = __builtin_amdgcn_permlane32_swap(__float_as_uint(ps), __float_as_uint(ps), false, false);
    ps = __uint_as_float(rr[0]) + __uint_as_float(rr[1]); }
  l_reg = l_reg * alpha + ps;
#define PK4(P, BASE, OUT) do { unsigned a0 = cvtpk(P[BASE + 0], P[BASE + 1]), a1 = cvtpk(P[BASE + 2], P[BASE + 3]);   \
    unsigned b0 = cvtpk(P[BASE + 4], P[BASE + 5]), b1 = cvtpk(P[BASE + 6], P[BASE + 7]);                              \
    auto r0 = __builtin_amdgcn_permlane32_swap(a0, b0, false, false); auto r1 = __builtin_amdgcn_permlane32_swap(a1, b1, false, false); \
    u32x4 w = {r0[0], r1[0], r0[1], r1[1]}; OUT = *reinterpret_cast<bf16x8*>(&w); } while (0)
  PK4(p0, 0, pa0); PK4(p0, 8, pa1); PK4(p1, 0, pa2); PK4(p1, 8, pa3);
#undef PK4
}
__device__ __forceinline__ void qkt(f32x16& p0, f32x16& p1, const bf16* Ks, const bf16x8* qr, int r32, int hi) {
  p0 = f32x16{}; p1 = f32x16{};
  for (int d0 = 0; d0 < 8; ++d0) { int cb = (d0 * 16 + hi * 8) * 2;
    bf16x8 b0 = *reinterpret_cast<const bf16x8*>((const char*)Ks + KSWZ(r32, cb));
    bf16x8 b1 = *reinterpret_cast<const bf16x8*>((const char*)Ks + KSWZ(32 + r32, cb));
    p0 = __builtin_amdgcn_mfma_f32_32x32x16_bf16(b0, qr[d0], p0, 0, 0, 0);
    p1 = __builtin_amdgcn_mfma_f32_32x32x16_bf16(b1, qr[d0], p1, 0, 0, 0); }
}
__device__ __forceinline__ int v_st(int k, int c) { const int kk = (k & ~0xC) | ((k & 4) << 1) | ((k & 8) >> 1); return ((kk >> 3) * 4 + (c >> 5)) * 512 + ((kk & 7) * 32 + (c & 31)) * 2; }
__device__ __forceinline__ int v_rd_base(int lane) { return ((lane & 3) << 3) | (((lane >> 2) & 3) << 6) | (((lane >> 4) & 1) << 5) | (((lane >> 5) & 1) << 8); }
constexpr int v_rd_off(int d0, int ks, int half) { return d0 * 512 + ks * 4096 + half * 2048; }
template <int OFF> __device__ __forceinline__ s16x4 tr_read(int vb) {
  s16x4 r; asm volatile("ds_read_b64_tr_b16 %0, %1 offset:%2" : "=&v"(r) : "v"(vb), "i"(OFF) : "memory"); return r;
}
template <int D0> __device__ __forceinline__ void pv_one(f32x16& od, int vb, bf16x8 pa0, bf16x8 pa1, bf16x8 pa2, bf16x8 pa3) {
  const s16x4 l0 = tr_read<v_rd_off(D0, 0, 0)>(vb), h0 = tr_read<v_rd_off(D0, 0, 1)>(vb), l1 = tr_read<v_rd_off(D0, 1, 0)>(vb), h1 = tr_read<v_rd_off(D0, 1, 1)>(vb);
  const s16x4 l2 = tr_read<v_rd_off(D0, 2, 0)>(vb), h2 = tr_read<v_rd_off(D0, 2, 1)>(vb), l3 = tr_read<v_rd_off(D0, 3, 0)>(vb), h3 = tr_read<v_rd_off(D0, 3, 1)>(vb);
  asm volatile("s_waitcnt lgkmcnt(0)" ::: "memory"); SBAR();
#define PK(L, H) (bf16x8){L[0], L[1], L[2], L[3], H[0], H[1], H[2], H[3]}
  od = __builtin_amdgcn_mfma_f32_32x32x16_bf16(pa0, PK(l0, h0), od, 0, 0, 0);
  od = __builtin_amdgcn_mfma_f32_32x32x16_bf16(pa1, PK(l1, h1), od, 0, 0, 0);
  od = __builtin_amdgcn_mfma_f32_32x32x16_bf16(pa2, PK(l2, h2), od, 0, 0, 0);
  od = __builtin_amdgcn_mfma_f32_32x32x16_bf16(pa3, PK(l3, h3), od, 0, 0, 0);
#undef PK
}
__device__ __forceinline__ void pv_d0(f32x16* o, int vb, bf16x8 pa0, bf16x8 pa1, bf16x8 pa2, bf16x8 pa3) {
  pv_one<0>(o[0], vb, pa0, pa1, pa2, pa3); pv_one<1>(o[1], vb, pa0, pa1, pa2, pa3); pv_one<2>(o[2], vb, pa0, pa1, pa2, pa3); pv_one<3>(o[3], vb, pa0, pa1, pa2, pa3);
}


__device__ __forceinline__ float bf2f(short s) { return __uint_as_float(((unsigned)(unsigned short)s) << 16); }
__device__ __forceinline__ int koff(int j, int qb) { return (j < 4) ? qb * 256 + j * 64 : (j - 4) * 64; }
__device__ __forceinline__ void init_tile(f32x16& p0, f32x16& p1, int j, unsigned selmask, int rowi, int wid, int hi) {
  if (j < 4) {
    if (64 * j + 63 <= wid * 32) {
#pragma unroll
      for (int r = 0; r < 16; ++r) { p0[r] = 0.f; p1[r] = 0.f; }
    } else if (64 * j > wid * 32 + 31) {
#pragma unroll
      for (int r = 0; r < 16; ++r) { p0[r] = NEG; p1[r] = NEG; }
    } else {
      int tz = threadIdx.x; asm volatile("" : "+v"(tz));
      const int limh = (tz >> 6) * 32 + (tz & 31) - 4 * ((tz >> 5) & 1) - 64 * j; const float neg = NEG;
#define MOBA_MSK(P, R, CONST) asm volatile("v_cmp_gt_i32 vcc, %2, %1\n\tv_cndmask_b32 %0, 0, %3, vcc" : "=v"(P[R]) : "v"(limh), "n"(CONST), "v"(neg) : "vcc")
#define MOBA_MSK2(R) MOBA_MSK(p0, R, ((R) & 3) + 8 * ((R) >> 2)); MOBA_MSK(p1, R, 32 + ((R) & 3) + 8 * ((R) >> 2))
      MOBA_MSK2(0); MOBA_MSK2(1); MOBA_MSK2(2); MOBA_MSK2(3); MOBA_MSK2(4); MOBA_MSK2(5); MOBA_MSK2(6); MOBA_MSK2(7);
      MOBA_MSK2(8); MOBA_MSK2(9); MOBA_MSK2(10); MOBA_MSK2(11); MOBA_MSK2(12); MOBA_MSK2(13); MOBA_MSK2(14); MOBA_MSK2(15);
#undef MOBA_MSK2
#undef MOBA_MSK
    }
  } else {
    const float iv = ((selmask >> ((j - 4) >> 2)) & 1u) ? 0.f : NEG;
#pragma unroll
    for (int r = 0; r < 16; ++r) { p0[r] = iv; p1[r] = iv; }
  }
}
__device__ __forceinline__ void qktm(f32x16& p0, f32x16& p1, const bf16* Ks, const bf16x8* qr, int r32, int hi, int j, unsigned selmask, int rowi, int wid) {
  init_tile(p0, p1, j, selmask, rowi, wid, hi);
  for (int d0 = 0; d0 < 8; ++d0) { int cb = (d0 * 16 + hi * 8) * 2;
    bf16x8 b0 = *reinterpret_cast<const bf16x8*>((const char*)Ks + KSWZ(r32, cb));
    bf16x8 b1 = *reinterpret_cast<const bf16x8*>((const char*)Ks + KSWZ(32 + r32, cb));
    p0 = __builtin_amdgcn_mfma_f32_32x32x16_bf16(b0, qr[d0], p0, 0, 0, 0);
    p1 = __builtin_amdgcn_mfma_f32_32x32x16_bf16(b1, qr[d0], p1, 0, 0, 0); }
}

__device__ __forceinline__ void moba_body(const bf16* __restrict__ Qb, const bf16* __restrict__ Kh, const bf16* __restrict__ Vh, const float* __restrict__ km,
                                          unsigned char* __restrict__ Ob, int qb, char* lds) {
  using St = Stage<bf16>;
  int tid = threadIdx.x; asm volatile("" : "+v"(tid));
  const int wid = tid >> 6, lane = tid & 63, r32 = lane & 31, hi = lane >> 5;
  bf16* V_lds = (bf16*)lds; bf16* K_lds = (bf16*)(lds + 2 * SHM_V);
  float* ws = (float*)(lds + 2 * SHM_V + 2 * SHM_K) + wid * 64; float* li_l = ws; float* al_l = ws + 32;
  float m_reg = -1e30f, l_reg = 0; f32x16 o[4] = {}; bf16x8 qr[8];
  __syncthreads();
  float* kml = (float*)(lds + SHM_ATTN);
  if (tid < 224) *reinterpret_cast<float4*>(kml + tid * 4) = *reinterpret_cast<const float4*>(km + tid * 4);
  const bf16* Qw = Qb + (long)(wid * QBLK + r32) * LDQ + hi * 8;
#pragma unroll
  for (int d0 = 0; d0 < 8; ++d0) qr[d0] = St::ld8(Qw + d0 * 16);
  {
    const int sr0 = tid >> 4, sc0 = (tid & 15) * 8, k00 = koff(0, qb);
    const typename St::T tv0 = St::ld8(&Vh[(long)(k00 + sr0) * LDK + sc0]), tv1 = St::ld8(&Vh[(long)(k00 + 32 + sr0) * LDK + sc0]);
    const typename St::T tk0 = St::ld8(&Kh[(long)(k00 + sr0) * LDK + sc0]), tk1 = St::ld8(&Kh[(long)(k00 + 32 + sr0) * LDK + sc0]);
    asm volatile("s_waitcnt vmcnt(0)" ::: "memory");
    *(bf16x8*)((char*)V_lds + v_st(sr0, sc0)) = St::tobf(tv0); *(bf16x8*)((char*)V_lds + v_st(32 + sr0, sc0)) = St::tobf(tv1);
    *(bf16x8*)((char*)K_lds + KSWZ(sr0, sc0 * 2)) = St::tobf(tk0); *(bf16x8*)((char*)K_lds + KSWZ(32 + sr0, sc0 * 2)) = St::tobf(tk1); }
  __syncthreads();
  asm volatile("" : "+v"(tid));
  unsigned selmask = 0u;
  {
    float g[7];
#pragma unroll
    for (int n = 0; n < 7; ++n) {
      float s = 0.f;
      if (n < qb) {
        const float* kp = kml + n * 128 + hi * 8;
#pragma unroll
        for (int d0 = 0; d0 < 8; ++d0) {
          const float4 k0 = *reinterpret_cast<const float4*>(kp + d0 * 16), k1 = *reinterpret_cast<const float4*>(kp + d0 * 16 + 4);
          s += bf2f(qr[d0][0]) * k0.x + bf2f(qr[d0][1]) * k0.y + bf2f(qr[d0][2]) * k0.z + bf2f(qr[d0][3]) * k0.w
             + bf2f(qr[d0][4]) * k1.x + bf2f(qr[d0][5]) * k1.y + bf2f(qr[d0][6]) * k1.z + bf2f(qr[d0][7]) * k1.w;
        }
        s += __shfl_xor(s, 32);
      }
      g[n] = (n < qb) ? s : -INFINITY;
    }
#pragma unroll
    for (int n = 0; n < 7; ++n) {
      int rank = 0;
#pragma unroll
      for (int m = 0; m < 7; ++m) if (m != n) rank += (g[m] > g[n] || (g[m] == g[n] && m < n)) ? 1 : 0;
      if (n < qb && rank < 3) selmask |= (1u << n);
    }
  }
  const int rowi = wid * QBLK + r32;
  const int sr = tid >> 4, sc = (tid & 15) * 8, vst0 = v_st(sr, sc), vst1 = v_st(32 + sr, sc);
  const int vb0 = (int)(uintptr_t)V_lds + v_rd_base(lane);
  struct { typename St::T vs0, vs1, ks0, ks1; } sr_[SDEPTH];
#define SLOAD(i, k0) do { sr_[i].vs0 = St::ld8(&Vh[(long)((k0) + sr) * LDK + sc]); sr_[i].vs1 = St::ld8(&Vh[(long)((k0) + 32 + sr) * LDK + sc]); \
    sr_[i].ks0 = St::ld8(&Kh[(long)((k0) + sr) * LDK + sc]); sr_[i].ks1 = St::ld8(&Kh[(long)((k0) + 32 + sr) * LDK + sc]); } while (0)
#define SWRITE(b, i) do { *(bf16x8*)((char*)V_lds + (b) * SHM_V + vst0) = St::tobf(sr_[i].vs0);          \
    *(bf16x8*)((char*)V_lds + (b) * SHM_V + vst1) = St::tobf(sr_[i].vs1); int kc = sc * 2;               \
    *(bf16x8*)((char*)K_lds + (b) * SHM_K + KSWZ(sr, kc)) = St::tobf(sr_[i].ks0);                       \
    *(bf16x8*)((char*)K_lds + (b) * SHM_K + KSWZ(32 + sr, kc)) = St::tobf(sr_[i].ks1); } while (0)
#define SWAIT() do { if constexpr (SDEPTH == 2) asm volatile("s_waitcnt vmcnt(4)" ::: "memory"); else asm volatile("s_waitcnt vmcnt(0)" ::: "memory"); } while (0)
#define RESC(a) do { if (__any((a) < 1.f)) { if (hi == 0) al_l[r32] = (a); asm volatile("s_waitcnt lgkmcnt(0)" ::: "memory"); \
    for (int d = 0; d < 4; ++d) for (int r = 0; r < 16; ++r) o[d][r] *= al_l[crow(r, hi)]; } } while (0)
  f32x16 pA0, pA1, pB0, pB1; float mnA, mnB, alA, alB; bf16x8 pa0, pa1, pa2, pa3; const int NT = 4 * (qb + 1);
  constexpr int SE = 0, SO = SDEPTH - 1;
  static_assert(SDEPTH == 1, "prologue order"); SLOAD(SO, koff(1, qb));
  qktm(pA0, pA1, K_lds, qr, r32, hi, 0, selmask, rowi, wid); partialSM(pA0, pA1, m_reg, mnA, alA);
  SWAIT(); SWRITE(1, SO); __syncthreads();
  for (int j = 1; j + 1 < NT; j += 2) {
    SBAR(); qktm(pB0, pB1, (bf16*)((char*)K_lds + SHM_K), qr, r32, hi, j, selmask, rowi, wid);
    finishSM(pA0, pA1, alA, l_reg, pa0, pa1, pa2, pa3); SBAR();
    SLOAD(SO, koff(j + SDEPTH, qb)); SBAR();
    pv_d0(o, vb0, pa0, pa1, pa2, pa3); partialSM(pB0, pB1, m_reg, mnB, alB);
    __syncthreads(); SWAIT(); SWRITE(0, SE);
    RESC(alB); __syncthreads();
    SBAR(); qktm(pA0, pA1, K_lds, qr, r32, hi, j + 1, selmask, rowi, wid);
    finishSM(pB0, pB1, alB, l_reg, pa0, pa1, pa2, pa3); SBAR();
    if (SDEPTH == 1 || j + 3 < NT) SLOAD(SE, koff(j + 1 + SDEPTH, qb)); SBAR();
    pv_d0(o, vb0 + (int)SHM_V, pa0, pa1, pa2, pa3); partialSM(pA0, pA1, m_reg, mnA, alA);
    __syncthreads(); SWAIT(); SWRITE(1, SO);
    RESC(alA); __syncthreads();
  }
  SBAR(); qktm(pB0, pB1, (bf16*)((char*)K_lds + SHM_K), qr, r32, hi, NT - 1, selmask, rowi, wid);
  finishSM(pA0, pA1, alA, l_reg, pa0, pa1, pa2, pa3); SBAR();
  pv_d0(o, vb0, pa0, pa1, pa2, pa3); partialSM(pB0, pB1, m_reg, mnB, alB);
  __syncthreads(); RESC(alB);
  finishSM(pB0, pB1, alB, l_reg, pa0, pa1, pa2, pa3); SBAR();
  pv_d0(o, vb0 + (int)SHM_V, pa0, pa1, pa2, pa3);
  if (hi == 0) li_l[r32] = l_reg; asm volatile("s_waitcnt lgkmcnt(0)" ::: "memory");
  float rli[16];
#pragma unroll
  for (int r = 0; r < 16; ++r) rli[r] = __builtin_amdgcn_rcpf(li_l[crow(r, hi)]);
  unsigned char* Ow = Ob + (long)(wid * QBLK) * LDO;
#pragma unroll
  for (int r = 0; r < 16; ++r) { int orow = crow(r, hi);
    for (int d0 = 0; d0 < 4; ++d0) { const float v = o[d0][r] * rli[r] * OSCALE; const int q8 = __builtin_amdgcn_cvt_pk_fp8_f32(v, v, 0, false); Ow[(long)orow * LDO + d0 * 32 + r32] = (unsigned char)(q8 & 0xff); } }
#undef SLOAD
#undef SWRITE
#undef SWAIT
#undef RESC
}
#undef KSWZ
#undef SBAR
}
constexpr int NWAVES = 8;
constexpr int T_ = 8192, DM = 4096, INC = 20480, CD = 2048, AD = 2048, NH = 16, HD = 128, SEQ = 2048, NBATCH = 4, NBLK = 8;
constexpr int PH = 8, NKEYS = 128, NEXP = 16384, PTOPK = 16, NSEL = PH * PTOPK;
constexpr float EPS = 1e-6f;
enum { I_X = 0, I_NMIX, I_WIN, I_BGATE, I_CONVW, I_WCO, I_WAO, I_WO, I_NFFN, I_WPQ, I_SUBK, I_UEMB, I_VEMB, I_NFIN, N_IN };
#ifndef ALL_LOWP_GEMM1
#define ALL_LOWP_GEMM1 1
#endif
constexpr int Z8_COL0 = ALL_LOWP_GEMM1 ? 0 : 6144;
#ifndef PROJ_INT8
#define PROJ_INT8 1
#endif
constexpr float HN8_SCALE = PROJ_INT8 ? 32.0f : 16.0f, WIN8_SCALE = PROJ_INT8 ? 2048.0f : 1024.0f, ATT8_SCALE = 64.0f, WAO8_SCALE = 512.0f, MRG8_SCALE = 32.0f, WO8_SCALE = PROJ_INT8 ? 2048.0f : 1024.0f;
#ifndef SCORES_INT8
#define SCORES_INT8 1
#endif
#ifndef CONVOUT_INT8
#define CONVOUT_INT8 0
#endif
#ifndef CONVOUT_FP8
#define CONVOUT_FP8 1
#endif
#ifndef DEFER_FFN_NORM
#define DEFER_FFN_NORM 1
#endif
constexpr int HQ_SCALE = 24;
constexpr float XN8_SCALE = DEFER_FFN_NORM ? (float)HQ_SCALE : 32.0f, WPQ8_SCALE = 2048.0f, BZ8_SCALE = CONVOUT_FP8 ? 4.0f : 8.0f, WCO8_SCALE = CONVOUT_FP8 ? 2048.0f : 1024.0f;
#ifndef UV_IN_GEMM1
#define UV_IN_GEMM1 1
#endif
constexpr int LOWP = PROJ_INT8 ? 2 : 1;
constexpr int ZC_B = 0, ZC_C = 2048, ZC_U = 4096, ZC_Q = 6144, ZC_K = 8192, ZC_V = 10240, ZC_GC = 12288, ZC_GA = 16384;

constexpr size_t MiB = 1u << 20;
#ifndef GEMM3_FP8
#define GEMM3_FP8 1
#endif
constexpr int LDP = DM + 64;
constexpr int LDP8 = (DM + 128) / 2;
constexpr int LDH = CD + 64;
constexpr int LDH8 = (AD + 128) / 2;
constexpr size_t WS_CTL = 0, CTL_ZERO_BYTES = 1 * MiB;
constexpr size_t WS_KMEAN = 1 * MiB;
constexpr size_t WS_WINT = 2 * MiB;
constexpr size_t WS_WIN8 = (ALL_LOWP_GEMM1 ? 2 : 51) * MiB;
constexpr size_t WS_WIN8_OLD_ = 51 * MiB;
constexpr size_t WS_HN8  = 109 * MiB;
constexpr size_t WS_WAO8 = 142 * MiB;
constexpr size_t WS_WCOT = 151 * MiB;
constexpr size_t WS_WOT  = 168 * MiB;
constexpr size_t WS_WPQF = 201 * MiB;
constexpr size_t WS_HN   = 218 * MiB;
constexpr size_t WS_Z    = 283 * MiB;
constexpr size_t WS_BZ   = 603 * MiB;
constexpr size_t WS_ATT  = 636 * MiB;
constexpr size_t WS_MRG  = 653 * MiB;
constexpr size_t WS_HB   = WS_Z + 64 * MiB;
constexpr size_t WS_MRG8 = WS_HN;
constexpr size_t WS_XN   = 718 * MiB;
constexpr size_t WS_ST   = 783 * MiB;
constexpr size_t WS_EXP  = 847 * MiB;
constexpr size_t WS_GATE = 851 * MiB;
constexpr size_t WS_UB   = 855 * MiB;
constexpr size_t WS_VB   = 919 * MiB;
constexpr size_t WS_END  = 983 * MiB;
constexpr size_t WS_AC = WS_MRG, WS_WC = WS_WCOT;
static_assert((size_t)4096 * LDP8 * 2 <= 17 * MiB && (size_t)8192 * LDP8 * 2 <= 65 * MiB, "fused GEMM2 operands");
constexpr size_t WS_SSQP = WS_ATT, WS_RS = WS_ATT + 2 * MiB;
static_assert((size_t)20480 * LDP8 * 2 <= 107 * MiB && (size_t)6144 * LDP * 2 <= 49 * MiB && (size_t)14336 * LDP8 * 2 <= 58 * MiB && (size_t)8192 * LDP8 * 2 <= 33 * MiB && (size_t)4096 * LDH8 * 2 <= 9 * MiB && (size_t)4096 * LDH * 2 <= 17 * MiB, "ws map 1");
static_assert((size_t)4096 * LDP * 2 <= 33 * MiB && (size_t)2048 * LDP * 2 <= 17 * MiB && (size_t)8192 * LDP * 2 <= 65 * MiB && (size_t)8192 * LDH * 2 <= 33 * MiB && (size_t)8192 * LDH8 * 2 <= 17 * MiB, "ws map 2");
constexpr int CW_TMO = 0, CW_CODE = 1, CW_BAR = 4096;
constexpr int CW_SSQX = 131072;

constexpr int RING_OFF = 0, RING_BYTES = 131072;
constexpr int LDSCTL_OFF = RING_BYTES, MISC_OFF = LDSCTL_OFF + 320;
constexpr int LDS_BYTES = 147968;
static_assert(MISC_OFF + 128 <= pg8::HK_LDS_OFF && pg8::HK_LDS_OFF + 8 * 2048 <= LDS_BYTES && RING_OFF == 0, "LDS map");
static_assert(WS_VB - WS_UB == 64 * MiB, "TblHook: v table 64 MiB behind u");
#define GAS __attribute__((address_space(1)))
#define LAS __attribute__((address_space(3)))
typedef unsigned short bf16;
typedef unsigned v4u __attribute__((ext_vector_type(4)));
typedef float f32x4 __attribute__((ext_vector_type(4)));
typedef short bf16x8 __attribute__((ext_vector_type(8)));
typedef GAS unsigned gu32;
typedef GAS unsigned long long gu64;
#define RLX_AGENT __ATOMIC_RELAXED, __HIP_MEMORY_SCOPE_AGENT
#define LDS_WAIT() asm volatile("s_waitcnt lgkmcnt(0)" ::: "memory")
#define VM_WAIT() asm volatile("s_waitcnt vmcnt(0)" ::: "memory")
__device__ __forceinline__ unsigned long long rt() { return __builtin_amdgcn_s_memrealtime(); }
__device__ __forceinline__ unsigned f2bf(float f) { unsigned u = __builtin_bit_cast(unsigned, f); return (u + 0x7fffu + ((u >> 16) & 1u)) >> 16; }
__device__ __forceinline__ unsigned pk2(float lo, float hi) { return f2bf(lo) | (f2bf(hi) << 16); }
#define XB_TMO      128
#define XB_XCNT(j)  (256  + 64 * (j))
#define XB_XSUB(j)  (1280 + 64 * (j))
#define XB_XGEN(j)  (2304 + 64 * (j))
#define XB_TOP      3328
#define XB_TOPGEN   3392
#define XCD_BAR_WORDS 3456
#define XB_SPIN_CAP (1u << 18)

__device__ __forceinline__ unsigned xb_ld(unsigned* p)              { return __hip_atomic_load(p, __ATOMIC_RELAXED, __HIP_MEMORY_SCOPE_AGENT); }
__device__ __forceinline__ unsigned xb_add(unsigned* p, unsigned v) { return __hip_atomic_fetch_add(p, v, __ATOMIC_RELAXED, __HIP_MEMORY_SCOPE_AGENT); }
__device__ __forceinline__ unsigned xb_xcc_id() { return (unsigned)__builtin_amdgcn_s_getreg((3 << 11) | 20) & 0xFu; }
#define XB_SPIN(cond, bar) do { unsigned _sp = 0; while (cond) { __builtin_amdgcn_s_sleep(1); \
    if ((++_sp & 255u) == 0u) { if (xb_ld(&(bar)[XB_TMO])) break; if (_sp > XB_SPIN_CAP) { atomicAdd(&(bar)[XB_TMO], 1u); break; } } } } while (0)

struct XcdBarrier {
    unsigned* bar; unsigned x;
    volatile LAS unsigned* st;
};

__device__ __forceinline__ XcdBarrier xcd_barrier_post(unsigned* bar, volatile LAS unsigned* st) {
    XcdBarrier b; b.bar = bar; b.x = xb_xcc_id(); b.st = st;
    if (threadIdx.x == 0) (void)xb_add(&bar[XB_XCNT(b.x)], 1u);
    return b;
}
__device__ __forceinline__ void xcd_barrier_complete(unsigned* bar, unsigned x, unsigned& nloc, unsigned& nx) {
    const unsigned G = gridDim.x * gridDim.y * gridDim.z;
    unsigned sum, cnt, mine, sp = 0u;
    for (;;) {
        sum = 0u; cnt = 0u; mine = 0u;
#pragma unroll
        for (unsigned j = 0; j < 16; ++j) { const unsigned c = xb_ld(&bar[XB_XCNT(j)]); sum += c; cnt += (c > 0u) ? 1u : 0u; mine = (j == x) ? c : mine; }
        if (sum == G) break;
        __builtin_amdgcn_s_sleep(1);
        if ((++sp & 255u) == 0u) { if (xb_ld(&bar[XB_TMO])) break; if (sp > XB_SPIN_CAP) { atomicAdd(&bar[XB_TMO], 1u); break; } }
    }
    nloc = mine > 0u ? mine : 1u; nx = cnt > 0u ? cnt : 1u;
}

__device__ __forceinline__ void xcd_barrier(const XcdBarrier& b) {
    asm volatile("s_waitcnt vmcnt(0)" ::: "memory");
    __syncthreads();
    if (threadIdx.x == 0) {
        unsigned* bar = b.bar;
        __builtin_amdgcn_s_waitcnt(0);
        unsigned nloc = b.st[0], nx = b.st[1];
        if (nloc == 0u) { xcd_barrier_complete(bar, b.x, nloc, nx); b.st[0] = nloc; b.st[1] = nx; }
        const unsigned old = xb_add(&bar[XB_XSUB(b.x)], 1u);
        const unsigned gen = old / nloc;
        if (old + 1u == (gen + 1u) * nloc) {
            __builtin_amdgcn_fence(__ATOMIC_RELEASE, "agent");
            asm volatile("s_waitcnt vmcnt(0)" ::: "memory");
            const unsigned og = xb_add(&bar[XB_TOP], 1u);
            const unsigned tg = og / nx;
            if (og + 1u == (tg + 1u) * nx) xb_add(&bar[XB_TOPGEN], 1u);
            else XB_SPIN(xb_ld(&bar[XB_TOPGEN]) == tg, bar);
            __builtin_amdgcn_fence(__ATOMIC_ACQUIRE, "agent");
            xb_add(&bar[XB_XGEN(b.x)], 1u);
            asm volatile("s_waitcnt vmcnt(0)" ::: "memory");
        } else {
            XB_SPIN(xb_ld(&bar[XB_XGEN(b.x)]) == gen, bar);
            __builtin_amdgcn_fence(__ATOMIC_ACQUIRE, "agent");
            asm volatile("s_waitcnt vmcnt(0)" ::: "memory");
        }
    }
    __syncthreads();
}
typedef unsigned u32x2 __attribute__((ext_vector_type(2)));
typedef __bf16 bfx2 __attribute__((ext_vector_type(2)));
typedef float f32x2 __attribute__((ext_vector_type(2)));
constexpr float PEER_USCALE = 1024.0f, PEER_VSCALE = 16.0f, PEER_XSCALE = 16.0f;
__device__ __forceinline__ int q_i8(float v) { const int q = __float2int_rn(v); return q < -127 ? -127 : (q > 127 ? 127 : q); }
__device__ __forceinline__ int pk_i8(float a, float b, float c, float d) { return (int)((unsigned)(q_i8(a) & 0xff) | ((unsigned)(q_i8(b) & 0xff) << 8) | ((unsigned)(q_i8(c) & 0xff) << 16) | ((unsigned)(q_i8(d) & 0xff) << 24)); }
struct Frame {
    LAS unsigned char* lds;
    volatile LAS unsigned* MISC;
    gu32* ctl;
    int tid, lane, wave;
    int vcu, G;
    const float* in[N_IN]; float* out; unsigned char* ws;
};
__device__ __forceinline__ float wave_sum(float v) {
    v += __builtin_bit_cast(float, __builtin_amdgcn_update_dpp(0, __builtin_bit_cast(int, v), 0xB1, 0xf, 0xf, false));
    v += __builtin_bit_cast(float, __builtin_amdgcn_update_dpp(0, __builtin_bit_cast(int, v), 0x4E, 0xf, 0xf, false));
    v += __builtin_bit_cast(float, __builtin_amdgcn_update_dpp(0, __builtin_bit_cast(int, v), 0x141, 0xf, 0xf, false));
    v += __builtin_bit_cast(float, __builtin_amdgcn_update_dpp(0, __builtin_bit_cast(int, v), 0x140, 0xf, 0xf, false));
    { unsigned a_ = __builtin_bit_cast(unsigned, v), b_ = a_; asm volatile("" : "+v"(b_));
      const auto r = __builtin_amdgcn_permlane16_swap(a_, b_, false, false); const unsigned r0_ = r[0], r1_ = r[1]; v = __uint_as_float(r0_) + __uint_as_float(r1_); }
    { unsigned a_ = __builtin_bit_cast(unsigned, v), b_ = a_; asm volatile("" : "+v"(b_));
      const auto r = __builtin_amdgcn_permlane32_swap(a_, b_, false, false); const unsigned r0_ = r[0], r1_ = r[1]; v = __uint_as_float(r0_) + __uint_as_float(r1_); }
    return v;
}
__device__ __forceinline__ float bflo(unsigned w) { return __uint_as_float(w << 16); }
__device__ __forceinline__ float bfhi(unsigned w) { return __uint_as_float(w & 0xffff0000u); }
__device__ __forceinline__ void p0_transpose_item(const float* W, int K, int N, bf16* WT, int ldo, LAS float* scr, int item, int lane) {
    const int nblk = N / 32, kb = item / nblk, nb = item % nblk, k0 = 64 * kb, n0 = 32 * nb;
    { f32x4 v_[8];
#pragma unroll
      for (int i = 0; i < 8; ++i) v_[i] = *(const GAS f32x4*)(W + (size_t)(k0 + i * 8 + (lane >> 3)) * N + n0 + (lane & 7) * 4);
#pragma unroll
      for (int i = 0; i < 8; ++i) { LAS float* d_ = scr + (i * 8 + (lane >> 3)) * 33 + (lane & 7) * 4; d_[0] = v_[i].x; d_[1] = v_[i].y; d_[2] = v_[i].z; d_[3] = v_[i].w; } }
    LDS_WAIT(); asm volatile("" ::: "memory");
    const int c = lane & 7;
#pragma unroll
    for (int j = 0; j < 4; ++j) { const int n = (lane >> 3) + 8 * j; const LAS float* s = scr + (8 * c) * 33 + n;
        v4u o; o.x = pk2(s[0 * 33], s[1 * 33]); o.y = pk2(s[2 * 33], s[3 * 33]); o.z = pk2(s[4 * 33], s[5 * 33]); o.w = pk2(s[6 * 33], s[7 * 33]);
        *(GAS v4u*)(WT + (size_t)(n0 + n) * ldo + k0 + 8 * c) = o; }
    LDS_WAIT(); asm volatile("" ::: "memory");
}
__device__ __forceinline__ void p0_transpose_item_fp8(const float* W, int ldo8, int N, unsigned char* WT8, int ncol0, int nb, int kb, LAS float* scr, int lane, float sc) {
    const int k0 = 64 * kb, n0 = 32 * nb;
    { f32x4 v_[8];
#pragma unroll
      for (int i = 0; i < 8; ++i) v_[i] = *(const GAS f32x4*)(W + (size_t)(k0 + i * 8 + (lane >> 3)) * N + ncol0 + n0 + (lane & 7) * 4);
#pragma unroll
      for (int i = 0; i < 8; ++i) { LAS float* d_ = scr + (i * 8 + (lane >> 3)) * 33 + (lane & 7) * 4; d_[0] = v_[i].x; d_[1] = v_[i].y; d_[2] = v_[i].z; d_[3] = v_[i].w; } }
    LDS_WAIT(); asm volatile("" ::: "memory");
    const int c = lane & 3;
#pragma unroll
    for (int j = 0; j < 2; ++j) { const int n = (lane >> 2) + 16 * j; const LAS float* s = scr + (16 * c) * 33 + n; v4u o;
        int w0 = __builtin_amdgcn_cvt_pk_fp8_f32(s[0 * 33] * sc, s[1 * 33] * sc, 0, false); w0 = __builtin_amdgcn_cvt_pk_fp8_f32(s[2 * 33] * sc, s[3 * 33] * sc, w0, true);
        int w1 = __builtin_amdgcn_cvt_pk_fp8_f32(s[4 * 33] * sc, s[5 * 33] * sc, 0, false); w1 = __builtin_amdgcn_cvt_pk_fp8_f32(s[6 * 33] * sc, s[7 * 33] * sc, w1, true);
        int w2 = __builtin_amdgcn_cvt_pk_fp8_f32(s[8 * 33] * sc, s[9 * 33] * sc, 0, false); w2 = __builtin_amdgcn_cvt_pk_fp8_f32(s[10 * 33] * sc, s[11 * 33] * sc, w2, true);
        int w3 = __builtin_amdgcn_cvt_pk_fp8_f32(s[12 * 33] * sc, s[13 * 33] * sc, 0, false); w3 = __builtin_amdgcn_cvt_pk_fp8_f32(s[14 * 33] * sc, s[15 * 33] * sc, w3, true);
        o.x = (unsigned)w0; o.y = (unsigned)w1; o.z = (unsigned)w2; o.w = (unsigned)w3;
        *(GAS v4u*)(WT8 + (size_t)(n0 + n) * ldo8 + k0 + 16 * c) = o; }
    LDS_WAIT(); asm volatile("" ::: "memory");
}
__device__ __forceinline__ void rms_row_to_bf16(const float* xrow, const float* gain, bf16* orow, int lane, unsigned char* o8row = nullptr, float sc8 = 1.f) {
    const GAS f32x4* xr = (const GAS f32x4*)xrow + lane;
    f32x4 v[16]; float s = 0.f;
#pragma unroll
    for (int i = 0; i < 16; ++i) { v[i] = xr[64 * i]; s += (v[i].x * v[i].x + v[i].y * v[i].y) + (v[i].z * v[i].z + v[i].w * v[i].w); }
    const GAS f32x4* gr = (const GAS f32x4*)gain + lane;
    f32x4 gq[16];
#pragma unroll
    for (int i = 0; i < 16; ++i) gq[i] = gr[64 * i];
    const float rs = 1.0f / sqrtf(wave_sum(s) * (1.0f / DM) + EPS);
    asm volatile("" ::: "memory");
    GAS u32x2* o8 = (GAS u32x2*)orow + lane;
#pragma unroll
    for (int i = 0; i < 16; ++i) { const f32x4 g = gq[i]; const float y0 = v[i].x * rs * g.x, y1 = v[i].y * rs * g.y, y2 = v[i].z * rs * g.z, y3 = v[i].w * rs * g.w;
        if (orow) { u32x2 w; w.x = pk2(y0, y1); w.y = pk2(y2, y3); o8[64 * i] = w; }
        if (o8row) { int q; if (PROJ_INT8) q = pk_i8(y0 * sc8, y1 * sc8, y2 * sc8, y3 * sc8); else { q = __builtin_amdgcn_cvt_pk_fp8_f32(y0 * sc8, y1 * sc8, 0, false); q = __builtin_amdgcn_cvt_pk_fp8_f32(y2 * sc8, y3 * sc8, q, true); } ((GAS unsigned*)o8row)[64 * i + lane] = (unsigned)q; } }
}
__device__ __forceinline__ bf16x8 cvt8(const float* p) {
    const f32x4 a = *(const GAS f32x4*)p, b = *(const GAS f32x4*)(p + 4);
    v4u w; w.x = pk2(a.x, a.y); w.y = pk2(a.z, a.w); w.z = pk2(b.x, b.y); w.w = pk2(b.z, b.w);
    return __builtin_bit_cast(bf16x8, w);
}
__device__ __forceinline__ void p0_prologue(Frame& F) {
    LAS float* scr = (LAS float*)(F.lds + RING_OFF + F.wave * 16384);
    const int gw = F.vcu * NWAVES + F.wave, NGW = F.G * NWAVES;
    bf16* WINT = (bf16*)(F.ws + WS_WINT); bf16* WCOT = (bf16*)(F.ws + WS_WCOT);
    constexpr int I_1 = (DM / 64) * (INC / 32), I_2 = (CD / 64) * (DM / 32), I_3 = (AD / 64) * (DM / 32), I_4 = (DM / 64) * (DM / 32);
    constexpr int NITEMS = I_1 + I_2 + I_3 + I_4;
    struct TItem { const float* src; unsigned char* dst; int N, ldo, fp8; float sc; };
#define P0_KB(r, NB) (2 * (((r) >> 1) / (NB)) + ((r) & 1))
#define P0_NB(r, NB) (((r) >> 1) % (NB))
    auto decode = [&](int it) { TItem t; int r = it;
        if (r < I_1) { const int kb = P0_KB(r, INC / 32), nb = P0_NB(r, INC / 32); t.src = F.in[I_WIN] + (size_t)(64 * kb) * INC + 32 * nb; t.N = INC;
            if (nb < Z8_COL0 / 32) { t.fp8 = 0; t.ldo = 2 * LDP; t.dst = (unsigned char*)WINT + (size_t)(32 * nb) * (2 * LDP) + 2 * 64 * kb; t.sc = 1.f; }
            else { t.fp8 = LOWP; t.ldo = 2 * LDP8; t.dst = (unsigned char*)(F.ws + WS_WIN8) + (size_t)(32 * nb - Z8_COL0) * (2 * LDP8) + 64 * kb; t.sc = WIN8_SCALE; }
            return t; } r -= I_1;
        if (r < I_2) { const int kb = P0_KB(r, DM / 32), nb = P0_NB(r, DM / 32); t.src = F.in[I_WCO] + (size_t)(64 * kb) * DM + 32 * nb; t.N = DM;
            if (GEMM2_FUSED) { t.fp8 = 1; t.ldo = 2 * LDP8; t.dst = (unsigned char*)(F.ws + WS_WC) + (size_t)(32 * nb) * (2 * LDP8) + 64 * kb; t.sc = WCO8_SCALE; }
            else if (CONVOUT_INT8 || CONVOUT_FP8) { t.fp8 = CONVOUT_FP8 ? 1 : 2; t.ldo = 2 * LDH8; t.dst = (unsigned char*)WCOT + (size_t)(32 * nb) * (2 * LDH8) + 64 * kb; t.sc = WCO8_SCALE; }
            else { t.fp8 = 0; t.ldo = 2 * LDH; t.dst = (unsigned char*)WCOT + (size_t)(32 * nb) * (2 * LDH) + 2 * 64 * kb; t.sc = 1.f; }
            return t; } r -= I_2;
        if (r < I_3) { const int kb = P0_KB(r, DM / 32), nb = P0_NB(r, DM / 32); t.src = F.in[I_WAO] + (size_t)(64 * kb) * DM + 32 * nb; t.N = DM; t.fp8 = 1; t.sc = WAO8_SCALE;
            if (GEMM2_FUSED) { t.ldo = 2 * LDP8; t.dst = (unsigned char*)(F.ws + WS_WC) + (size_t)(32 * nb) * (2 * LDP8) + 2048 + 64 * kb; }
            else { t.ldo = 2 * LDH8; t.dst = (unsigned char*)(F.ws + WS_WAO8) + (size_t)(32 * nb) * (2 * LDH8) + 64 * kb; }
            return t; } r -= I_3;
        { const int kb = P0_KB(r, DM / 32), nb = P0_NB(r, DM / 32); t.src = F.in[I_WO] + (size_t)(64 * kb) * DM + 32 * nb; t.N = DM;
          if (GEMM3_FP8) { t.fp8 = LOWP; t.ldo = 2 * LDP8; t.dst = (unsigned char*)(F.ws + WS_WOT) + (size_t)(32 * nb) * (2 * LDP8) + 64 * kb; t.sc = WO8_SCALE; }
          else { t.fp8 = 0; t.ldo = 2 * LDP; t.dst = (unsigned char*)(F.ws + WS_WOT) + (size_t)(32 * nb) * (2 * LDP) + 2 * 64 * kb; t.sc = 1.f; } }
        return t; };
#define P0_LOAD(T, V) do { _Pragma("unroll") for (int i = 0; i < 8; ++i) V[i] = *(const GAS f32x4*)(T.src + (size_t)(i * 8 + (F.lane >> 3)) * T.N + (F.lane & 7) * 4); } while (0)
#define P0_PROC(T, V) do { _Pragma("unroll") for (int i = 0; i < 8; ++i) { LAS float* d_ = scr + (i * 8 + (F.lane >> 3)) * 33 + (F.lane & 7) * 4; d_[0] = V[i].x; d_[1] = V[i].y; d_[2] = V[i].z; d_[3] = V[i].w; } \
        LDS_WAIT(); asm volatile("" ::: "memory"); \
        if (T.fp8) { const int c = F.lane & 3; const float sc = T.sc; \
            _Pragma("unroll") for (int j = 0; j < 2; ++j) { const int n = (F.lane >> 2) + 16 * j; const LAS float* s = scr + (16 * c) * 33 + n; v4u o; \
                int w0, w1, w2, w3; \
                if (T.fp8 == 2) { w0 = pk_i8(s[0 * 33] * sc, s[1 * 33] * sc, s[2 * 33] * sc, s[3 * 33] * sc); w1 = pk_i8(s[4 * 33] * sc, s[5 * 33] * sc, s[6 * 33] * sc, s[7 * 33] * sc); w2 = pk_i8(s[8 * 33] * sc, s[9 * 33] * sc, s[10 * 33] * sc, s[11 * 33] * sc); w3 = pk_i8(s[12 * 33] * sc, s[13 * 33] * sc, s[14 * 33] * sc, s[15 * 33] * sc); } \
                else { w0 = __builtin_amdgcn_cvt_pk_fp8_f32(s[0 * 33] * sc, s[1 * 33] * sc, 0, false); w0 = __builtin_amdgcn_cvt_pk_fp8_f32(s[2 * 33] * sc, s[3 * 33] * sc, w0, true); \
                w1 = __builtin_amdgcn_cvt_pk_fp8_f32(s[4 * 33] * sc, s[5 * 33] * sc, 0, false); w1 = __builtin_amdgcn_cvt_pk_fp8_f32(s[6 * 33] * sc, s[7 * 33] * sc, w1, true); \
                w2 = __builtin_amdgcn_cvt_pk_fp8_f32(s[8 * 33] * sc, s[9 * 33] * sc, 0, false); w2 = __builtin_amdgcn_cvt_pk_fp8_f32(s[10 * 33] * sc, s[11 * 33] * sc, w2, true); \
                w3 = __builtin_amdgcn_cvt_pk_fp8_f32(s[12 * 33] * sc, s[13 * 33] * sc, 0, false); w3 = __builtin_amdgcn_cvt_pk_fp8_f32(s[14 * 33] * sc, s[15 * 33] * sc, w3, true); } \
                o.x = (unsigned)w0; o.y = (unsigned)w1; o.z = (unsigned)w2; o.w = (unsigned)w3; *(GAS v4u*)(T.dst + (size_t)n * T.ldo + 16 * c) = o; } } \
        else { const int c = F.lane & 7; \
            _Pragma("unroll") for (int j = 0; j < 4; ++j) { const int n = (F.lane >> 3) + 8 * j; const LAS float* s = scr + (8 * c) * 33 + n; v4u o; \
                o.x = pk2(s[0 * 33], s[1 * 33]); o.y = pk2(s[2 * 33], s[3 * 33]); o.z = pk2(s[4 * 33], s[5 * 33]); o.w = pk2(s[6 * 33], s[7 * 33]); *(GAS v4u*)(T.dst + (size_t)n * T.ldo + 16 * c) = o; } } \
        LDS_WAIT(); asm volatile("" ::: "memory"); } while (0)
    {
        int it = gw; TItem ta, tb; f32x4 va[8], vb[8];
        if (it < NITEMS) { ta = decode(it); P0_LOAD(ta, va); }
        while (it < NITEMS) {
            int itn = it + NGW; if (itn < NITEMS) { tb = decode(itn); P0_LOAD(tb, vb); }
            P0_PROC(ta, va); it = itn; if (it >= NITEMS) break;
            itn = it + NGW; if (itn < NITEMS) { ta = decode(itn); P0_LOAD(ta, va); }
            P0_PROC(tb, vb); it = itn;
        }
    }
#undef P0_KB
#undef P0_NB
#undef P0_LOAD
#undef P0_PROC
    bf16* HN = (bf16*)(F.ws + WS_HN);
    for (int m = gw; m < T_; m += NGW) rms_row_to_bf16(F.in[I_X] + (size_t)m * DM, F.in[I_NMIX], Z8_COL0 > 0 ? HN + (size_t)m * LDP : nullptr, F.lane, (unsigned char*)(F.ws + WS_HN8) + (size_t)m * (2 * LDP8), HN8_SCALE);
    {
        bf16* WF = (bf16*)(F.ws + WS_WPQF); const float* SK = F.in[I_SUBK]; const float* WQ = F.in[I_WPQ];
        const int l15 = F.lane & 15, l4 = F.lane >> 4;
        for (int task = gw; task < 2048; task += NGW) {
            const int combo = task & 127, kr = task >> 7, hc = combo >> 3, kt = combo & 7, n0 = hc * 128 + kt * 16;
            bf16x8 bfr[4];
#pragma unroll
            for (int ds = 0; ds < 4; ++ds) bfr[ds] = cvt8(SK + (size_t)(n0 + l15) * 128 + ds * 32 + 8 * l4);
#pragma unroll 1
            for (int kq = 0; kq < 4; ++kq) {
                f32x4 ra[4][4], rb[4][4];
#pragma unroll
                for (int g = 0; g < 4; ++g)
#pragma unroll
                    for (int ds = 0; ds < 4; ++ds) { const float* wp = WQ + (size_t)(kr * 256 + (kq * 4 + g) * 16 + l15) * 2048 + hc * 128 + ds * 32 + 8 * l4; ra[g][ds] = *(const GAS f32x4*)wp; rb[g][ds] = *(const GAS f32x4*)(wp + 4); }
#pragma unroll
                for (int g = 0; g < 4; ++g) {
                    const int k0 = kr * 256 + (kq * 4 + g) * 16;
                    pg8::f32x4 acc = {0.f, 0.f, 0.f, 0.f};
#pragma unroll
                    for (int ds = 0; ds < 4; ++ds) { v4u w; w.x = pk2(ra[g][ds].x, ra[g][ds].y); w.y = pk2(ra[g][ds].z, ra[g][ds].w); w.z = pk2(rb[g][ds].x, rb[g][ds].y); w.w = pk2(rb[g][ds].z, rb[g][ds].w);
                        acc = __builtin_amdgcn_mfma_f32_16x16x32_bf16(__builtin_bit_cast(bf16x8, w), bfr[ds], acc, 0, 0, 0); }
                    if (SCORES_INT8) *(GAS unsigned*)((unsigned char*)WF + (size_t)(n0 + l15) * (2 * LDP8) + k0 + 4 * l4) = (unsigned)pk_i8(acc[0] * WPQ8_SCALE, acc[1] * WPQ8_SCALE, acc[2] * WPQ8_SCALE, acc[3] * WPQ8_SCALE);
                    else { u32x2 w; w.x = pk2(acc[0], acc[1]); w.y = pk2(acc[2], acc[3]);
                    *(GAS u32x2*)(WF + (size_t)(n0 + l15) * LDP + k0 + 4 * l4) = w; }
                }
            }
        }
    }
    static_assert(PEER_USCALE == pg8::HK_USCALE && PEER_VSCALE == pg8::HK_VSCALE, "TblHook scales");
    if (!UV_IN_GEMM1) {
        const size_t n8 = (size_t)NEXP * DM / 8; const size_t gt = (size_t)F.vcu * (NWAVES * 64) + F.tid, nth = (size_t)F.G * (NWAVES * 64);
        unsigned char* UB = (unsigned char*)(F.ws + WS_UB); unsigned char* VB = (unsigned char*)(F.ws + WS_VB);
        auto cvt_chunk = [&](size_t i, const f32x4 a, const f32x4 b) { const bool isu = i < n8; const size_t j = isu ? i : i - n8; const float sc = isu ? PEER_USCALE : PEER_VSCALE;
            int w0, w1;
            if (isu) { w0 = pk_i8(a.x * sc, a.y * sc, a.z * sc, a.w * sc); w1 = pk_i8(b.x * sc, b.y * sc, b.z * sc, b.w * sc); }
            else { w0 = __builtin_amdgcn_cvt_pk_fp8_f32(a.x * sc, a.y * sc, 0, false); w0 = __builtin_amdgcn_cvt_pk_fp8_f32(a.z * sc, a.w * sc, w0, true);
                   w1 = __builtin_amdgcn_cvt_pk_fp8_f32(b.x * sc, b.y * sc, 0, false); w1 = __builtin_amdgcn_cvt_pk_fp8_f32(b.z * sc, b.w * sc, w1, true); }
            const size_t e = j >> 9, col = (j & 511) * 8, sl = col >> 10, c = col & 1023;
            u32x2 w; w.x = (unsigned)w0; w.y = (unsigned)w1; *(GAS u32x2*)((isu ? UB : VB) + (sl * NEXP + e) * 1024 + c) = w; };
        auto src_of = [&](size_t i) { const bool isu = i < n8; const size_t j = isu ? i : i - n8; return (isu ? F.in[I_UEMB] : F.in[I_VEMB]) + j * 8; };
        size_t i = gt;
        for (; i + 7 * nth < 2 * n8; i += 8 * nth) {
            f32x4 a_[8], b_[8];
#pragma unroll
            for (int c = 0; c < 8; ++c) { const float* sp = src_of(i + c * nth); a_[c] = *(const GAS f32x4*)sp; b_[c] = *(const GAS f32x4*)(sp + 4); }
#pragma unroll
            for (int c = 0; c < 8; ++c) cvt_chunk(i + c * nth, a_[c], b_[c]);
        }
        for (; i < 2 * n8; i += nth) { const float* s0 = src_of(i); const f32x4 a0 = *(const GAS f32x4*)s0, b0 = *(const GAS f32x4*)(s0 + 4); cvt_chunk(i, a0, b0); }
    }
}
__device__ __forceinline__ void p2_conv_kmean(Frame& F) {
    const bf16* Z = (const bf16*)(F.ws + WS_Z);
    float* KM = (float*)(F.ws + WS_KMEAN);
    LAS float* red = (LAS float*)(F.lds + RING_OFF);
    for (int u = F.vcu; u < 128; u += F.G) {
        const int bn = u >> 2, cg = u & 3, b = bn >> 3, n = bn & 7;
        const bf16* kp = Z + (size_t)(b * SEQ + n * 256 + F.wave * 32) * INC + ZC_K + cg * 512 + F.lane * 8;
        float s[8];
#pragma unroll
        for (int e = 0; e < 8; ++e) s[e] = 0.f;
#pragma unroll 16
        for (int t = 0; t < 32; ++t) { const v4u w = *(const GAS v4u*)(kp + (size_t)t * INC);
            s[0] += bflo(w.x); s[1] += bfhi(w.x); s[2] += bflo(w.y); s[3] += bfhi(w.y); s[4] += bflo(w.z); s[5] += bfhi(w.z); s[6] += bflo(w.w); s[7] += bfhi(w.w); }
        __syncthreads();
#pragma unroll
        for (int e = 0; e < 8; ++e) red[F.wave * 512 + F.lane * 8 + e] = s[e];
        __syncthreads();
        { float a = 0.f;
#pragma unroll
          for (int w = 0; w < 8; ++w) a += red[w * 512 + F.tid];
          const int col = cg * 512 + F.tid, h = col >> 7, d = col & 127;
          KM[((size_t)(b * NH + h) * NBLK + n) * HD + d] = a * (1.0f / 256.0f); }
    }
    const int gw = F.vcu * NWAVES + F.wave, NGW = F.G * NWAVES;
    bf16* BZ = (bf16*)(F.ws + WS_BZ); const float* CW = F.in[I_CONVW];
    for (int u = gw; u < (T_ / 16) * 4; u += NGW) {
        const int ch = u >> 2, cg = u & 3, t0 = ch * 16, c0 = cg * 512 + F.lane * 8;
        float w0[8], w1[8], w2[8];
#pragma unroll
        for (int e = 0; e < 8; ++e) { w0[e] = CW[c0 + e]; w1[e] = CW[CD + c0 + e]; w2[e] = CW[2 * CD + c0 + e]; }
        float p2[8], p1[8];
        const bool first = (t0 % SEQ) == 0;
#pragma unroll
        for (int e = 0; e < 8; ++e) { p2[e] = 0.f; p1[e] = 0.f; }
        if (!first) {
            const bf16* zr2 = Z + (size_t)(t0 - 2) * INC + c0; const bf16* zr1 = Z + (size_t)(t0 - 1) * INC + c0;
            const v4u c2 = *(const GAS v4u*)(zr2 + ZC_C), u2 = *(const GAS v4u*)(zr2 + ZC_U), c1 = *(const GAS v4u*)(zr1 + ZC_C), u1 = *(const GAS v4u*)(zr1 + ZC_U);
            p2[0] = bflo(c2.x) * bflo(u2.x); p2[1] = bfhi(c2.x) * bfhi(u2.x); p2[2] = bflo(c2.y) * bflo(u2.y); p2[3] = bfhi(c2.y) * bfhi(u2.y);
            p2[4] = bflo(c2.z) * bflo(u2.z); p2[5] = bfhi(c2.z) * bfhi(u2.z); p2[6] = bflo(c2.w) * bflo(u2.w); p2[7] = bfhi(c2.w) * bfhi(u2.w);
            p1[0] = bflo(c1.x) * bflo(u1.x); p1[1] = bfhi(c1.x) * bfhi(u1.x); p1[2] = bflo(c1.y) * bflo(u1.y); p1[3] = bfhi(c1.y) * bfhi(u1.y);
            p1[4] = bflo(c1.z) * bflo(u1.z); p1[5] = bfhi(c1.z) * bfhi(u1.z); p1[6] = bflo(c1.w) * bflo(u1.w); p1[7] = bfhi(c1.w) * bfhi(u1.w);
        }
        constexpr int CONV_TB = 4;
#pragma unroll 1
        for (int th = 0; th < 16; th += CONV_TB) {
        v4u ccv[CONV_TB], uuv[CONV_TB], bbv[CONV_TB];
#pragma unroll
        for (int t8 = 0; t8 < CONV_TB; ++t8) { const bf16* zr = Z + (size_t)(t0 + th + t8) * INC + c0; ccv[t8] = *(const GAS v4u*)(zr + ZC_C); uuv[t8] = *(const GAS v4u*)(zr + ZC_U); bbv[t8] = *(const GAS v4u*)(zr + ZC_B); }
        asm volatile("" ::: "memory");
#pragma unroll
        for (int t8 = 0; t8 < CONV_TB; ++t8) { const int t = th + t8;
            const v4u cc = ccv[t8], uu = uuv[t8], bb = bbv[t8];
            float p0[8], bg[8], o[8];
            p0[0] = bflo(cc.x) * bflo(uu.x); p0[1] = bfhi(cc.x) * bfhi(uu.x); p0[2] = bflo(cc.y) * bflo(uu.y); p0[3] = bfhi(cc.y) * bfhi(uu.y);
            p0[4] = bflo(cc.z) * bflo(uu.z); p0[5] = bfhi(cc.z) * bfhi(uu.z); p0[6] = bflo(cc.w) * bflo(uu.w); p0[7] = bfhi(cc.w) * bfhi(uu.w);
            bg[0] = bflo(bb.x); bg[1] = bfhi(bb.x); bg[2] = bflo(bb.y); bg[3] = bfhi(bb.y); bg[4] = bflo(bb.z); bg[5] = bfhi(bb.z); bg[6] = bflo(bb.w); bg[7] = bfhi(bb.w);
#pragma unroll
            for (int e = 0; e < 8; ++e) { o[e] = bg[e] * (w0[e] * p2[e] + w1[e] * p1[e] + w2[e] * p0[e]); p2[e] = p1[e]; p1[e] = p0[e]; }
            if (CONVOUT_FP8) { u32x2 w8; int q0 = __builtin_amdgcn_cvt_pk_fp8_f32(o[0] * BZ8_SCALE, o[1] * BZ8_SCALE, 0, false); q0 = __builtin_amdgcn_cvt_pk_fp8_f32(o[2] * BZ8_SCALE, o[3] * BZ8_SCALE, q0, true);
                int q1 = __builtin_amdgcn_cvt_pk_fp8_f32(o[4] * BZ8_SCALE, o[5] * BZ8_SCALE, 0, false); q1 = __builtin_amdgcn_cvt_pk_fp8_f32(o[6] * BZ8_SCALE, o[7] * BZ8_SCALE, q1, true); w8.x = (unsigned)q0; w8.y = (unsigned)q1;
                if (GEMM2_FUSED) *(GAS u32x2*)((unsigned char*)(F.ws + WS_AC) + (size_t)(t0 + t) * (2 * LDP8) + c0) = w8;
                else *(GAS u32x2*)((unsigned char*)BZ + (size_t)(t0 + t) * (2 * LDH8) + c0) = w8; }
            else if (CONVOUT_INT8) { u32x2 w8; w8.x = (unsigned)pk_i8(o[0] * BZ8_SCALE, o[1] * BZ8_SCALE, o[2] * BZ8_SCALE, o[3] * BZ8_SCALE); w8.y = (unsigned)pk_i8(o[4] * BZ8_SCALE, o[5] * BZ8_SCALE, o[6] * BZ8_SCALE, o[7] * BZ8_SCALE);
                *(GAS u32x2*)((unsigned char*)BZ + (size_t)(t0 + t) * (2 * LDH8) + c0) = w8; }
            else { v4u w; w.x = pk2(o[0], o[1]); w.y = pk2(o[2], o[3]); w.z = pk2(o[4], o[5]); w.w = pk2(o[6], o[7]);
            *(GAS v4u*)(BZ + (size_t)(t0 + t) * LDH + c0) = w; }
        }
        asm volatile("" ::: "memory");
        }
    }
}
__device__ __forceinline__ void p3_attention(Frame& F, char* lds) {
    const bf16* Z = (const bf16*)(F.ws + WS_Z); unsigned char* ATT = (unsigned char*)(F.ws + WS_ATT); const float* KM = (const float*)(F.ws + WS_KMEAN);
    for (int u = F.vcu; u < NBATCH * NH * 4; u += F.G) {
        const int bh = u >> 2, p = u & 3, b = bh / NH, h = bh % NH;
        const bf16* Kh = Z + (size_t)(b * SEQ) * INC + ZC_K + h * HD; const bf16* Vh = Z + (size_t)(b * SEQ) * INC + ZC_V + h * HD;
        const float* km = KM + (size_t)(b * NH + h) * NBLK * HD;
#pragma unroll 1
        for (int half = 0; half < 2; ++half) {
            const int qb = half == 0 ? 7 - p : p;
            const bf16* Qb = Z + (size_t)(b * SEQ + qb * 256) * INC + ZC_Q + h * HD;
            unsigned char* Ob = GEMM2_FUSED ? (unsigned char*)(F.ws + WS_AC) + (size_t)(b * SEQ + qb * 256) * (2 * LDP8) + 2048 + h * HD : ATT + (size_t)(b * SEQ + qb * 256) * (2 * LDH8) + h * HD;
            moba::moba_body(Qb, Kh, Vh, km, Ob, qb, lds);
        }
    }
}
__device__ __forceinline__ void rms_rowbf_to_bf16(const bf16* hrow, const float* gain, bf16* orow, int lane, unsigned char* q8row = nullptr) {
    const GAS v4u* hr = (const GAS v4u*)hrow + lane;
    v4u v[8]; float s = 0.f;
#pragma unroll
    for (int i = 0; i < 8; ++i) { v[i] = hr[64 * i];
        s += (bflo(v[i].x) * bflo(v[i].x) + bfhi(v[i].x) * bfhi(v[i].x)) + (bflo(v[i].y) * bflo(v[i].y) + bfhi(v[i].y) * bfhi(v[i].y)) + (bflo(v[i].z) * bflo(v[i].z) + bfhi(v[i].z) * bfhi(v[i].z)) + (bflo(v[i].w) * bflo(v[i].w) + bfhi(v[i].w) * bfhi(v[i].w)); }
    const float rs = 1.0f / sqrtf(wave_sum(s) * (1.0f / DM) + EPS);
    GAS v4u* o8 = (GAS v4u*)orow + lane;
#pragma unroll
    for (int i = 0; i < 8; ++i) { const f32x4 g0 = *(const GAS f32x4*)(gain + 512 * i + 8 * lane), g1 = *(const GAS f32x4*)(gain + 512 * i + 8 * lane + 4); v4u w;
        w.x = pk2(bflo(v[i].x) * rs * g0.x, bfhi(v[i].x) * rs * g0.y); w.y = pk2(bflo(v[i].y) * rs * g0.z, bfhi(v[i].y) * rs * g0.w);
        w.z = pk2(bflo(v[i].z) * rs * g1.x, bfhi(v[i].z) * rs * g1.y); w.w = pk2(bflo(v[i].w) * rs * g1.z, bfhi(v[i].w) * rs * g1.w);
        if (q8row) { const float q = rs * XN8_SCALE; u32x2 w8; w8.x = (unsigned)pk_i8(bflo(v[i].x) * q * g0.x, bfhi(v[i].x) * q * g0.y, bflo(v[i].y) * q * g0.z, bfhi(v[i].y) * q * g0.w); w8.y = (unsigned)pk_i8(bflo(v[i].z) * q * g1.x, bfhi(v[i].z) * q * g1.y, bflo(v[i].w) * q * g1.z, bfhi(v[i].w) * q * g1.w);
            ((GAS u32x2*)q8row)[64 * i + lane] = w8; }
        else o8[64 * i] = w; }
}
__device__ __forceinline__ void p6_rms(Frame& F) {
    const int gw = F.vcu * NWAVES + F.wave, NGW = F.G * NWAVES; bf16* XN = (bf16*)(F.ws + WS_XN); const bf16* HB = (const bf16*)(F.ws + WS_HB);
    for (int m = gw; m < T_; m += NGW) rms_rowbf_to_bf16(HB + (size_t)m * DM, F.in[I_NFFN], XN + (size_t)m * LDP, F.lane, SCORES_INT8 ? (unsigned char*)XN + (size_t)m * (2 * LDP8) : nullptr);
}
__device__ __forceinline__ int fkey(float f) { const int b = __float_as_int(f); return b ^ ((b >> 31) & 0x7fffffff); }
__device__ __forceinline__ float kval(int k) { return __int_as_float(k ^ ((k >> 31) & 0x7fffffff)); }
__device__ __forceinline__ int imax(int a, int b) { return a > b ? a : b; }
__device__ __forceinline__ int imin(int a, int b) { return a < b ? a : b; }
__device__ __forceinline__ void sort16_desc(int (&v)[16]) {
#pragma unroll
    for (int k = 2; k <= 16; k <<= 1)
#pragma unroll
        for (int j = k >> 1; j > 0; j >>= 1)
#pragma unroll
            for (int i = 0; i < 16; ++i) { const int l = i ^ j; if (l > i) { const int a = v[i], b = v[l]; const int mx = imax(a, b), mn = imin(a, b); const bool desc = (i & k) == 0; v[i] = desc ? mx : mn; v[l] = desc ? mn : mx; } }
}
__device__ __forceinline__ void merge_top16(int (&run)[16], const int (&grp)[16]) {
#pragma unroll
    for (int i = 0; i < 16; ++i) run[i] = imax(run[i], grp[15 - i]);
#pragma unroll
    for (int j = 8; j > 0; j >>= 1)
#pragma unroll
        for (int i = 0; i < 16; ++i) { const int l = i ^ j; if (l > i) { const int a = run[i], b = run[l]; run[i] = imax(a, b); run[l] = imin(a, b); } }
}
__device__ __forceinline__ void topk128(const float* sp, int (&run)[16]) {
#pragma unroll
    for (int i = 0; i < 16; ++i) run[i] = (int)0x80000000;
#pragma unroll 1
    for (int gg = 0; gg < 2; ++gg) {
        float raw[64];
#pragma unroll
        for (int i = 0; i < 64; ++i) raw[i] = sp[(size_t)(gg * 64 + i) * T_];
#pragma unroll
        for (int g = 0; g < 4; ++g) {
            int grp[16];
#pragma unroll
            for (int i = 0; i < 16; ++i) grp[i] = (fkey(raw[g * 16 + i]) & ~0x7F) | (gg * 64 + g * 16 + i);
            sort16_desc(grp);
            merge_top16(run, grp);
        }
    }
}
struct CandTab { int a[64], b[64]; };
__host__ __device__ constexpr CandTab make_cand() { CandTab t{}; int n = 0; for (int a = 0; a < 16; ++a) for (int b = 0; b < 16; ++b) if ((a + 1) * (b + 1) <= 16) { t.a[n] = a; t.b[n] = b; ++n; }
    for (; n < 64; ++n) { t.a[n] = -1; t.b[n] = -1; } return t; }
constexpr size_t WS_PART = WS_Z, WS_SSQ = WS_Z + 32 * MiB, WS_ES = WS_Z + 33 * MiB, WS_GS = WS_Z + 37 * MiB, WS_BST = WS_Z + 41 * MiB;
constexpr int NBUCK = 8, BUCK_SHIFT = 11;
__device__ __forceinline__ void p8_topk(Frame& F) {
    constexpr CandTab CT = make_cand();
    const float* ST = (const float*)(F.ws + WS_ST); int* EXP = (int*)(F.ws + WS_EXP); float* GATE = (float*)(F.ws + WS_GATE);
    int* ES = (int*)(F.ws + WS_ES); float* GS = (float*)(F.ws + WS_GS); int* BST = (int*)(F.ws + WS_BST);
    LAS int* EL = (LAS int*)(F.lds + RING_OFF); LAS float* GL = (LAS float*)(F.lds + RING_OFF + 16384);
    LAS int* tab = (LAS int*)(F.lds + RING_OFF + 32768 + F.wave * 8192);
    const int lane = F.lane, tl = lane & 31, c = lane >> 5, h = F.wave;
    for (int u = F.vcu; u < T_ / 32; u += F.G) {
        const int t = u * 32 + tl;
        int mine[16];
        topk128(ST + (size_t)((h * 2 + c) * 128) * T_ + t, mine);
        float s1[16], s2[16];
#pragma unroll
        for (int i = 0; i < 16; ++i) { const int other = __shfl_xor(mine[i], 32); const int k1 = c ? other : mine[i], k2 = c ? mine[i] : other;
            s1[i] = kval(k1 & ~0x7F); s2[i] = kval(k2 & ~0x7F); tab[i * 64 + lane] = k1 & 0x7F; tab[(16 + i) * 64 + lane] = k2 & 0x7F; }
        int c0[16], c1[16], c2[16], c3[16];
#pragma unroll
        for (int i = 0; i < 16; ++i) {
            c0[i] = CT.a[i] < 0 ? (int)0x80000000 : ((fkey(s1[CT.a[i] < 0 ? 0 : CT.a[i]] + s2[CT.b[i] < 0 ? 0 : CT.b[i]]) & ~0xFF) | (CT.a[i] * 16 + CT.b[i]));
            c1[i] = CT.a[16 + i] < 0 ? (int)0x80000000 : ((fkey(s1[CT.a[16 + i] < 0 ? 0 : CT.a[16 + i]] + s2[CT.b[16 + i] < 0 ? 0 : CT.b[16 + i]]) & ~0xFF) | (CT.a[16 + i] * 16 + CT.b[16 + i]));
            c2[i] = CT.a[32 + i] < 0 ? (int)0x80000000 : ((fkey(s1[CT.a[32 + i] < 0 ? 0 : CT.a[32 + i]] + s2[CT.b[32 + i] < 0 ? 0 : CT.b[32 + i]]) & ~0xFF) | (CT.a[32 + i] * 16 + CT.b[32 + i]));
            c3[i] = CT.a[48 + i] < 0 ? (int)0x80000000 : ((fkey(s1[CT.a[48 + i] < 0 ? 0 : CT.a[48 + i]] + s2[CT.b[48 + i] < 0 ? 0 : CT.b[48 + i]]) & ~0xFF) | (CT.a[48 + i] * 16 + CT.b[48 + i]));
        }
        sort16_desc(c0); sort16_desc(c1); sort16_desc(c2); sort16_desc(c3);
        merge_top16(c0, c1); merge_top16(c2, c3); merge_top16(c0, c2);
        LDS_WAIT();
        float rs = 1.0f;
        if (DEFER_FFN_NORM) { const float* sp_ = (const float*)(F.ws + WS_SSQP) + (size_t)t * 64; float a_ = 0.f;
#pragma unroll
            for (int j = 0; j < 16; ++j) { const f32x4 v_ = *(const GAS f32x4*)(sp_ + 4 * j); a_ += (v_.x + v_.y) + (v_.z + v_.w); }
            rs = 1.0f / sqrtf(a_ * (1.0f / DM) + EPS); if (h == 0 && c == 0) ((float*)(F.ws + WS_RS))[t] = rs; }
        int ex[16]; float gv[16]; float sum = 0.f; const float mx = kval(c0[0] & ~0xFF);
#pragma unroll
        for (int i = 0; i < 16; ++i) { const int ab = c0[i] & 0xFF, a = ab >> 4, b = ab & 15; const int i1 = tab[a * 64 + lane], i2 = tab[(16 + b) * 64 + lane];
            ex[i] = i1 * NKEYS + i2; gv[i] = __expf((kval(c0[i] & ~0xFF) - mx) * rs); sum += gv[i]; }
        const float inv = 1.0f / sum;
        if (c == 0) {
            int* ep = EXP + (size_t)t * NSEL + h * PTOPK; float* gp = GATE + (size_t)t * NSEL + h * PTOPK;
#pragma unroll
            for (int i = 0; i < 16; i += 4) { *(int4*)(ep + i) = make_int4(ex[i], ex[i + 1], ex[i + 2], ex[i + 3]); *(float4*)(gp + i) = make_float4(gv[i] * inv, gv[i + 1] * inv, gv[i + 2] * inv, gv[i + 3] * inv); }
#pragma unroll
            for (int i = 0; i < 16; ++i) { EL[tl * NSEL + h * PTOPK + i] = ex[i]; GL[tl * NSEL + h * PTOPK + i] = gv[i] * inv; }
        }
        __syncthreads();
#pragma unroll
        for (int q = 0; q < 4; ++q) {
            const int tq = F.wave * 4 + q; const size_t tt = (size_t)(u * 32 + tq);
            int k0 = (EL[tq * NSEL + lane] << 7) | lane, k1 = (EL[tq * NSEL + 64 + lane] << 7) | (64 + lane);
#pragma unroll
            for (int k = 2; k <= 128; k <<= 1)
#pragma unroll
                for (int j = k >> 1; j > 0; j >>= 1) {
                    if (j == 64) { const int lo = imin(k0, k1), hi = imax(k0, k1); k0 = lo; k1 = hi; }
                    else { const int p0 = __shfl_xor(k0, j), p1 = __shfl_xor(k1, j); const bool lower = (lane & j) == 0, up0 = (lane & k) == 0, up1 = ((64 + lane) & k) == 0;
                        k0 = (lower == up0) ? imin(k0, p0) : imax(k0, p0); k1 = (lower == up1) ? imin(k1, p1) : imax(k1, p1); }
                }
            const int e0 = k0 >> 7, e1 = k1 >> 7;
            ES[tt * NSEL + lane] = e0; ES[tt * NSEL + 64 + lane] = e1; GS[tt * NSEL + lane] = GL[tq * NSEL + (k0 & 127)]; GS[tt * NSEL + 64 + lane] = GL[tq * NSEL + (k1 & 127)];
            int bstv = 0;
#pragma unroll
            for (int b = 0; b <= NBUCK; ++b) { const int cnt = __popcll(__ballot(e0 < (b << BUCK_SHIFT))) + __popcll(__ballot(e1 < (b << BUCK_SHIFT))); bstv = (lane == b) ? cnt : bstv; }
            if (lane < 16) BST[tt * 16 + lane] = bstv;
        }
        __syncthreads();
    }
}
constexpr int P9_NSL = 4, P9_SLD = DM / P9_NSL, P9_TPS = 4;
constexpr int P9_TPU = 8;
constexpr int P9_WLDS = 9216;
__device__ __forceinline__ int rfl(int v) { return __builtin_amdgcn_readfirstlane(v); }
template <int CTRL, int RMASK> __device__ __forceinline__ float dppadd(float v) { return v + __builtin_bit_cast(float, __builtin_amdgcn_update_dpp(0, __builtin_bit_cast(int, v), CTRL, RMASK, 0xf, false)); }
__device__ __forceinline__ f32x2 fp8lo(unsigned w) { return __builtin_amdgcn_cvt_pk_f32_fp8((int)w, false); }
__device__ __forceinline__ f32x2 fp8hi(unsigned w) { return __builtin_amdgcn_cvt_pk_f32_fp8((int)w, true); }
#define P9_DESC(i) const int d_ = rfl(DS[i]); const int tkd = d_ & 7, pd = (d_ >> 3) & 127, nd = d_ >> 10; const int nm1 = imax(nd, 1) - 1
#define P9_ISSUE(i, W) do { P9_DESC(i); const int ev_ = EL[tkd * 128 + pd + imin(lane & 7, nm1)]; \
        _Pragma("unroll") for (int q = 0; q < 8; ++q) { const int e_ = __builtin_amdgcn_readlane(ev_, q); W[q] = *(const GAS v4u*)(TB + (size_t)e_ * P9_SLD); } } while (0)
#define P9_DOT16(W, K) __builtin_amdgcn_sdot4((int)W.x, xs[K].x, __builtin_amdgcn_sdot4((int)W.y, xs[K].y, __builtin_amdgcn_sdot4((int)W.z, xs[K].z, __builtin_amdgcn_sdot4((int)W.w, xs[K].w, 0, false), false), false), false)
__device__ __forceinline__ int ifold32(int a, int b) { const auto r = __builtin_amdgcn_permlane32_swap((unsigned)a, (unsigned)b, false, false); return (int)(r[0] + r[1]); }
__device__ __forceinline__ int ifold16(int a, int b) { const auto r = __builtin_amdgcn_permlane16_swap((unsigned)a, (unsigned)b, false, false); return (int)(r[0] + r[1]); }
template <int CTRL> __device__ __forceinline__ int idppadd(int v) { return v + __builtin_amdgcn_update_dpp(0, v, CTRL, 0xf, 0xf, false); }
#define P9_DQ(Q, K) ((Q) <= nm1 ? P9_DOT16(W_[Q], K) : 0)
#define P9_CONS_U_TK(K, W) { const v4u (&W_)[8] = W; const int d0 = P9_DOT16(W_[0], K), d1 = P9_DQ(1, K), d2 = P9_DQ(2, K), d3 = P9_DQ(3, K), d4 = P9_DQ(4, K), d5 = P9_DQ(5, K), d6 = P9_DQ(6, K), d7 = P9_DQ(7, K); \
        const int e0 = ifold32(d0, d1), e1 = ifold32(d2, d3), e2 = ifold32(d4, d5), e3 = ifold32(d6, d7); const int f0 = ifold16(e0, e1), f1 = ifold16(e2, e3); \
        const bool up8 = (lane & 8) != 0; int g = up8 ? f1 : f0; const int o = up8 ? f0 : f1; \
        g += __builtin_amdgcn_update_dpp(0, o, 0x128, 0xf, 0xf, false);     \
        g = idppadd<0xB1>(g); g = idppadd<0x4E>(g); g = idppadd<0x141>(g); \
        if ((lane & 7) == 0 && qmap <= nm1) HL[K * 128 + pd + qmap] = (float)g * (1.0f / (PEER_USCALE * (SCORES_INT8 ? XN8_SCALE : PEER_XSCALE))); }
#define P9_CONS_V_TK(K, W) { const float hvv_ = HL[K * 128 + pd + imin(lane & 7, nm1)]; \
        _Pragma("unroll") for (int q = 0; q < 8; ++q) if (q < nd) { const float hq = __builtin_bit_cast(float, __builtin_amdgcn_readlane(__builtin_bit_cast(int, hvv_), q)); const f32x2 h2 = {hq, hq}; const v4u ww = W[q]; \
            acc[K][0] = fp8lo(ww.x) * h2 + acc[K][0]; acc[K][1] = fp8hi(ww.x) * h2 + acc[K][1]; acc[K][2] = fp8lo(ww.y) * h2 + acc[K][2]; acc[K][3] = fp8hi(ww.y) * h2 + acc[K][3]; \
            acc[K][4] = fp8lo(ww.z) * h2 + acc[K][4]; acc[K][5] = fp8hi(ww.z) * h2 + acc[K][5]; acc[K][6] = fp8lo(ww.w) * h2 + acc[K][6]; acc[K][7] = fp8hi(ww.w) * h2 + acc[K][7]; __builtin_amdgcn_sched_barrier(0); } }
#define P9_CONSUME(i, W, CONS) do { P9_DESC(i); switch (tkd) { case 0: CONS(0, W); break; case 1: CONS(1, W); break; case 2: CONS(2, W); break; default: CONS(3, W); break; } } while (0)
#define P9_CONSUME8(i, W, CONS) do { P9_DESC(i); switch (tkd) { case 0: CONS(0, W); break; case 1: CONS(1, W); break; case 2: CONS(2, W); break; case 3: CONS(3, W); break; \
        case 4: CONS(4, W); break; case 5: CONS(5, W); break; case 6: CONS(6, W); break; default: CONS(7, W); break; } } while (0)
#define P9_PIPELINE(CONS) do { v4u wA[8], wB[8], wC[8]; P9_ISSUE(0, wA); P9_ISSUE(1, wB); \
        for (int i = 0; i < NBP; i += 3) { P9_ISSUE(i + 2, wC); P9_CONSUME(i, wA, CONS); P9_ISSUE(i + 3, wA); P9_CONSUME(i + 1, wB, CONS); P9_ISSUE(i + 4, wB); P9_CONSUME(i + 2, wC, CONS); } } while (0)
#define P9_PIPELINE8(CONS) do { v4u wA[8], wB[8], wC[8]; P9_ISSUE(0, wA); P9_ISSUE(1, wB); \
        for (int i = 0; i < NBP; i += 3) { P9_ISSUE(i + 2, wC); P9_CONSUME8(i, wA, CONS); P9_ISSUE(i + 3, wA); P9_CONSUME8(i + 1, wB, CONS); P9_ISSUE(i + 4, wB); P9_CONSUME8(i + 2, wC, CONS); } } while (0)
template <int TPS> __device__ __forceinline__ int p9_build_desc(const int* BST, int tb, int lane, LAS int* DS) {
    const int tkg = lane & (TPS - 1), bg = (lane / TPS) & 7; const int s0 = BST[(size_t)(tb + tkg) * 16 + bg], s1 = BST[(size_t)(tb + tkg) * 16 + bg + 1], cnt = lane < 8 * TPS ? s1 - s0 : 0, nb = (cnt + 7) >> 3;
    int inc = nb;
#pragma unroll
    for (int o = 1; o < 64; o <<= 1) { const int v = __shfl_up(inc, o); inc += (lane >= o) ? v : 0; }
    const int off = inc - nb, NBT = __builtin_amdgcn_readlane(inc, 63);
    for (int i = 0; i < nb; ++i) DS[off + i] = tkg | ((s0 + 8 * i) << 3) | (imin(8, cnt - 8 * i) << 10);
    const int NBP = ((NBT + 2) / 3) * 3;
    if (lane < NBP + 2 - NBT) DS[NBT + lane] = 0;
    LDS_WAIT();
    return NBP;
}
__device__ __forceinline__ void p9a_peer_u(Frame& F) {
    if (F.G % 8 != 0) return;
    const int lane = F.lane, sl = (blockIdx.x & 7) >> 1, rk = (blockIdx.x >> 3) * 2 + (blockIdx.x & 1), NR = F.G >> 2, TPR = T_ / NR;
    const bf16* XN = (const bf16*)(F.ws + WS_XN); const unsigned char* TB = (const unsigned char*)(F.ws + WS_UB) + (size_t)sl * NEXP * P9_SLD + lane * 16;
    const int* ES = (const int*)(F.ws + WS_ES); const int* BST = (const int*)(F.ws + WS_BST); float* PART = (float*)(F.ws + WS_PART) + (size_t)sl * T_ * NSEL;
    LAS int* EL = (LAS int*)(F.lds + RING_OFF + F.wave * P9_WLDS); LAS float* HL = (LAS float*)(EL + 1024); LAS int* DS = EL + 2048;
    const int qmap = 4 * ((lane >> 3) & 1) + 2 * ((lane >> 4) & 1) + (lane >> 5);
    for (int tb = rk * TPR + F.wave * P9_TPU; tb < (rk + 1) * TPR; tb += NWAVES * P9_TPU) {
        typedef int i32x4 __attribute__((ext_vector_type(4))); i32x4 xs[P9_TPU];
#pragma unroll
        for (int tk = 0; tk < P9_TPU; ++tk) { const size_t t = (size_t)(tb + tk);
            if (SCORES_INT8) { const v4u x8 = *(const GAS v4u*)((const unsigned char*)XN + t * (2 * LDP8) + sl * P9_SLD + lane * 16); xs[tk].x = (int)x8.x; xs[tk].y = (int)x8.y; xs[tk].z = (int)x8.z; xs[tk].w = (int)x8.w; }
            else { const bf16* xp = XN + t * LDP + sl * P9_SLD + lane * 16; const v4u x0 = *(const GAS v4u*)xp, x1 = *(const GAS v4u*)(xp + 8);
            xs[tk].x = pk_i8(bflo(x0.x) * PEER_XSCALE, bfhi(x0.x) * PEER_XSCALE, bflo(x0.y) * PEER_XSCALE, bfhi(x0.y) * PEER_XSCALE); xs[tk].y = pk_i8(bflo(x0.z) * PEER_XSCALE, bfhi(x0.z) * PEER_XSCALE, bflo(x0.w) * PEER_XSCALE, bfhi(x0.w) * PEER_XSCALE);
            xs[tk].z = pk_i8(bflo(x1.x) * PEER_XSCALE, bfhi(x1.x) * PEER_XSCALE, bflo(x1.y) * PEER_XSCALE, bfhi(x1.y) * PEER_XSCALE); xs[tk].w = pk_i8(bflo(x1.z) * PEER_XSCALE, bfhi(x1.z) * PEER_XSCALE, bflo(x1.w) * PEER_XSCALE, bfhi(x1.w) * PEER_XSCALE);
            }
            EL[tk * 128 + lane] = ES[t * NSEL + lane]; EL[tk * 128 + 64 + lane] = ES[t * NSEL + 64 + lane]; }
        const int NBP = p9_build_desc<P9_TPU>(BST, tb, lane, DS);
        P9_PIPELINE8(P9_CONS_U_TK);
        LDS_WAIT();
#pragma unroll
        for (int tk = 0; tk < P9_TPU; ++tk) { const size_t t = (size_t)(tb + tk); PART[t * NSEL + lane] = HL[tk * 128 + lane]; PART[t * NSEL + 64 + lane] = HL[tk * 128 + 64 + lane]; }
        LDS_WAIT();
    }
}
__device__ __forceinline__ void p9b_peer_v(Frame& F, float* yout, unsigned* ssqx) {
    if (F.G % 8 != 0) return;
    int lane_o = F.lane; asm volatile("" : "+v"(lane_o));
    const int lane = lane_o, sl = (blockIdx.x & 7) >> 1, rk = (blockIdx.x >> 3) * 2 + (blockIdx.x & 1), NR = F.G >> 2, TPR = T_ / NR;
    const unsigned char* TB = (const unsigned char*)(F.ws + WS_VB) + (size_t)sl * NEXP * P9_SLD + lane * 16;
    const int* ES = (const int*)(F.ws + WS_ES); const float* GS = (const float*)(F.ws + WS_GS); const int* BST = (const int*)(F.ws + WS_BST);
    const float* PART = (const float*)(F.ws + WS_PART); const float* nf = F.in[I_NFIN] + sl * P9_SLD + lane * 16;
    LAS int* EL = (LAS int*)(F.lds + RING_OFF + F.wave * P9_WLDS); LAS float* HL = (LAS float*)(EL + 1024); LAS int* DS = EL + 2048;
#define P9B_SETUP(TB) do { _Pragma("unroll") for (int tk = 0; tk < P9_TPS; ++tk) { const size_t t = (size_t)((TB) + tk); \
            EL[tk * 128 + lane] = ES[t * NSEL + lane]; EL[tk * 128 + 64 + lane] = ES[t * NSEL + 64 + lane]; \
            float a0 = 0.f, a1 = 0.f; \
            _Pragma("unroll") for (int s = 0; s < P9_NSL; ++s) { a0 += PART[((size_t)s * T_ + t) * NSEL + lane]; a1 += PART[((size_t)s * T_ + t) * NSEL + 64 + lane]; } \
            if (DEFER_FFN_NORM) { const float rs_ = ((const float*)(F.ws + WS_RS))[t]; a0 *= rs_; a1 *= rs_; } \
            HL[tk * 128 + lane] = 0.5f * a0 * (1.0f + erff(a0 * 0.70710678118654752f)) * GS[t * NSEL + lane]; HL[tk * 128 + 64 + lane] = 0.5f * a1 * (1.0f + erff(a1 * 0.70710678118654752f)) * GS[t * NSEL + 64 + lane]; } \
        NBP = p9_build_desc<P9_TPS>(BST, (TB), lane, DS); } while (0)
    const int tb0 = rk * TPR + F.wave * P9_TPS, tbe = (rk + 1) * TPR; int NBP = 0;
    f32x2 acc[P9_TPS][8];
    v4u wA[8], wB[8], wC[8];
    if (tb0 < tbe) { P9B_SETUP(tb0); P9_ISSUE(0, wA); P9_ISSUE(1, wB); }
    for (int tb = tb0; tb < tbe; tb += NWAVES * P9_TPS) {
#pragma unroll
        for (int tk = 0; tk < P9_TPS; ++tk)
#pragma unroll
            for (int k = 0; k < 8; ++k) acc[tk][k] = (f32x2){0.f, 0.f};
        for (int i = 0; i < NBP; i += 3) { P9_ISSUE(i + 2, wC); P9_CONSUME(i, wA, P9_CONS_V_TK); P9_ISSUE(i + 3, wA); P9_CONSUME(i + 1, wB, P9_CONS_V_TK); P9_ISSUE(i + 4, wB); P9_CONSUME(i + 2, wC, P9_CONS_V_TK); }
        float ssl[P9_TPS];
        v4u hva[P9_TPS], hvb[P9_TPS];
#pragma unroll
        for (int tk = 0; tk < P9_TPS; ++tk) { const bf16* hrow = (const bf16*)(F.ws + WS_HB) + (size_t)(tb + tk) * DM + sl * P9_SLD + lane * 16; hva[tk] = *(const GAS v4u*)hrow; hvb[tk] = *(const GAS v4u*)(hrow + 8); }
        asm volatile("" ::: "memory");
#pragma unroll
        for (int tk = 0; tk < P9_TPS; ++tk) { const size_t t = (size_t)(tb + tk); float ss = 0.f;
            const v4u hv0 = hva[tk], hv1 = hvb[tk];
#pragma unroll
            for (int c = 0; c < 4; ++c) { const unsigned ha = c == 0 ? hv0.x : c == 1 ? hv0.z : c == 2 ? hv1.x : hv1.z, hb2 = c == 0 ? hv0.y : c == 1 ? hv0.w : c == 2 ? hv1.y : hv1.w; const f32x4 x0 = {bflo(ha), bfhi(ha), bflo(hb2), bfhi(hb2)};
                acc[tk][2 * c].x = x0.x + acc[tk][2 * c].x * (1.0f / PEER_VSCALE); acc[tk][2 * c].y = x0.y + acc[tk][2 * c].y * (1.0f / PEER_VSCALE);
                acc[tk][2 * c + 1].x = x0.z + acc[tk][2 * c + 1].x * (1.0f / PEER_VSCALE); acc[tk][2 * c + 1].y = x0.w + acc[tk][2 * c + 1].y * (1.0f / PEER_VSCALE);
                ss += (acc[tk][2 * c].x * acc[tk][2 * c].x + acc[tk][2 * c].y * acc[tk][2 * c].y) + (acc[tk][2 * c + 1].x * acc[tk][2 * c + 1].x + acc[tk][2 * c + 1].y * acc[tk][2 * c + 1].y); }
            ss = fmaxf(wave_sum(ss), 1e-30f); ssl[tk] = ss;
            if (lane == 0) __hip_atomic_store(ssqx + t * P9_NSL + sl, __float_as_uint(ss), __ATOMIC_RELAXED, __HIP_MEMORY_SCOPE_AGENT); }
        LDS_WAIT();
        if (tb + NWAVES * P9_TPS < tbe) P9B_SETUP(tb + NWAVES * P9_TPS);
        unsigned wv = 1u;
        for (unsigned spin = 0; spin < (1u << 22); ++spin) {
            if (lane < P9_TPS * P9_NSL) wv = __hip_atomic_load(ssqx + (size_t)tb * P9_NSL + lane, __ATOMIC_RELAXED, __HIP_MEMORY_SCOPE_AGENT);
            if (__all(wv != 0u)) break;
            __builtin_amdgcn_s_sleep(2);
        }
        const float wf = (lane < P9_TPS * P9_NSL) ? __uint_as_float(wv) : 0.f;
        if (tb + NWAVES * P9_TPS < tbe) { P9_ISSUE(0, wA); P9_ISSUE(1, wB); }
        f32x4 gq[4];
#pragma unroll
        for (int c = 0; c < 4; ++c) gq[c] = *(const GAS f32x4*)(nf + 4 * c);
        asm volatile("" ::: "memory");
#pragma unroll
        for (int tk = 0; tk < P9_TPS; ++tk) { const size_t t = (size_t)(tb + tk); float* orow = yout + t * DM + sl * P9_SLD + lane * 16;
            float tot = 0.f;
#pragma unroll
            for (int s2 = 0; s2 < P9_NSL; ++s2) tot += (s2 == sl) ? ssl[tk] : __builtin_bit_cast(float, __builtin_amdgcn_readlane(__builtin_bit_cast(int, wf), tk * P9_NSL + s2));
            const float rs = 1.0f / sqrtf(tot * (1.0f / DM) + EPS);
#pragma unroll
            for (int c = 0; c < 4; ++c) { const f32x4 g = gq[c]; f32x4 y;
                y.x = acc[tk][2 * c].x * rs * g.x; y.y = acc[tk][2 * c].y * rs * g.y; y.z = acc[tk][2 * c + 1].x * rs * g.z; y.w = acc[tk][2 * c + 1].y * rs * g.w;
                *(GAS f32x4*)(orow + 4 * c) = y; } }
    }
#undef P9B_SETUP
}

struct Args { const float* in[N_IN]; float* out; unsigned char* ws; int ph_lo, ph_hi; };
static_assert(sizeof(Args) == N_IN * 8 + 8 + 8 + 8, "Args has no padding");
constexpr int N_PHASES = 11;
#ifndef MK_PER_PHASE
#define MK_PER_PHASE 0
#endif
__global__ void __launch_bounds__(NWAVES * 64, 2) fwd(Args args) {
    extern __shared__ __attribute__((aligned(16))) unsigned char lds[];
    Frame F;
    F.lds = (LAS unsigned char*)lds;
    F.MISC = (volatile LAS unsigned*)(F.lds + MISC_OFF);
    F.tid = threadIdx.x; F.lane = F.tid & 63; F.wave = __builtin_amdgcn_readfirstlane(F.tid >> 6);
    F.G = gridDim.x; { const int bx = blockIdx.x; F.vcu = (F.G % 8 == 0) ? (bx % 8) * (F.G / 8) + bx / 8 : bx; }
    F.ws = args.ws; F.out = args.out; F.ctl = (gu32*)(args.ws + WS_CTL);
#pragma unroll
    for (int i = 0; i < N_IN; ++i) F.in[i] = args.in[i];
    for (int u = F.tid; u < (LDS_BYTES - LDSCTL_OFF) / 4; u += NWAVES * 64) ((LAS unsigned*)(F.lds + LDSCTL_OFF))[u] = 0u;
    __syncthreads();
    XcdBarrier bar; bar.bar = (unsigned*)(F.ctl + CW_BAR); bar.x = 0; bar.st = nullptr;
    if (!MK_PER_PHASE) bar = xcd_barrier_post((unsigned*)(F.ctl + CW_BAR), F.MISC + 8);
    const int lo = args.ph_lo, hi = args.ph_hi;
#define IN(k) (lo <= (k) && (k) < hi)
#define SEAM(k) do { if (IN(k) && IN((k) + 1)) xcd_barrier(bar); } while (0)
    bf16* const HN = (bf16*)(F.ws + WS_HN); bf16* const Z = (bf16*)(F.ws + WS_Z); bf16* const BZ = (bf16*)(F.ws + WS_BZ); bf16* const ATT = (bf16*)(F.ws + WS_ATT);
    bf16* const MRG = (bf16*)(F.ws + WS_MRG); bf16* const XN = (bf16*)(F.ws + WS_XN); float* const ST = (float*)(F.ws + WS_ST);

#ifndef REPEAT_PHASE
#define REPEAT_PHASE -1
#endif
#define RUN(k, BODY) do { if (IN(k)) { BODY; if (REPEAT_PHASE == (k)) { xcd_barrier(bar); BODY; } } } while (0)
#define PH_GEMM1 { if (Z8_COL0 > 0) { pg8::Gemm g{HN, (const bf16*)(F.ws + WS_WINT), T_, Z8_COL0, DM, LDP}; pg8::StaticOrder S; S.init(T_, Z8_COL0, F.G, (int)blockIdx.x); pg8::EpiZ E{Z, F.in[I_BGATE], 0, 1.0f}; \
          pg8::gemm_phase<pg8::EpiZ, pg8::StaticOrder, true, true, false>(F.lds + RING_OFF, g, S, E); \
        __syncthreads(); } \
        { pg8::Gemm g{(const bf16*)(F.ws + WS_HN8), (const bf16*)(F.ws + WS_WIN8), T_, INC - Z8_COL0, DM / 2, LDP8}; pg8::StaticOrder S; S.init(T_, INC - Z8_COL0, F.G, (int)blockIdx.x); \
          pg8::EpiZ E{Z, F.in[I_BGATE], Z8_COL0, 1.0f / (HN8_SCALE * WIN8_SCALE)}; \
          pg8::TblHook hk{F.in[I_UEMB], F.in[I_VEMB], (unsigned char*)(F.ws + WS_UB), (unsigned char*)(F.ws + WS_KMEAN), F.vcu * NWAVES + F.wave, F.G * NWAVES}; \
          pg8::gemm_phase<pg8::EpiZ, pg8::StaticOrder, true, true, LOWP, UV_IN_GEMM1>(F.lds + RING_OFF, g, S, E, hk); } }
#define PH_GEMM2_FUSED { pg8::Gemm g{(const bf16*)(F.ws + WS_AC), (const bf16*)(F.ws + WS_WC), T_, DM, DM / 2, LDP8}; pg8::StaticOrder S; S.init(T_, DM, F.G, (int)blockIdx.x); \
        pg8::EpiMerge E{Z + ZC_GC, (unsigned char*)(F.ws + WS_MRG8)}; static_assert(CONVOUT_FP8 && GEMM3_FP8 && PROJ_INT8 && BZ8_SCALE * WCO8_SCALE * 4.f == ATT8_SCALE * WAO8_SCALE && ATT8_SCALE * WAO8_SCALE == 32768.f && MRG8_SCALE == 32.f && ZC_GA - ZC_GC == 4096, "EpiMerge constants"); \
        pg8::gemm_phase<pg8::EpiMerge, pg8::StaticOrder, true, true, 1>(F.lds + RING_OFF, g, S, E); }
#define PH_GEMM2_SPLIT { { pg8::Gemm g{BZ, (const bf16*)(F.ws + WS_WCOT), T_, DM, (CONVOUT_INT8 || CONVOUT_FP8) ? CD / 2 : CD, (CONVOUT_INT8 || CONVOUT_FP8) ? LDH8 : LDH}; pg8::StaticOrder S; S.init(T_, DM, F.G, (int)blockIdx.x); \
          typedef pg8::EpiGate<0, LDP, 2 * LDP8, (CONVOUT_INT8 || CONVOUT_FP8) ? 13 : 0, 0> EG0; EG0 E{MRG, Z + ZC_GC, nullptr}; static_assert(BZ8_SCALE * WCO8_SCALE == 8192.f, "EpiGate shift"); \
          pg8::gemm_phase<EG0, pg8::StaticOrder, true, true, CONVOUT_FP8 ? 1 : (CONVOUT_INT8 ? 2 : 0)>(F.lds + RING_OFF, g, S, E); } \
        __syncthreads(); \
        { pg8::Gemm g{ATT, (const bf16*)(F.ws + WS_WAO8), T_, DM, AD / 2, LDH8}; pg8::StaticOrder S; S.init(T_, DM, F.G, (int)blockIdx.x); typedef pg8::EpiGate<GEMM3_FP8 ? (PROJ_INT8 ? 3 : 2) : 1, LDP, 2 * LDP8, 15, 5> EG1; EG1 E{MRG, Z + ZC_GA, (unsigned char*)(F.ws + WS_MRG8)}; static_assert(ATT8_SCALE * WAO8_SCALE == 32768.f && MRG8_SCALE == 32.f, "EpiGate shifts"); \
          pg8::gemm_phase<EG1, pg8::StaticOrder, true, true, true>(F.lds + RING_OFF, g, S, E); } }
#define PH_GEMM3 { pg8::Gemm g{GEMM3_FP8 ? (const bf16*)(F.ws + WS_MRG8) : MRG, (const bf16*)(F.ws + WS_WOT), T_, DM, GEMM3_FP8 ? DM / 2 : DM, GEMM3_FP8 ? LDP8 : LDP}; pg8::StaticOrder S; S.init(T_, DM, F.G, (int)blockIdx.x); \
        if constexpr (DEFER_FFN_NORM) { typedef pg8::EpiHQ<HQ_SCALE, 2 * LDP8, WS_XN, WS_SSQP> EHQ; EHQ E{(bf16*)(F.ws + WS_HB), F.in[I_X], F.in[I_NFFN], F.ws, GEMM3_FP8 ? 1.0f / (MRG8_SCALE * WO8_SCALE) : 1.0f}; \
            pg8::gemm_phase<EHQ, pg8::StaticOrder, true, true, GEMM3_FP8 ? LOWP : 0>(F.lds + RING_OFF, g, S, E); } \
        else { pg8::EpiHB E{(bf16*)(F.ws + WS_HB), F.in[I_X], GEMM3_FP8 ? 1.0f / (MRG8_SCALE * WO8_SCALE) : 1.0f}; \
        pg8::gemm_phase<pg8::EpiHB, pg8::StaticOrder, true, true, GEMM3_FP8 ? LOWP : 0>(F.lds + RING_OFF, g, S, E); } }
#define PH_GEMM4 { pg8::Gemm g{(const bf16*)(F.ws + WS_WPQF), XN, 2048, T_, SCORES_INT8 ? DM / 2 : DM, SCORES_INT8 ? LDP8 : LDP}; pg8::StaticOrder S; S.init(2048, T_, F.G, (int)blockIdx.x); \
        pg8::EpiF32R E{ST, T_, nullptr, SCORES_INT8 ? 1.0f / (XN8_SCALE * WPQ8_SCALE) : 1.0f}; \
        pg8::gemm_phase<pg8::EpiF32R, pg8::StaticOrder, true, true, SCORES_INT8 ? 2 : 0>(F.lds + RING_OFF, g, S, E); }
    RUN(0, p0_prologue(F)); SEAM(0);
    RUN(1, PH_GEMM1); SEAM(1);
    RUN(2, p2_conv_kmean(F)); SEAM(2);
    RUN(3, p3_attention(F, (char*)lds + RING_OFF)); SEAM(3);
#if GEMM2_FUSED
    RUN(4, PH_GEMM2_FUSED); SEAM(4);
#else
    RUN(4, PH_GEMM2_SPLIT); SEAM(4);
#endif
    RUN(5, PH_GEMM3); SEAM(5);
#if !DEFER_FFN_NORM
    RUN(6, p6_rms(F)); SEAM(6);
#endif
    RUN(7, PH_GEMM4); SEAM(7);
    RUN(8, p8_topk(F)); SEAM(8);
    RUN(9, p9a_peer_u(F)); SEAM(9);
    if (IN(10)) {
        if (REPEAT_PHASE == 10) { p9b_peer_v(F, (float*)(F.ws + WS_WINT), (unsigned*)(F.ctl + CW_SSQX)); xcd_barrier(bar); }
        p9b_peer_v(F, F.out, (unsigned*)(F.ctl + CW_SSQX));
    }
#undef IN
#undef SEAM
}

extern "C" void kernel_launch(void* const* d_in, const int* in_sizes, int n_in, void* d_out, int out_size, void* d_ws, size_t ws_size, hipStream_t stream) {
    static int grid = 0;
    if (grid == 0) {
        if (n_in != N_IN || in_sizes[0] != T_ * DM || out_size != T_ * DM || ws_size < WS_END) { fprintf(stderr, "kernel_launch: shape mismatch (n_in %d in0 %d out %d ws %zu)\n", n_in, n_in > 0 ? in_sizes[0] : -1, out_size, ws_size); grid = -1; return; }
        int dev = 0, cus = 0, per_cu = 0;
        if (hipGetDevice(&dev) != hipSuccess || hipDeviceGetAttribute(&cus, hipDeviceAttributeMultiprocessorCount, dev) != hipSuccess) { grid = -1; return; }
        if (hipFuncSetAttribute((const void*)fwd, hipFuncAttributeMaxDynamicSharedMemorySize, LDS_BYTES) != hipSuccess) { fprintf(stderr, "kernel_launch: hipFuncSetAttribute failed\n"); grid = -1; return; }
        if (hipOccupancyMaxActiveBlocksPerMultiprocessor(&per_cu, (const void*)fwd, NWAVES * 64, LDS_BYTES) != hipSuccess || per_cu < 1)
            fprintf(stderr, "kernel_launch: note: occupancy query reports %d workgroups per CU\n", per_cu);
        (void)hipGetLastError();
        grid = cus;
    }
    if (grid < 0) return;
    if (hipMemsetAsync((char*)d_ws + WS_CTL, 0, CTL_ZERO_BYTES, stream) != hipSuccess) return;
    Args a{};
    for (int i = 0; i < N_IN; ++i) a.in[i] = (const float*)d_in[i];
    a.out = (float*)d_out; a.ws = (unsigned char*)d_ws;
#if MK_PER_PHASE
    for (int p = 0; p < N_PHASES; ++p) { a.ph_lo = p; a.ph_hi = p + 1; hipLaunchKernelGGL(fwd, dim3(grid), dim3(NWAVES * 64), LDS_BYTES, stream, a); }
#else
    a.ph_lo = 0; a.ph_hi = N_PHASES;
    hipLaunchKernelGGL(fwd, dim3(grid), dim3(NWAVES * 64), LDS_BYTES, stream, a);
#endif
    const hipError_t le = hipPeekAtLastError();
    if (le != hipSuccess) fprintf(stderr, "kernel_launch: launch failed: %s\n", hipGetErrorName(le));
}
```

```cpp
#include <hip/hip_runtime.h>
#include <cstdio>
#include <cstdint>
#ifndef RELAX_EPI
#define RELAX_EPI 0
#endif
namespace pg8 {
#define PG8_LAS __attribute__((address_space(3)))
typedef unsigned short bf16_t;
typedef short bf16x8 __attribute__((ext_vector_type(8)));
typedef float f32x4 __attribute__((ext_vector_type(4)));
typedef unsigned u32x4 __attribute__((ext_vector_type(4)));
constexpr int BM = 256, BK = 64, HALF = 128, HTB = HALF * BK * 2  , STAGE_BYTES = 8 * HTB, NXCD = 8, WGM = 8;

__host__ __device__ __forceinline__ int lds_byte(int r, int c) { const int st = (r >> 4) * 2 + (c >> 5), rr = r & 15, cc = c & 31, ob = rr * 64 + cc * 2; return st * 1024 + (ob ^ (((ob >> 9) & 1) << 5)); }
__host__ __device__ __forceinline__ void stage_rc(int b, int& R, int& C) { const int st = b / 1024, sb = b % 1024, swz = sb ^ (((sb >> 9) & 1) << 5); R = (st >> 1) * 16 + swz / 64; C = (st & 1) * 32 + (swz % 64) / 2; }
__host__ __device__ __forceinline__ int perm32(int rho) { const int n = rho >> 4, i = rho & 15; return 8 * (i >> 2) + 4 * n + (i & 3); }

struct Unit { int pm, pn; };
struct Gemm { const bf16_t* A; const bf16_t* Bt; int M, N, K, ld; };

struct StaticOrder {
    int nM, nN, nwg, G, c;
    __host__ __device__ void init(int M, int N, int G_, int c_) { nM = M / BM; nN = N / BM; nwg = nM * nN; G = G_; c = c_; }
    __host__ __device__ bool next(int i, Unit& u) const {
        const long L = (long)i * G + c; if (L >= nwg) return false;
        int wgid = (int)L; { const int q = nwg / NXCD, r = nwg % NXCD, xcd = wgid % NXCD, off = wgid / NXCD; wgid = (xcd < r ? xcd * (q + 1) : r * (q + 1) + (xcd - r) * q) + off; }
        const int nig = WGM * nN, gid = wgid / nig, fm = gid * WGM, gsz = (nM - fm) < WGM ? (nM - fm) : WGM;
        u.pm = fm + ((wgid % nig) % gsz); u.pn = (wgid % nig) / gsz; return true;
    }
    __device__ __forceinline__ void a_ready(const Unit&) const {}
    __device__ __forceinline__ void done(const Unit&) const {}
};

constexpr int HK_NCHUNK = 262144, HK_HALF = 131072; constexpr float HK_USCALE = 1024.0f, HK_VSCALE = 16.0f;
struct TblHook { const float* u; const float* v; unsigned char* ub; unsigned char* dummy; int gwave, ngw; };
constexpr int HK_LDS_OFF = 131584;
__device__ __forceinline__ void hook_issue(const TblHook& h, int it, int lane, PG8_LAS unsigned char* slot) {
    const int q = __builtin_amdgcn_readfirstlane(it * h.ngw + h.gwave); const int qq = q < HK_NCHUNK ? q : 0; const bool isu = qq < HK_HALF; const int j = isu ? qq : qq - HK_HALF;
    const __amdgpu_buffer_rsrc_t r = __builtin_amdgcn_make_buffer_rsrc((void*)(isu ? h.u : h.v), (short)0, 0x7fffffff, 0x00020000);
    const unsigned so = (unsigned)j * 2048u, l16 = (unsigned)lane * 16u;
    __builtin_amdgcn_raw_ptr_buffer_load_lds(r, (PG8_LAS void*)slot, 16, l16, so, 0, 0);
    __builtin_amdgcn_raw_ptr_buffer_load_lds(r, (PG8_LAS void*)(slot + 1024), 16, l16, so + 1024u, 0, 0);
}
__device__ __forceinline__ unsigned hook_u8(const f32x4 a) {
    const float lim = 127.0f / HK_USCALE; unsigned y[4];
#pragma unroll
    for (int i = 0; i < 4; ++i) y[i] = __float_as_uint(__builtin_fmaf(__builtin_amdgcn_fmed3f(a[i], -lim, lim), HK_USCALE, 12582912.0f));
    const unsigned lo = __builtin_amdgcn_perm(y[1], y[0], 0x0c0c0400u), hi = __builtin_amdgcn_perm(y[3], y[2], 0x04000c0cu);
    return lo | hi;
}
__device__ __forceinline__ unsigned hook_f8(const f32x4 a) { int w = __builtin_amdgcn_cvt_pk_fp8_f32(a[0] * HK_VSCALE, a[1] * HK_VSCALE, 0, false); return (unsigned)__builtin_amdgcn_cvt_pk_fp8_f32(a[2] * HK_VSCALE, a[3] * HK_VSCALE, w, true); }
__device__ __forceinline__ void hook_store(const TblHook& h, int it, int lane, const f32x4 a, const f32x4 b) {
    const int q = __builtin_amdgcn_readfirstlane(it * h.ngw + h.gwave); const bool act = q < HK_NCHUNK; const int qq = act ? q : 0;
    const bool isu = qq < HK_HALF; const int j = isu ? qq : qq - HK_HALF; const int e = j >> 3, c512 = j & 7, sl = c512 >> 1, c0 = (c512 & 1) * 512;
    unsigned char* dt = h.ub + (isu ? (size_t)0 : ((size_t)64 << 20)) + ((size_t)sl * 16384 + e) * 1024 + c0;
    unsigned char* d = act ? dt : h.dummy + (size_t)h.gwave * 512;
    const unsigned l4 = (unsigned)lane * 4u; unsigned w0, w1;
    if (isu) { w0 = hook_u8(a); w1 = hook_u8(b); } else { w0 = hook_f8(a); w1 = hook_f8(b); }
    *(unsigned*)(d + l4) = w0; *(unsigned*)(d + 256 + l4) = w1;
}
__device__ __forceinline__ void hook_store8(const TblHook& h, int it, int lane, const f32x4 a, const f32x4 b) {
    const int q = __builtin_amdgcn_readfirstlane(it * h.ngw + h.gwave); const bool act = q < HK_NCHUNK; const int qq = act ? q : 0;
    const bool isu = qq < HK_HALF; const int j = isu ? qq : qq - HK_HALF; const int e = j >> 3, c512 = j & 7, sl = c512 >> 1, c0 = (c512 & 1) * 512;
    unsigned char* dt = h.ub + (isu ? (size_t)0 : ((size_t)64 << 20)) + ((size_t)sl * 16384 + e) * 1024 + c0;
    unsigned char* d = act ? dt : h.dummy + (size_t)h.gwave * 512;
    typedef unsigned hk_u2 __attribute__((ext_vector_type(2))); hk_u2 w;
    if (isu) { w.x = hook_u8(a); w.y = hook_u8(b); } else { w.x = hook_f8(a); w.y = hook_f8(b); }
    *(hk_u2*)(d + (unsigned)lane * 8u) = w;
}
__device__ __forceinline__ unsigned cvt_pk_bf16(float lo, float hi) { unsigned r; asm volatile("v_cvt_pk_bf16_f32 %0, %1, %2" : "=v"(r) : "v"(lo), "v"(hi)); return r; }
typedef float f32x2 __attribute__((ext_vector_type(2)));
__device__ __forceinline__ float bf_lo(unsigned w) { return __uint_as_float(w << 16); }
__device__ __forceinline__ float bf_hi(unsigned w) { return __uint_as_float(w & 0xffff0000u); }
__device__ __forceinline__ float sigm(float x) { return __builtin_amdgcn_rcpf(1.0f + __builtin_amdgcn_exp2f(-1.4426950408889634f * x)); }
typedef int v8i32 __attribute__((ext_vector_type(8))); typedef int v4i32 __attribute__((ext_vector_type(4)));
__device__ __forceinline__ v8i32 cat8(bf16x8 a, bf16x8 b) { const v4i32 x = __builtin_bit_cast(v4i32, a), y = __builtin_bit_cast(v4i32, b); return (v8i32){x[0], x[1], x[2], x[3], y[0], y[1], y[2], y[3]}; }
constexpr int ZLD = 20480;
constexpr int ZGATE0 = 12288;
struct EpiZ {
    static constexpr bool PERM = true, AFTER_DRAIN = false, HAS_MID = false; static constexpr int NSTORE = 16;
    bf16_t* Z; const float* bgate; int col_off; float scale;
    __device__ __forceinline__ void operator()(const f32x4 (&acc)[2][2][4][2], const Unit& u, int wr, int wc, int fr, int fq) const {
        const int row0 = u.pm * BM + wr * 64 + fr, col0 = col_off + u.pn * BM + wc * 32 + 8 * fq;
        const bool gate = (col_off + u.pn * BM) >= ZGATE0;
        f32x4 bv[2][2];
#pragma unroll
        for (int bj = 0; bj < 2; ++bj)
#pragma unroll
            for (int n = 0; n < 2; ++n) bv[bj][n] = gate ? *(const f32x4*)(bgate + (col0 - ZGATE0) + bj * HALF + 4 * n) : (f32x4){0.f, 0.f, 0.f, 0.f};
#pragma unroll
        for (int ai = 0; ai < 2; ++ai)
#pragma unroll
            for (int m = 0; m < 4; ++m) { bf16_t* rowp = Z + (size_t)(row0 + ai * HALF + m * 16) * ZLD + col0;
#pragma unroll
                for (int bj = 0; bj < 2; ++bj) { f32x4 v0 = acc[ai][bj][m][0] * scale + bv[bj][0], v1 = acc[ai][bj][m][1] * scale + bv[bj][1];
                    if (gate) {
#pragma unroll
                        for (int j = 0; j < 4; ++j) { v0[j] = sigm(v0[j]); v1[j] = sigm(v1[j]); } }
                    u32x4 w; w.x = cvt_pk_bf16(v0[0], v0[1]); w.y = cvt_pk_bf16(v0[2], v0[3]); w.z = cvt_pk_bf16(v1[0], v1[1]); w.w = cvt_pk_bf16(v1[2], v1[3]);
                    *(u32x4*)(rowp + bj * HALF) = w; } }
    }
};
template <int MODE, int ldo, int ldo8, int ACC_SHIFT, int OUT_SHIFT> struct EpiGate {
    static constexpr bool PERM = true, AFTER_DRAIN = false, HAS_MID = false; static constexpr int NSTORE = 16;
    static constexpr float scale = 1.0f / (float)(1 << ACC_SHIFT), oscale = (float)(1 << OUT_SHIFT);
    bf16_t* O; const bf16_t* Zg; unsigned char* O8;
    __device__ __forceinline__ void operator()(const f32x4 (&acc)[2][2][4][2], const Unit& u, int wr, int wc, int fr, int fq) const {
        const int row0 = u.pm * BM + wr * 64 + fr, col0 = u.pn * BM + wc * 32 + 8 * fq;
#pragma unroll
        for (int ai = 0; ai < 2; ++ai)
#pragma unroll
            for (int m = 0; m < 4; ++m) { const size_t r = (size_t)(row0 + ai * HALF + m * 16); bf16_t* rowp = O + r * ldo + col0; const bf16_t* gp = Zg + r * ZLD + col0;
#pragma unroll
                for (int bj = 0; bj < 2; ++bj) { const u32x4 g = *(const u32x4*)(gp + bj * HALF); const f32x4 v0 = acc[ai][bj][m][0] * scale, v1 = acc[ai][bj][m][1] * scale;
                    float o0 = v0[0] * bf_lo(g.x), o1 = v0[1] * bf_hi(g.x), o2 = v0[2] * bf_lo(g.y), o3 = v0[3] * bf_hi(g.y);
                    float o4 = v1[0] * bf_lo(g.z), o5 = v1[1] * bf_hi(g.z), o6 = v1[2] * bf_lo(g.w), o7 = v1[3] * bf_hi(g.w);
                    if (MODE >= 1) { const u32x4 p = *(const u32x4*)(rowp + bj * HALF);
                        o0 += bf_lo(p.x); o1 += bf_hi(p.x); o2 += bf_lo(p.y); o3 += bf_hi(p.y); o4 += bf_lo(p.z); o5 += bf_hi(p.z); o6 += bf_lo(p.w); o7 += bf_hi(p.w); }
                    if (MODE == 3) {
                        int q_[8]; const float ov_[8] = {o0, o1, o2, o3, o4, o5, o6, o7};
#pragma unroll
                        for (int j = 0; j < 8; ++j) { int q = __float2int_rn(ov_[j] * oscale); q_[j] = (q < -127 ? -127 : (q > 127 ? 127 : q)) & 0xff; }
                        typedef unsigned u32x2e __attribute__((ext_vector_type(2))); u32x2e w8; w8.x = (unsigned)(q_[0] | (q_[1] << 8) | (q_[2] << 16) | (q_[3] << 24)); w8.y = (unsigned)(q_[4] | (q_[5] << 8) | (q_[6] << 16) | (q_[7] << 24));
                        *(u32x2e*)(O8 + r * ldo8 + col0 + bj * HALF) = w8; }
                    if (MODE == 2) {
                        int w0 = __builtin_amdgcn_cvt_pk_fp8_f32(o0 * oscale, o1 * oscale, 0, false); w0 = __builtin_amdgcn_cvt_pk_fp8_f32(o2 * oscale, o3 * oscale, w0, true);
                        int w1 = __builtin_amdgcn_cvt_pk_fp8_f32(o4 * oscale, o5 * oscale, 0, false); w1 = __builtin_amdgcn_cvt_pk_fp8_f32(o6 * oscale, o7 * oscale, w1, true);
                        typedef unsigned u32x2e __attribute__((ext_vector_type(2))); u32x2e w8; w8.x = (unsigned)w0; w8.y = (unsigned)w1;
                        *(u32x2e*)(O8 + r * ldo8 + col0 + bj * HALF) = w8; }
                    if (MODE < 2) { u32x4 w; w.x = cvt_pk_bf16(o0, o1); w.y = cvt_pk_bf16(o2, o3); w.z = cvt_pk_bf16(o4, o5); w.w = cvt_pk_bf16(o6, o7);
                        *(u32x4*)(rowp + bj * HALF) = w; } } }
    }
};
struct EpiF32R {
    static constexpr bool PERM = false, AFTER_DRAIN = false, HAS_MID = false; static constexpr int NSTORE = 32;
    float* C; int ldc; const float* R; float scale;
    __device__ __forceinline__ void operator()(const f32x4 (&acc)[2][2][4][2], const Unit& u, int wr, int wc, int fr, int fq) const {
        const int row0 = u.pm * BM + wr * 64 + fr, col0 = u.pn * BM + wc * 32 + 4 * fq;
#pragma unroll
        for (int ai = 0; ai < 2; ++ai)
#pragma unroll
            for (int m = 0; m < 4; ++m) { const size_t off = (size_t)(row0 + ai * HALF + m * 16) * ldc + col0;
#pragma unroll
                for (int bj = 0; bj < 2; ++bj)
#pragma unroll
                    for (int n = 0; n < 2; ++n) { f32x4 v = acc[ai][bj][m][n] * scale; if (R) v += *(const f32x4*)(R + off + bj * HALF + n * 16); *(f32x4*)(C + off + bj * HALF + n * 16) = v; } }
    }
};

struct EpiHB {
    static constexpr bool PERM = false, AFTER_DRAIN = false, HAS_MID = false; static constexpr int NSTORE = 32;
    bf16_t* HB; const float* R; float scale;
    __device__ __forceinline__ void operator()(const f32x4 (&acc)[2][2][4][2], const Unit& u, int wr, int wc, int fr, int fq) const {
        const int row0 = u.pm * BM + wr * 64 + fr, col0 = u.pn * BM + wc * 32 + 4 * fq;
        typedef unsigned u32x2e __attribute__((ext_vector_type(2)));
#pragma unroll
        for (int ai = 0; ai < 2; ++ai)
#pragma unroll
            for (int m = 0; m < 4; ++m) { const size_t off = (size_t)(row0 + ai * HALF + m * 16) * 4096 + col0;
#pragma unroll
                for (int bj = 0; bj < 2; ++bj)
#pragma unroll
                    for (int n = 0; n < 2; ++n) { const f32x4 v = acc[ai][bj][m][n] * scale + *(const f32x4*)(R + off + bj * HALF + n * 16);
                        u32x2e w; w.x = cvt_pk_bf16(v[0], v[1]); w.y = cvt_pk_bf16(v[2], v[3]); *(u32x2e*)(HB + off + bj * HALF + n * 16) = w; } }
    }
};

__device__ __forceinline__ unsigned q8x4(const f32x4 a, const f32x4 g, float s) {
    unsigned y[4];
#pragma unroll
    for (int i = 0; i < 4; ++i) y[i] = __float_as_uint(__builtin_fmaf(__builtin_amdgcn_fmed3f(a[i] * g[i] * s, -127.0f, 127.0f), 1.0f, 12582912.0f));
    return __builtin_amdgcn_perm(y[1], y[0], 0x0c0c0400u) | __builtin_amdgcn_perm(y[3], y[2], 0x04000c0cu);
}
template <int HQS, int LDQ8  , size_t OFF_Q8, size_t OFF_SSQP> struct EpiHQ {
    static constexpr bool PERM = true, AFTER_DRAIN = false, HAS_MID = false; static constexpr int NSTORE = 32;
    bf16_t* HB; const float* R; const float* gain; unsigned char* ws; float scale;
    __device__ __forceinline__ void operator()(const f32x4 (&acc)[2][2][4][2], const Unit& u, int wr, int wc, int fr, int fq) const {
        const int row0 = u.pm * BM + wr * 64 + fr, col0 = u.pn * BM + wc * 32 + 8 * fq;
        typedef unsigned u32x2e __attribute__((ext_vector_type(2)));
        f32x4 gv[2][2];
#pragma unroll
        for (int bj = 0; bj < 2; ++bj)
#pragma unroll
            for (int n = 0; n < 2; ++n) gv[bj][n] = *(const f32x4*)(gain + col0 + bj * HALF + 4 * n);
        float* SSQP = (float*)(ws + OFF_SSQP); unsigned char* Q8 = ws + OFF_Q8;
#pragma unroll
        for (int ai = 0; ai < 2; ++ai)
#pragma unroll
            for (int m = 0; m < 4; ++m) { const size_t r = (size_t)(row0 + ai * HALF + m * 16); float ss = 0.f;
#pragma unroll
                for (int bj = 0; bj < 2; ++bj) { const size_t off = r * 4096 + col0 + bj * HALF;
                    const f32x4 v0 = acc[ai][bj][m][0] * scale + *(const f32x4*)(R + off), v1 = acc[ai][bj][m][1] * scale + *(const f32x4*)(R + off + 4);
                    ss += (v0[0] * v0[0] + v0[1] * v0[1]) + (v0[2] * v0[2] + v0[3] * v0[3]) + (v1[0] * v1[0] + v1[1] * v1[1]) + (v1[2] * v1[2] + v1[3] * v1[3]);
                    u32x4 w; w.x = cvt_pk_bf16(v0[0], v0[1]); w.y = cvt_pk_bf16(v0[2], v0[3]); w.z = cvt_pk_bf16(v1[0], v1[1]); w.w = cvt_pk_bf16(v1[2], v1[3]);
                    *(u32x4*)(HB + off) = w;
                    u32x2e q; q.x = q8x4(v0, gv[bj][0], (float)HQS); q.y = q8x4(v1, gv[bj][1], (float)HQS);
                    *(u32x2e*)(Q8 + r * LDQ8 + col0 + bj * HALF) = q; }
                ss += __shfl_xor(ss, 16); ss += __shfl_xor(ss, 32);
                if (fq == 0) SSQP[r * 64 + u.pn * 4 + wc] = ss; }
    }
};

struct EpiMerge {
    static constexpr bool PERM = true, AFTER_DRAIN = false, HAS_MID = true; static constexpr int NSTORE = 16;
    const bf16_t* Zgc; unsigned char* O8;
    static constexpr int ldo8 = 4224;
    __device__ __forceinline__ void mid(f32x4 (&acc)[2][2][4][2], const Unit& u, int wr, int wc, int fr, int fq) const {
        asm volatile("" : "+v"(fr), "+v"(fq));
        const int row0 = u.pm * BM + wr * 64 + fr, col0 = u.pn * BM + wc * 32 + 8 * fq;
#pragma unroll
        for (int ai = 0; ai < 2; ++ai)
#pragma unroll
            for (int m = 0; m < 4; ++m) { const bf16_t* gp = Zgc + (size_t)(row0 + ai * HALF + m * 16) * ZLD + col0;
#pragma unroll
                for (int bj = 0; bj < 2; ++bj) { const u32x4 c = *(const u32x4*)(gp + bj * HALF), a = *(const u32x4*)(gp + 4096 + bj * HALF);
                    f32x4 r0, r1;
                    r0[0] = 4.0f * bf_lo(c.x) * __builtin_amdgcn_rcpf(bf_lo(a.x)); r0[1] = 4.0f * bf_hi(c.x) * __builtin_amdgcn_rcpf(bf_hi(a.x)); r0[2] = 4.0f * bf_lo(c.y) * __builtin_amdgcn_rcpf(bf_lo(a.y)); r0[3] = 4.0f * bf_hi(c.y) * __builtin_amdgcn_rcpf(bf_hi(a.y));
                    r1[0] = 4.0f * bf_lo(c.z) * __builtin_amdgcn_rcpf(bf_lo(a.z)); r1[1] = 4.0f * bf_hi(c.z) * __builtin_amdgcn_rcpf(bf_hi(a.z)); r1[2] = 4.0f * bf_lo(c.w) * __builtin_amdgcn_rcpf(bf_lo(a.w)); r1[3] = 4.0f * bf_hi(c.w) * __builtin_amdgcn_rcpf(bf_hi(a.w));
                    acc[ai][bj][m][0] *= r0; acc[ai][bj][m][1] *= r1; }
                if (m == 3) __builtin_amdgcn_sched_barrier(0); }
    }
    __device__ __forceinline__ void operator()(const f32x4 (&acc)[2][2][4][2], const Unit& u, int wr, int wc, int fr, int fq) const {
        const int row0 = u.pm * BM + wr * 64 + fr, col0 = u.pn * BM + wc * 32 + 8 * fq;
        typedef unsigned u32x2e __attribute__((ext_vector_type(2)));
#pragma unroll
        for (int ai = 0; ai < 2; ++ai)
#pragma unroll
            for (int m = 0; m < 4; ++m) { const size_t r = (size_t)(row0 + ai * HALF + m * 16); const bf16_t* gp = Zgc + r * ZLD + col0 + 4096;
                u32x4 ab[2];
#pragma unroll
                for (int bj = 0; bj < 2; ++bj) ab[bj] = *(const u32x4*)(gp + bj * HALF);
#pragma unroll
                for (int bj = 0; bj < 2; ++bj) { const u32x4 a = ab[bj];
                    const f32x4 g0 = {bf_lo(a.x), bf_hi(a.x), bf_lo(a.y), bf_hi(a.y)}, g1 = {bf_lo(a.z), bf_hi(a.z), bf_lo(a.w), bf_hi(a.w)};
                    u32x2e q; q.x = q8x4(acc[ai][bj][m][0], g0, 32.0f / 32768.0f); q.y = q8x4(acc[ai][bj][m][1], g1, 32.0f / 32768.0f);
                    *(u32x2e*)(O8 + r * ldo8 + col0 + bj * HALF) = q; } }
    }
};
template <class Epi, class Sched, bool ALIGN_EPI = false, bool SP2 = false, int FP8 = 0  , int HOOK = 0  >
__device__ __forceinline__ void gemm_phase(PG8_LAS unsigned char* lds, const Gemm g, const Sched& S, const Epi& E, const TblHook hk = TblHook{}) {
    const int tid = threadIdx.x, wid = __builtin_amdgcn_readfirstlane(tid >> 6), lane = tid & 63, wr = wid >> 2, wc = wid & 3, fr = lane & 15, fq = lane >> 4;
    const int K = g.K, nt = K / BK, LD = g.ld;
    unsigned voffA[2], voffB[2];
#pragma unroll
    for (int i = 0; i < 2; ++i) { int R, C; stage_rc(tid * 16 + i * 8192, R, C); const int Rb = Epi::PERM ? ((R & ~31) + perm32(R & 31)) : R;
        voffA[i] = (unsigned)(R * LD + C) * 2u; voffB[i] = (unsigned)(Rb * LD + C) * 2u; }
    const unsigned kstep = (unsigned)(BK * 2);
    const unsigned hstep = (unsigned)HALF * LD * 2;
    const unsigned tstep = 2 * hstep;
    const __amdgpu_buffer_rsrc_t rA = __builtin_amdgcn_make_buffer_rsrc((void*)g.A, (short)0, 0x7fffffff, 0x00020000), rB = __builtin_amdgcn_make_buffer_rsrc((void*)g.Bt, (short)0, 0x7fffffff, 0x00020000);
    const unsigned ldsw = (unsigned)wid * 1024u;
    const int aoff = lds_byte(wr * 64 + fr, fq * 8), boff = lds_byte(wc * 32 + fr, fq * 8);
#define PG8_SA(b, h) (((b) * 2 + (h)) * HTB)
#define PG8_SB(b, h) ((4 + (b) * 2 + (h)) * HTB)
#define PG8_STAGE(bufoff, rsrc, soff, voff) do { _Pragma("unroll") for (int _i = 0; _i < 2; ++_i) \
        __builtin_amdgcn_raw_ptr_buffer_load_lds(rsrc, (PG8_LAS void*)(lds + (bufoff) + ldsw + _i * 8192), 16, (voff)[_i], (soff), 0, 0); } while (0)
#define PG8_LDA(dst, b, h) do { _Pragma("unroll") for (int m = 0; m < 4; ++m) _Pragma("unroll") for (int k = 0; k < 2; ++k) dst[m][k] = *(const PG8_LAS bf16x8*)(lds + PG8_SA(b, h) + aoff + m * 2048 + k * 1024); } while (0)
#define PG8_LDB(dst, b, h) do { _Pragma("unroll") for (int n = 0; n < 2; ++n) _Pragma("unroll") for (int k = 0; k < 2; ++k) dst[n][k] = *(const PG8_LAS bf16x8*)(lds + PG8_SB(b, h) + boff + n * 2048 + k * 1024); } while (0)
#define PG8_MMA(ai, bj, At, Bt) do { __builtin_amdgcn_s_setprio(1); _Pragma("unroll") for (int m = 0; m < 4; ++m) _Pragma("unroll") for (int n = 0; n < 2; ++n) { \
        if constexpr (FP8 == 2) { _Pragma("unroll") for (int k = 0; k < 2; ++k) asm volatile("v_mfma_i32_16x16x64_i8 %0, %1, %2, %0" : "+v"(acc[ai][bj][m][n]) : "v"(Bt[n][k]), "v"(At[m][k]));   } \
        else if constexpr (FP8 == 1) { const v8i32 b8_ = cat8(Bt[n][0], Bt[n][1]), a8_ = cat8(At[m][0], At[m][1]);   \
            asm volatile("v_mfma_scale_f32_16x16x128_f8f6f4 %0, %1, %2, %0, %3, %3 op_sel_hi:[0,0,0]" : "+v"(acc[ai][bj][m][n]) : "v"(b8_), "v"(a8_), "v"(one_scale)); } \
        else { _Pragma("unroll") for (int k = 0; k < 2; ++k) asm volatile("v_mfma_f32_16x16x32_bf16 %0, %1, %2, %0" : "+v"(acc[ai][bj][m][n]) : "v"(Bt[n][k]), "v"(At[m][k])); } } __builtin_amdgcn_s_setprio(0); } while (0)
#define PG8_WAIT_V(n) asm volatile("s_waitcnt vmcnt(" #n ")" ::: "memory")
#define PG8_WAIT_VI(n) asm volatile("s_waitcnt vmcnt(%0)" :: "n"(n) : "memory")
#define PG8_WAIT_L(n) asm volatile("s_waitcnt lgkmcnt(" #n ")" ::: "memory")
#define PG8_BAR __builtin_amdgcn_s_barrier()
#define PG8_SCHED __builtin_amdgcn_sched_barrier(0)
    Unit cur, nxt; int ui = 0; int hit = 0;
#define PG8_HOOK_REST do { if constexpr (HOOK) { for (; hit * hk.ngw + hk.gwave < HK_NCHUNK; ++hit) { const int q_ = hit * hk.ngw + hk.gwave; const float* hp_ = (q_ < HK_HALF ? hk.u + (size_t)q_ * 512 : hk.v + (size_t)(q_ - HK_HALF) * 512) + lane * 4; \
        const f32x4 a_ = *(const f32x4*)hp_, b_ = *(const f32x4*)(hp_ + 256); hook_store(hk, hit, lane, a_, b_); } } } while (0)
    if (!S.next(0, cur)) { PG8_HOOK_REST; return; }
    const int one_scale = 0x7f7f7f7f;
    f32x4 acc[2][2][4][2];
#pragma unroll
    for (int a = 0; a < 2; ++a)
#pragma unroll
        for (int b = 0; b < 2; ++b)
#pragma unroll
            for (int m = 0; m < 4; ++m)
#pragma unroll
                for (int n = 0; n < 2; ++n) acc[a][b][m][n] = (f32x4){0.f, 0.f, 0.f, 0.f};
    bf16x8 At[4][2], B0[2][2], B1[2][2];
    unsigned cA = (unsigned)cur.pm * tstep, cB = (unsigned)cur.pn * tstep;
    S.a_ready(cur);
    if constexpr (SP2) {
        PG8_STAGE(PG8_SB(0, 0), rB, cB, voffB); PG8_STAGE(PG8_SB(0, 1), rB, cB + hstep, voffB); PG8_STAGE(PG8_SA(0, 0), rA, cA, voffA); PG8_STAGE(PG8_SA(0, 1), rA, cA + hstep, voffA);
        if (wr == 1) PG8_BAR;
        PG8_WAIT_V(2); PG8_BAR;
        PG8_STAGE(PG8_SB(1, 0), rB, cB + kstep, voffB); PG8_STAGE(PG8_SA(1, 0), rA, cA + kstep, voffA); PG8_STAGE(PG8_SB(1, 1), rB, cB + hstep + kstep, voffB);
        PG8_WAIT_V(6); PG8_BAR;
    } else {
        PG8_STAGE(PG8_SB(0, 0), rB, cB, voffB); PG8_STAGE(PG8_SA(0, 0), rA, cA, voffA); PG8_STAGE(PG8_SB(0, 1), rB, cB + hstep, voffB); PG8_STAGE(PG8_SA(0, 1), rA, cA + hstep, voffA);
        if (wr == 1) PG8_BAR;
        PG8_WAIT_V(4); PG8_BAR;
        PG8_STAGE(PG8_SB(1, 0), rB, cB + kstep, voffB); PG8_STAGE(PG8_SA(1, 0), rA, cA + kstep, voffA); PG8_STAGE(PG8_SB(1, 1), rB, cB + hstep + kstep, voffB);
        PG8_WAIT_V(6); PG8_BAR;
    }
    for (;;) {
        const bool has_next = S.next(ui + 1, nxt);
        const unsigned nA = has_next ? (unsigned)nxt.pm * tstep : cA, nB = has_next ? (unsigned)nxt.pn * tstep : cB;
        const bool hon = HOOK && ((hit + nt / 2 - 1) * hk.ngw + hk.gwave < HK_NCHUNK);
        for (int t = 0; t < nt; t += 2) {
            if constexpr (Epi::HAS_MID) { if (t == nt / 2) { asm volatile("s_nop 7\n\ts_nop 7\n\ts_nop 7" ::: "memory"); E.mid(acc, cur, wr, wc, fr, fq); } }
            const bool last = (t == nt - 2);
            const unsigned a1 = cA + (unsigned)(t + 1) * kstep;
            const unsigned a2 = last ? nA : cA + (unsigned)(t + 2) * kstep, b2 = last ? nB : cB + (unsigned)(t + 2) * kstep;
            const unsigned a3 = a2 + kstep, b3 = b2 + kstep;
            if (last && has_next) S.a_ready(nxt);
            constexpr int EPI_NS = Epi::NSTORE; const bool relax = RELAX_EPI && (t == 0) && (ui > 0);
            if constexpr (SP2) {
            PG8_LDB(B0, 0, 0); PG8_LDB(B1, 0, 1); PG8_SCHED; PG8_LDA(At, 0, 0); PG8_STAGE(PG8_SA(1, 1), rA, a1 + hstep, voffA);
            if constexpr (HOOK) { if (hon) hook_issue(hk, hit, lane, lds + HK_LDS_OFF + wid * 2048); }
            if (relax) PG8_WAIT_VI(8 + EPI_NS); else if (hon) PG8_WAIT_V(10); else PG8_WAIT_V(8);
            PG8_WAIT_L(0); PG8_BAR; PG8_MMA(0, 0, At, B0); PG8_MMA(0, 1, At, B1); PG8_BAR; PG8_SCHED;
            PG8_LDA(At, 0, 1); PG8_STAGE(PG8_SB(0, 0), rB, b2, voffB); PG8_STAGE(PG8_SB(0, 1), rB, b2 + hstep, voffB); PG8_STAGE(PG8_SA(0, 0), rA, a2, voffA);
            if (relax) PG8_WAIT_VI(8 + EPI_NS); else if (hon) PG8_WAIT_V(10); else PG8_WAIT_V(8);
            PG8_WAIT_L(0); PG8_BAR; PG8_MMA(1, 0, At, B0); PG8_MMA(1, 1, At, B1); PG8_BAR; PG8_SCHED;
            PG8_LDB(B0, 1, 0); PG8_LDB(B1, 1, 1); PG8_SCHED; PG8_LDA(At, 1, 0); PG8_STAGE(PG8_SA(0, 1), rA, a2 + hstep, voffA);
            if (hon) PG8_WAIT_V(10); else PG8_WAIT_V(8);
            PG8_WAIT_L(0); PG8_BAR; PG8_MMA(0, 0, At, B0); PG8_MMA(0, 1, At, B1); PG8_BAR; PG8_SCHED;
            PG8_LDA(At, 1, 1); PG8_STAGE(PG8_SB(1, 0), rB, b3, voffB); PG8_STAGE(PG8_SB(1, 1), rB, b3 + hstep, voffB); PG8_STAGE(PG8_SA(1, 0), rA, a3, voffA);
            PG8_WAIT_V(8); if constexpr (HOOK) { if (hon) { const PG8_LAS unsigned char* sl_ = lds + HK_LDS_OFF + wid * 2048; const f32x4 ha_ = *(const PG8_LAS f32x4*)(sl_ + lane * 32), hb_ = *(const PG8_LAS f32x4*)(sl_ + lane * 32 + 16); hook_store8(hk, hit, lane, ha_, hb_); ++hit; } }
            PG8_WAIT_L(0); PG8_BAR; PG8_MMA(1, 0, At, B0); PG8_MMA(1, 1, At, B1); PG8_BAR; PG8_SCHED;
            } else {
            PG8_LDB(B0, 0, 0); PG8_SCHED; PG8_LDA(At, 0, 0); PG8_STAGE(PG8_SA(1, 1), rA, a1 + hstep, voffA);
            PG8_WAIT_L(8); PG8_BAR; PG8_WAIT_L(0); PG8_MMA(0, 0, At, B0); PG8_BAR; PG8_SCHED;
            PG8_LDB(B1, 0, 1); PG8_STAGE(PG8_SB(0, 0), rB, b2, voffB);
            PG8_BAR; PG8_WAIT_L(0); PG8_MMA(0, 1, At, B1); PG8_BAR;
            PG8_LDA(At, 0, 1); PG8_STAGE(PG8_SA(0, 0), rA, a2, voffA);
            PG8_BAR; PG8_WAIT_L(0); PG8_MMA(1, 0, At, B0); PG8_BAR; PG8_SCHED;
            PG8_STAGE(PG8_SB(0, 1), rB, b2 + hstep, voffB);
            PG8_WAIT_V(6); PG8_BAR; PG8_MMA(1, 1, At, B1); PG8_BAR;
            PG8_LDB(B0, 1, 0); PG8_SCHED; PG8_LDA(At, 1, 0); PG8_STAGE(PG8_SA(0, 1), rA, a2 + hstep, voffA);
            PG8_WAIT_L(8); PG8_BAR; PG8_WAIT_L(0); PG8_MMA(0, 0, At, B0); PG8_BAR; PG8_SCHED;
            PG8_LDB(B1, 1, 1); PG8_STAGE(PG8_SB(1, 0), rB, b3, voffB);
            PG8_BAR; PG8_WAIT_L(0); PG8_MMA(0, 1, At, B1); PG8_BAR;
            PG8_LDA(At, 1, 1); PG8_STAGE(PG8_SA(1, 0), rA, a3, voffA);
            PG8_BAR; PG8_WAIT_L(0); PG8_MMA(1, 0, At, B0); PG8_BAR; PG8_SCHED;
            PG8_STAGE(PG8_SB(1, 1), rB, b3 + hstep, voffB);
            PG8_WAIT_V(6); PG8_BAR; PG8_MMA(1, 1, At, B1); PG8_BAR;
            }
        }
        asm volatile("s_nop 7\n\ts_nop 7\n\ts_nop 7" ::: "memory");
        if constexpr (FP8 == 2) {
#pragma unroll
            for (int a = 0; a < 2; ++a)
#pragma unroll
                for (int b = 0; b < 2; ++b)
#pragma unroll
                    for (int m = 0; m < 4; ++m)
#pragma unroll
                        for (int n = 0; n < 2; ++n) { const v4i32 q_ = __builtin_bit_cast(v4i32, acc[a][b][m][n]); acc[a][b][m][n] = (f32x4){(float)q_[0], (float)q_[1], (float)q_[2], (float)q_[3]}; } }
        if constexpr (ALIGN_EPI) { if (wr == 0) PG8_BAR; }
        if constexpr (!Epi::AFTER_DRAIN) { E(acc, cur, wr, wc, fr, fq); S.done(cur); }
        if (!has_next) break;
#pragma unroll
        for (int a = 0; a < 2; ++a)
#pragma unroll
            for (int b = 0; b < 2; ++b)
#pragma unroll
                for (int m = 0; m < 4; ++m)
#pragma unroll
                    for (int n = 0; n < 2; ++n) acc[a][b][m][n] = (f32x4){0.f, 0.f, 0.f, 0.f};
        cur = nxt; cA = nA; cB = nB; ++ui;
        if constexpr (ALIGN_EPI) { if (wr == 1) PG8_BAR; }
    }
    PG8_WAIT_V(0);
    if constexpr (!ALIGN_EPI) { if (wr == 0) PG8_BAR; }
    PG8_BAR;
    if constexpr (Epi::AFTER_DRAIN) { E.fused(acc, cur, wr, wc, fr, fq, lds, wid, lane); S.done(cur); }
    PG8_HOOK_REST;
#undef PG8_HOOK_REST
#undef PG8_SA
#undef PG8_SB
#undef PG8_STAGE
#undef PG8_LDA
#undef PG8_LDB
#undef PG8_MMA
#undef PG8_WAIT_V
#undef PG8_WAIT_L
#undef PG8_BAR
#undef PG8_SCHED
}
}
namespace moba {
typedef unsigned short bf16;
constexpr int   D = 128, NW = 8, QBLK = 32, KVBLK = 64;
constexpr float SCALE = 0.088388347648318440f;
constexpr float THR = 8.f;
constexpr int SDEPTH = 1;
#ifndef GEMM2_FUSED
#define GEMM2_FUSED 1
#endif
constexpr int LDQ = 20480, LDK = 20480, LDO = GEMM2_FUSED ? 4096 + 128 : 2048 + 128;
constexpr size_t SHM_V = KVBLK * D * 2, SHM_K = KVBLK * D * 2, SHM_ATTN = 2 * SHM_V + 2 * SHM_K + NW * 64 * 4;
constexpr float NEG = -1e30f;
constexpr float OSCALE = 64.0f;
using bf16x8 = __attribute__((ext_vector_type(8))) short;
using s16x4  = __attribute__((ext_vector_type(4))) short;
using f32x16 = __attribute__((ext_vector_type(16))) float;
using f32x8  = __attribute__((ext_vector_type(8))) float;
using u32x4  = __attribute__((ext_vector_type(4))) unsigned;
#define KSWZ(row, colB) ((row) * 256 + ((colB) ^ (((row) & 7) << 4)))
#define SBAR() __builtin_amdgcn_sched_barrier(0)
__device__ __forceinline__ int crow(int r, int hi) { return (r & 3) + 8 * (r >> 2) + 4 * hi; }
__device__ __forceinline__ unsigned cvtpk(float lo, float hi) {
  unsigned r; asm volatile("v_cvt_pk_bf16_f32 %0, %1, %2" : "=v"(r) : "v"(lo), "v"(hi)); return r;
}
template <typename TIn> struct Stage;
template <> struct Stage<bf16>  { using T = bf16x8;
  __device__ static __forceinline__ T ld8(const bf16* p) { return *reinterpret_cast<const bf16x8*>(p); }
  __device__ static __forceinline__ bf16x8 tobf(T x) { return x; } };

__device__ __forceinline__ void partialSM(f32x16& p0, f32x16& p1, float& m_reg, float& mn, float& alpha) {
  constexpr float C = SCALE * 1.4426950408889634f;
  float pmax = p0[0]; for (int r = 1; r < 16; ++r) pmax = fmaxf(pmax, p0[r]); for (int r = 0; r < 16; ++r) pmax = fmaxf(pmax, p1[r]);
  { auto rr = __builtin_amdgcn_permlane32_swap(__float_as_uint(pmax), __float_as_uint(pmax), false, false);
    pmax = fmaxf(__uint_as_float(rr[0]), __uint_as_float(rr[1])); }
  if (__builtin_expect(__all(pmax - m_reg <= THR / SCALE), 1)) { mn = m_reg; alpha = 1.f; }
  else { mn = fmaxf(m_reg, pmax); alpha = __builtin_amdgcn_exp2f((m_reg - mn) * C); m_reg = mn; }
  float mnC = -mn * C;
  for (int r = 0; r < 16; ++r) p0[r] = fmaf(p0[r], C, mnC); for (int r = 0; r < 16; ++r) p1[r] = fmaf(p1[r], C, mnC);
  for (int r = 0; r < 16; ++r) p0[r] = __builtin_amdgcn_exp2f(p0[r]);
}
__device__ __forceinline__ void finishSM(f32x16& p0, f32x16& p1, float alpha, float& l_reg, bf16x8& pa0, bf16x8& pa1, bf16x8& pa2, bf16x8& pa3) {
  for (int r = 0; r < 16; ++r) p1[r] = __builtin_amdgcn_exp2f(p1[r]);
  float ps = 0; for (int r = 0; r < 16; ++r) ps += p0[r]; for (int r = 0; r < 16; ++r) ps += p1[r];
  { auto rr = __builtin_amdgcn_permlane32_swap(__float_as_uint(ps), __float_as_uint(ps), false, false);
    ps = __uint_as_float(rr[0]) + __uint_as_float(rr[1]); }
  l_reg = l_reg * alpha + ps;
#define PK4(P, BASE, OUT) do { unsigned a0 = cvtpk(P[BASE + 0], P[BASE + 1]), a1 = cvtpk(P[BASE + 2], P[BASE + 3]);   \
    unsigned b0 = cvtpk(P[BASE + 4], P[BASE + 5]), b1 = cvtpk(P[BASE + 6], P[BASE + 7]);                              \
    auto r0 = __builtin_amdgcn_permlane32_swap(a0, b0, false, false); auto r1 = __builtin_amdgcn_permlane32_swap(a1, b1, false, false); \
    u32x4 w = {r0[0], r1[0], r0[1], r1[1]}; OUT = *reinterpret_cast<bf16x8*>(&w); } while (0)
  PK4(p0, 0, pa0); PK4(p0, 8, pa1); PK4(p1, 0, pa2); PK4(p1, 8, pa3);
#undef PK4
}
__device__ __forceinline__ void qkt(f32x16& p0, f32x16& p1, const bf16* Ks, const bf16x8* qr, int r32, int hi) {
  p0 = f32x16{}; p1 = f32x16{};
  for (int d0 = 0; d0 < 8; ++d0) { int cb = (d0 * 16 + hi * 8) * 2;
    bf16x8 b0 = *reinterpret_cast<const bf16x8*>((const char*)Ks + KSWZ(r32, cb));
    bf16x8 b1 = *reinterpret_cast<const bf16x8*>((const char*)Ks + KSWZ(32 + r32, cb));
    p0 = __builtin_amdgcn_mfma_f32_32x32x16_bf16(b0, qr[d0], p0, 0, 0, 0);
    p1 = __builtin_amdgcn_mfma_f32_32x32x16_bf16(b1, qr[d0], p1, 0, 0, 0); }
}
__device__ __forceinline__ int v_st(int k, int c) { const int kk = (k & ~0xC) | ((k & 4) << 1) | ((k & 8) >> 1); return ((kk >> 3) * 4 + (c >> 5)) * 512 + ((kk & 7) * 32 + (c & 31)) * 2; }
__device__ __forceinline__ int v_rd_base(int lane) { return ((lane & 3) << 3) | (((lane >> 2) & 3) << 6) | (((lane >> 4) & 1) << 5) | (((lane >> 5) & 1) << 8); }
constexpr int v_rd_off(int d0, int ks, int half) { return d0 * 512 + ks * 4096 + half * 2048; }
template <int OFF> __device__ __forceinline__ s16x4 tr_read(int vb) {
  s16x4 r; asm volatile("ds_read_b64_tr_b16 %0, %1 offset:%2" : "=&v"(r) : "v"(vb), "i"(OFF) : "memory"); return r;
}
template <int D0> __device__ __forceinline__ void pv_one(f32x16& od, int vb, bf16x8 pa0, bf16x8 pa1, bf16x8 pa2, bf16x8 pa3) {
  const s16x4 l0 = tr_read<v_rd_off(D0, 0, 0)>(vb), h0 = tr_read<v_rd_off(D0, 0, 1)>(vb), l1 = tr_read<v_rd_off(D0, 1, 0)>(vb), h1 = tr_read<v_rd_off(D0, 1, 1)>(vb);
  const s16x4 l2 = tr_read<v_rd_off(D0, 2, 0)>(vb), h2 = tr_read<v_rd_off(D0, 2, 1)>(vb), l3 = tr_read<v_rd_off(D0, 3, 0)>(vb), h3 = tr_read<v_rd_off(D0, 3, 1)>(vb);
  asm volatile("s_waitcnt lgkmcnt(0)" ::: "memory"); SBAR();
#define PK(L, H) (bf16x8){L[0], L[1], L[2], L[3], H[0], H[1], H[2], H[3]}
  od = __builtin_amdgcn_mfma_f32_32x32x16_bf16(pa0, PK(l0, h0), od, 0, 0, 0);
  od = __builtin_amdgcn_mfma_f32_32x32x16_bf16(pa1, PK(l1, h1), od, 0, 0, 0);
  od = __builtin_amdgcn_mfma_f32_32x32x16_bf16(pa2, PK(l2, h2), od, 0, 0, 0);
  od = __builtin_amdgcn_mfma_f32_32x32x16_bf16(pa3, PK(l3, h3), od, 0, 0, 0);
#undef PK
}
__device__ __forceinline__ void pv_d0(f32x16* o, int vb, bf16x8 pa0, bf16x8 pa1, bf16x8 pa2, bf16x8 pa3) {
  pv_one<0>(o[0], vb, pa0, pa1, pa2, pa3); pv_one<1>(o[1], vb, pa0, pa1, pa2, pa3); pv_one<2>(o[2], vb, pa0, pa1, pa2, pa3); pv_one<3>(o[3], vb, pa0, pa1, pa2, pa3);
}


__device__ __forceinline__ float bf2f(short s) { return __uint_as_float(((unsigned)(unsigned short)s) << 16); }
__device__ __forceinline__ int koff(int j, int qb) { return (j < 4) ? qb * 256 + j * 64 : (j - 4) * 64; }
__device__ __forceinline__ void init_tile(f32x16& p0, f32x16& p1, int j, unsigned selmask, int rowi, int wid, int hi) {
  if (j < 4) {
    if (64 * j + 63 <= wid * 32) {
#pragma unroll
      for (int r = 0; r < 16; ++r) { p0[r] = 0.f; p1[r] = 0.f; }
    } else if (64 * j > wid * 32 + 31) {
#pragma unroll
      for (int r = 0; r < 16; ++r) { p0[r] = NEG; p1[r] = NEG; }
    } else {
      int tz = threadIdx.x; asm volatile("" : "+v"(tz));
      const int limh = (tz >> 6) * 32 + (tz & 31) - 4 * ((tz >> 5) & 1) - 64 * j; const float neg = NEG;
#define MOBA_MSK(P, R, CONST) asm volatile("v_cmp_gt_i32 vcc, %2, %1\n\tv_cndmask_b32 %0, 0, %3, vcc" : "=v"(P[R]) : "v"(limh), "n"(CONST), "v"(neg) : "vcc")
#define MOBA_MSK2(R) MOBA_MSK(p0, R, ((R) & 3) + 8 * ((R) >> 2)); MOBA_MSK(p1, R, 32 + ((R) & 3) + 8 * ((R) >> 2))
      MOBA_MSK2(0); MOBA_MSK2(1); MOBA_MSK2(2); MOBA_MSK2(3); MOBA_MSK2(4); MOBA_MSK2(5); MOBA_MSK2(6); MOBA_MSK2(7);
      MOBA_MSK2(8); MOBA_MSK2(9); MOBA_MSK2(10); MOBA_MSK2(11); MOBA_MSK2(12); MOBA_MSK2(13); MOBA_MSK2(14); MOBA_MSK2(15);
#undef MOBA_MSK2
#undef MOBA_MSK
    }
  } else {
    const float iv = ((selmask >> ((j - 4) >> 2)) & 1u) ? 0.f : NEG;
#pragma unroll
    for (int r = 0; r < 16; ++r) { p0[r] = iv; p1[r] = iv; }
  }
}
__device__ __forceinline__ void qktm(f32x16& p0, f32x16& p1, const bf16* Ks, const bf16x8* qr, int r32, int hi, int j, unsigned selmask, int rowi, int wid) {
  init_tile(p0, p1, j, selmask, rowi, wid, hi);
  for (int d0 = 0; d0 < 8; ++d0) { int cb = (d0 * 16 + hi * 8) * 2;
    bf16x8 b0 = *reinterpret_cast<const bf16x8*>((const char*)Ks + KSWZ(r32, cb));
    bf16x8 b1 = *reinterpret_cast<const bf16x8*>((const char*)Ks + KSWZ(32 + r32, cb));
    p0 = __builtin_amdgcn_mfma_f32_32x32x16_bf16(b0, qr[d0], p0, 0, 0, 0);
    p1 = __builtin_amdgcn_mfma_f32_32x32x16_bf16(b1, qr[d0], p1, 0, 0, 0); }
}

__device__ __forceinline__ void moba_body(const bf16* __restrict__ Qb, const bf16* __restrict__ Kh, const bf16* __restrict__ Vh, const float* __restrict__ km,
                                          unsigned char* __restrict__ Ob, int qb, char* lds) {
  using St = Stage<bf16>;
  int tid = threadIdx.x; asm volatile("" : "+v"(tid));
  const int wid = tid >> 6, lane = tid & 63, r32 = lane & 31, hi = lane >> 5;
  bf16* V_lds = (bf16*)lds; bf16* K_lds = (bf16*)(lds + 2 * SHM_V);
  float* ws = (float*)(lds + 2 * SHM_V + 2 * SHM_K) + wid * 64; float* li_l = ws; float* al_l = ws + 32;
  float m_reg = -1e30f, l_reg = 0; f32x16 o[4] = {}; bf16x8 qr[8];
  __syncthreads();
  float* kml = (float*)(lds + SHM_ATTN);
  if (tid < 224) *reinterpret_cast<float4*>(kml + tid * 4) = *reinterpret_cast<const float4*>(km + tid * 4);
  const bf16* Qw = Qb + (long)(wid * QBLK + r32) * LDQ + hi * 8;
#pragma unroll
  for (int d0 = 0; d0 < 8; ++d0) qr[d0] = St::ld8(Qw + d0 * 16);
  {
    const int sr0 = tid >> 4, sc0 = (tid & 15) * 8, k00 = koff(0, qb);
    const typename St::T tv0 = St::ld8(&Vh[(long)(k00 + sr0) * LDK + sc0]), tv1 = St::ld8(&Vh[(long)(k00 + 32 + sr0) * LDK + sc0]);
    const typename St::T tk0 = St::ld8(&Kh[(long)(k00 + sr0) * LDK + sc0]), tk1 = St::ld8(&Kh[(long)(k00 + 32 + sr0) * LDK + sc0]);
    asm volatile("s_waitcnt vmcnt(0)" ::: "memory");
    *(bf16x8*)((char*)V_lds + v_st(sr0, sc0)) = St::tobf(tv0); *(bf16x8*)((char*)V_lds + v_st(32 + sr0, sc0)) = St::tobf(tv1);
    *(bf16x8*)((char*)K_lds + KSWZ(sr0, sc0 * 2)) = St::tobf(tk0); *(bf16x8*)((char*)K_lds + KSWZ(32 + sr0, sc0 * 2)) = St::tobf(tk1); }
  __syncthreads();
  asm volatile("" : "+v"(tid));
  unsigned selmask = 0u;
  {
    float g[7];
#pragma unroll
    for (int n = 0; n < 7; ++n) {
      float s = 0.f;
      if (n < qb) {
        const float* kp = kml + n * 128 + hi * 8;
#pragma unroll
        for (int d0 = 0; d0 < 8; ++d0) {
          const float4 k0 = *reinterpret_cast<const float4*>(kp + d0 * 16), k1 = *reinterpret_cast<const float4*>(kp + d0 * 16 + 4);
          s += bf2f(qr[d0][0]) * k0.x + bf2f(qr[d0][1]) * k0.y + bf2f(qr[d0][2]) * k0.z + bf2f(qr[d0][3]) * k0.w
             + bf2f(qr[d0][4]) * k1.x + bf2f(qr[d0][5]) * k1.y + bf2f(qr[d0][6]) * k1.z + bf2f(qr[d0][7]) * k1.w;
        }
        s += __shfl_xor(s, 32);
      }
      g[n] = (n < qb) ? s : -INFINITY;
    }
#pragma unroll
    for (int n = 0; n < 7; ++n) {
      int rank = 0;
#pragma unroll
      for (int m = 0; m < 7; ++m) if (m != n) rank += (g[m] > g[n] || (g[m] == g[n] && m < n)) ? 1 : 0;
      if (n < qb && rank < 3) selmask |= (1u << n);
    }
  }
  const int rowi = wid * QBLK + r32;
  const int sr = tid >> 4, sc = (tid & 15) * 8, vst0 = v_st(sr, sc), vst1 = v_st(32 + sr, sc);
  const int vb0 = (int)(uintptr_t)V_lds + v_rd_base(lane);
  struct { typename St::T vs0, vs1, ks0, ks1; } sr_[SDEPTH];
#define SLOAD(i, k0) do { sr_[i].vs0 = St::ld8(&Vh[(long)((k0) + sr) * LDK + sc]); sr_[i].vs1 = St::ld8(&Vh[(long)((k0) + 32 + sr) * LDK + sc]); \
    sr_[i].ks0 = St::ld8(&Kh[(long)((k0) + sr) * LDK + sc]); sr_[i].ks1 = St::ld8(&Kh[(long)((k0) + 32 + sr) * LDK + sc]); } while (0)
#define SWRITE(b, i) do { *(bf16x8*)((char*)V_lds + (b) * SHM_V + vst0) = St::tobf(sr_[i].vs0);          \
    *(bf16x8*)((char*)V_lds + (b) * SHM_V + vst1) = St::tobf(sr_[i].vs1); int kc = sc * 2;               \
    *(bf16x8*)((char*)K_lds + (b) * SHM_K + KSWZ(sr, kc)) = St::tobf(sr_[i].ks0);                       \
    *(bf16x8*)((char*)K_lds + (b) * SHM_K + KSWZ(32 + sr, kc)) = St::tobf(sr_[i].ks1); } while (0)
#define SWAIT() do { if constexpr (SDEPTH == 2) asm volatile("s_waitcnt vmcnt(4)" ::: "memory"); else asm volatile("s_waitcnt vmcnt(0)" ::: "memory"); } while (0)
#define RESC(a) do { if (__any((a) < 1.f)) { if (hi == 0) al_l[r32] = (a); asm volatile("s_waitcnt lgkmcnt(0)" ::: "memory"); \
    for (int d = 0; d < 4; ++d) for (int r = 0; r < 16; ++r) o[d][r] *= al_l[crow(r, hi)]; } } while (0)
  f32x16 pA0, pA1, pB0, pB1; float mnA, mnB, alA, alB; bf16x8 pa0, pa1, pa2, pa3; const int NT = 4 * (qb + 1);
  constexpr int SE = 0, SO = SDEPTH - 1;
  static_assert(SDEPTH == 1, "prologue order"); SLOAD(SO, koff(1, qb));
  qktm(pA0, pA1, K_lds, qr, r32, hi, 0, selmask, rowi, wid); partialSM(pA0, pA1, m_reg, mnA, alA);
  SWAIT(); SWRITE(1, SO); __syncthreads();
  for (int j = 1; j + 1 < NT; j += 2) {
    SBAR(); qktm(pB0, pB1, (bf16*)((char*)K_lds + SHM_K), qr, r32, hi, j, selmask, rowi, wid);
    finishSM(pA0, pA1, alA, l_reg, pa0, pa1, pa2, pa3); SBAR();
    SLOAD(SO, koff(j + SDEPTH, qb)); SBAR();
    pv_d0(o, vb0, pa0, pa1, pa2, pa3); partialSM(pB0, pB1, m_reg, mnB, alB);
    __syncthreads(); SWAIT(); SWRITE(0, SE);
    RESC(alB); __syncthreads();
    SBAR(); qktm(pA0, pA1, K_lds, qr, r32, hi, j + 1, selmask, rowi, wid);
    finishSM(pB0, pB1, alB, l_reg, pa0, pa1, pa2, pa3); SBAR();
    if (SDEPTH == 1 || j + 3 < NT) SLOAD(SE, koff(j + 1 + SDEPTH, qb)); SBAR();
    pv_d0(o, vb0 + (int)SHM_V, pa0, pa1, pa2, pa3); partialSM(pA0, pA1, m_reg, mnA, alA);
    __syncthreads(); SWAIT(); SWRITE(1, SO);
    RESC(alA); __syncthreads();
  }
  SBAR(); qktm(pB0, pB1, (bf16*)((char*)K_lds + SHM_K), qr, r32, hi, NT - 1, selmask, rowi, wid);
  finishSM(pA0, pA1, alA, l_reg, pa0, pa1, pa2, pa3); SBAR();
  pv_d0(o, vb0, pa0, pa1, pa2, pa3); partialSM(pB0, pB1, m_reg, mnB, alB);
  __syncthreads(); RESC(alB);
  finishSM(pB0, pB1, alB, l_reg, pa0, pa1, pa2, pa3); SBAR();
  pv_d0(o, vb0 + (int)SHM_V, pa0, pa1, pa2, pa3);
  if (hi == 0) li_l[r32] = l_reg; asm volatile("s_waitcnt lgkmcnt(0)" ::: "memory");
  float rli[16];
#pragma unroll
  for (int r = 0; r < 16; ++r) rli[r] = __builtin_amdgcn_rcpf(li_l[crow(r, hi)]);
  unsigned char* Ow = Ob + (long)(wid * QBLK) * LDO;
#pragma unroll
  for (int r = 0; r < 16; ++r) { int orow = crow(r, hi);
    for (int d0 = 0; d0 < 4; ++d0) { const float v = o[d0][r] * rli[r] * OSCALE; const int q8 = __builtin_amdgcn_cvt_pk_fp8_f32(v, v, 0, false); Ow[(long)orow * LDO + d0 * 32 + r32] = (unsigned char)(q8 & 0xff); } }
#undef SLOAD
#undef SWRITE
#undef SWAIT
#undef RESC
}
#undef KSWZ
#undef SBAR
}
constexpr int NWAVES = 8;
constexpr int T_ = 8192, DM = 4096, INC = 20480, CD = 2048, AD = 2048, NH = 16, HD = 128, SEQ = 2048, NBATCH = 4, NBLK = 8;
constexpr int PH = 8, NKEYS = 128, NEXP = 16384, PTOPK = 16, NSEL = PH * PTOPK;
constexpr float EPS = 1e-6f;
enum { I_X = 0, I_NMIX, I_WIN, I_BGATE, I_CONVW, I_WCO, I_WAO, I_WO, I_NFFN, I_WPQ, I_SUBK, I_UEMB, I_VEMB, I_NFIN, N_IN };
#ifndef ALL_LOWP_GEMM1
#define ALL_LOWP_GEMM1 1
#endif
constexpr int Z8_COL0 = ALL_LOWP_GEMM1 ? 0 : 6144;
#ifndef PROJ_INT8
#define PROJ_INT8 1
#endif
constexpr float HN8_SCALE = PROJ_INT8 ? 32.0f : 16.0f, WIN8_SCALE = PROJ_INT8 ? 2048.0f : 1024.0f, ATT8_SCALE = 64.0f, WAO8_SCALE = 512.0f, MRG8_SCALE = 32.0f, WO8_SCALE = PROJ_INT8 ? 2048.0f : 1024.0f;
#ifndef SCORES_INT8
#define SCORES_INT8 1
#endif
#ifndef CONVOUT_INT8
#define CONVOUT_INT8 0
#endif
#ifndef CONVOUT_FP8
#define CONVOUT_FP8 1
#endif
#ifndef DEFER_FFN_NORM
#define DEFER_FFN_NORM 1
#endif
constexpr int HQ_SCALE = 24;
constexpr float XN8_SCALE = DEFER_FFN_NORM ? (float)HQ_SCALE : 32.0f, WPQ8_SCALE = 2048.0f, BZ8_SCALE = CONVOUT_FP8 ? 4.0f : 8.0f, WCO8_SCALE = CONVOUT_FP8 ? 2048.0f : 1024.0f;
#ifndef UV_IN_GEMM1
#define UV_IN_GEMM1 1
#endif
constexpr int LOWP = PROJ_INT8 ? 2 : 1;
constexpr int ZC_B = 0, ZC_C = 2048, ZC_U = 4096, ZC_Q = 6144, ZC_K = 8192, ZC_V = 10240, ZC_GC = 12288, ZC_GA = 16384;

constexpr size_t MiB = 1u << 20;
#ifndef GEMM3_FP8
#define GEMM3_FP8 1
#endif
constexpr int LDP = DM + 64;
constexpr int LDP8 = (DM + 128) / 2;
constexpr int LDH = CD + 64;
constexpr int LDH8 = (AD + 128) / 2;
constexpr size_t WS_CTL = 0, CTL_ZERO_BYTES = 1 * MiB;
constexpr size_t WS_KMEAN = 1 * MiB;
constexpr size_t WS_WINT = 2 * MiB;
constexpr size_t WS_WIN8 = (ALL_LOWP_GEMM1 ? 2 : 51) * MiB;
constexpr size_t WS_WIN8_OLD_ = 51 * MiB;
constexpr size_t WS_HN8  = 109 * MiB;
constexpr size_t WS_WAO8 = 142 * MiB;
constexpr size_t WS_WCOT = 151 * MiB;
constexpr size_t WS_WOT  = 168 * MiB;
constexpr size_t WS_WPQF = 201 * MiB;
constexpr size_t WS_HN   = 218 * MiB;
constexpr size_t WS_Z    = 283 * MiB;
constexpr size_t WS_BZ   = 603 * MiB;
constexpr size_t WS_ATT  = 636 * MiB;
constexpr size_t WS_MRG  = 653 * MiB;
constexpr size_t WS_HB   = WS_Z + 64 * MiB;
constexpr size_t WS_MRG8 = WS_HN;
constexpr size_t WS_XN   = 718 * MiB;
constexpr size_t WS_ST   = 783 * MiB;
constexpr size_t WS_EXP  = 847 * MiB;
constexpr size_t WS_GATE = 851 * MiB;
constexpr size_t WS_UB   = 855 * MiB;
constexpr size_t WS_VB   = 919 * MiB;
constexpr size_t WS_END  = 983 * MiB;
constexpr size_t WS_AC = WS_MRG, WS_WC = WS_WCOT;
static_assert((size_t)4096 * LDP8 * 2 <= 17 * MiB && (size_t)8192 * LDP8 * 2 <= 65 * MiB, "fused GEMM2 operands");
constexpr size_t WS_SSQP = WS_ATT, WS_RS = WS_ATT + 2 * MiB;
static_assert((size_t)20480 * LDP8 * 2 <= 107 * MiB && (size_t)6144 * LDP * 2 <= 49 * MiB && (size_t)14336 * LDP8 * 2 <= 58 * MiB && (size_t)8192 * LDP8 * 2 <= 33 * MiB && (size_t)4096 * LDH8 * 2 <= 9 * MiB && (size_t)4096 * LDH * 2 <= 17 * MiB, "ws map 1");
static_assert((size_t)4096 * LDP * 2 <= 33 * MiB && (size_t)2048 * LDP * 2 <= 17 * MiB && (size_t)8192 * LDP * 2 <= 65 * MiB && (size_t)8192 * LDH * 2 <= 33 * MiB && (size_t)8192 * LDH8 * 2 <= 17 * MiB, "ws map 2");
constexpr int CW_TMO = 0, CW_CODE = 1, CW_BAR = 4096;
constexpr int CW_SSQX = 131072;

constexpr int RING_OFF = 0, RING_BYTES = 131072;
constexpr int LDSCTL_OFF = RING_BYTES, MISC_OFF = LDSCTL_OFF + 320;
constexpr int LDS_BYTES = 147968;
static_assert(MISC_OFF + 128 <= pg8::HK_LDS_OFF && pg8::HK_LDS_OFF + 8 * 2048 <= LDS_BYTES && RING_OFF == 0, "LDS map");
static_assert(WS_VB - WS_UB == 64 * MiB, "TblHook: v table 64 MiB behind u");
#define GAS __attribute__((address_space(1)))
#define LAS __attribute__((address_space(3)))
typedef unsigned short bf16;
typedef unsigned v4u __attribute__((ext_vector_type(4)));
typedef float f32x4 __attribute__((ext_vector_type(4)));
typedef short bf16x8 __attribute__((ext_vector_type(8)));
typedef GAS unsigned gu32;
typedef GAS unsigned long long gu64;
#define RLX_AGENT __ATOMIC_RELAXED, __HIP_MEMORY_SCOPE_AGENT
#define LDS_WAIT() asm volatile("s_waitcnt lgkmcnt(0)" ::: "memory")
#define VM_WAIT() asm volatile("s_waitcnt vmcnt(0)" ::: "memory")
__device__ __forceinline__ unsigned long long rt() { return __builtin_amdgcn_s_memrealtime(); }
__device__ __forceinline__ unsigned f2bf(float f) { unsigned u = __builtin_bit_cast(unsigned, f); return (u + 0x7fffu + ((u >> 16) & 1u)) >> 16; }
__device__ __forceinline__ unsigned pk2(float lo, float hi) { return f2bf(lo) | (f2bf(hi) << 16); }
#define XB_TMO      128
#define XB_XCNT(j)  (256  + 64 * (j))
#define XB_XSUB(j)  (1280 + 64 * (j))
#define XB_XGEN(j)  (2304 + 64 * (j))
#define XB_TOP      3328
#define XB_TOPGEN   3392
#define XCD_BAR_WORDS 3456
#define XB_SPIN_CAP (1u << 18)

__device__ __forceinline__ unsigned xb_ld(unsigned* p)              { return __hip_atomic_load(p, __ATOMIC_RELAXED, __HIP_MEMORY_SCOPE_AGENT); }
__device__ __forceinline__ unsigned xb_add(unsigned* p, unsigned v) { return __hip_atomic_fetch_add(p, v, __ATOMIC_RELAXED, __HIP_MEMORY_SCOPE_AGENT); }
__device__ __forceinline__ unsigned xb_xcc_id() { return (unsigned)__builtin_amdgcn_s_getreg((3 << 11) | 20) & 0xFu; }
#define XB_SPIN(cond, bar) do { unsigned _sp = 0; while (cond) { __builtin_amdgcn_s_sleep(1); \
    if ((++_sp & 255u) == 0u) { if (xb_ld(&(bar)[XB_TMO])) break; if (_sp > XB_SPIN_CAP) { atomicAdd(&(bar)[XB_TMO], 1u); break; } } } } while (0)

struct XcdBarrier {
    unsigned* bar; unsigned x;
    volatile LAS unsigned* st;
};

__device__ __forceinline__ XcdBarrier xcd_barrier_post(unsigned* bar, volatile LAS unsigned* st) {
    XcdBarrier b; b.bar = bar; b.x = xb_xcc_id(); b.st = st;
    if (threadIdx.x == 0) (void)xb_add(&bar[XB_XCNT(b.x)], 1u);
    return b;
}
__device__ __forceinline__ void xcd_barrier_complete(unsigned* bar, unsigned x, unsigned& nloc, unsigned& nx) {
    const unsigned G = gridDim.x * gridDim.y * gridDim.z;
    unsigned sum, cnt, mine, sp = 0u;
    for (;;) {
        sum = 0u; cnt = 0u; mine = 0u;
#pragma unroll
        for (unsigned j = 0; j < 16; ++j) { const unsigned c = xb_ld(&bar[XB_XCNT(j)]); sum += c; cnt += (c > 0u) ? 1u : 0u; mine = (j == x) ? c : mine; }
        if (sum == G) break;
        __builtin_amdgcn_s_sleep(1);
        if ((++sp & 255u) == 0u) { if (xb_ld(&bar[XB_TMO])) break; if (sp > XB_SPIN_CAP) { atomicAdd(&bar[XB_TMO], 1u); break; } }
    }
    nloc = mine > 0u ? mine : 1u; nx = cnt > 0u ? cnt : 1u;
}

__device__ __forceinline__ void xcd_barrier(const XcdBarrier& b) {
    asm volatile("s_waitcnt vmcnt(0)" ::: "memory");
    __syncthreads();
    if (threadIdx.x == 0) {
        unsigned* bar = b.bar;
        __builtin_amdgcn_s_waitcnt(0);
        unsigned nloc = b.st[0], nx = b.st[1];
        if (nloc == 0u) { xcd_barrier_complete(bar, b.x, nloc, nx); b.st[0] = nloc; b.st[1] = nx; }
        const unsigned old = xb_add(&bar[XB_XSUB(b.x)], 1u);
        const unsigned gen = old / nloc;
        if (old + 1u == (gen + 1u) * nloc) {
            __builtin_amdgcn_fence(__ATOMIC_RELEASE, "agent");
            asm volatile("s_waitcnt vmcnt(0)" ::: "memory");
            const unsigned og = xb_add(&bar[XB_TOP], 1u);
            const unsigned tg = og / nx;
            if (og + 1u == (tg + 1u) * nx) xb_add(&bar[XB_TOPGEN], 1u);
            else XB_SPIN(xb_ld(&bar[XB_TOPGEN]) == tg, bar);
            __builtin_amdgcn_fence(__ATOMIC_ACQUIRE, "agent");
            xb_add(&bar[XB_XGEN(b.x)], 1u);
            asm volatile("s_waitcnt vmcnt(0)" ::: "memory");
        } else {
            XB_SPIN(xb_ld(&bar[XB_XGEN(b.x)]) == gen, bar);
            __builtin_amdgcn_fence(__ATOMIC_ACQUIRE, "agent");
            asm volatile("s_waitcnt vmcnt(0)" ::: "memory");
        }
    }
    __syncthreads();
}
typedef unsigned u32x2 __attribute__((ext_vector_type(2)));
typedef __bf16 bfx2 __attribute__((ext_vector_type(2)));
typedef float f32x2 __attribute__((ext_vector_type(2)));
constexpr float PEER_USCALE = 1024.0f, PEER_VSCALE = 16.0f, PEER_XSCALE = 16.0f;
__device__ __forceinline__ int q_i8(float v) { const int q = __float2int_rn(v); return q < -127 ? -127 : (q > 127 ? 127 : q); }
__device__ __forceinline__ int pk_i8(float a, float b, float c, float d) { return (int)((unsigned)(q_i8(a) & 0xff) | ((unsigned)(q_i8(b) & 0xff) << 8) | ((unsigned)(q_i8(c) & 0xff) << 16) | ((unsigned)(q_i8(d) & 0xff) << 24)); }
struct Frame {
    LAS unsigned char* lds;
    volatile LAS unsigned* MISC;
    gu32* ctl;
    int tid, lane, wave;
    int vcu, G;
    const float* in[N_IN]; float* out; unsigned char* ws;
};
__device__ __forceinline__ float wave_sum(float v) {
    v += __builtin_bit_cast(float, __builtin_amdgcn_update_dpp(0, __builtin_bit_cast(int, v), 0xB1, 0xf, 0xf, false));
    v += __builtin_bit_cast(float, __builtin_amdgcn_update_dpp(0, __builtin_bit_cast(int, v), 0x4E, 0xf, 0xf, false));
    v += __builtin_bit_cast(float, __builtin_amdgcn_update_dpp(0, __builtin_bit_cast(int, v), 0x141, 0xf, 0xf, false));
    v += __builtin_bit_cast(float, __builtin_amdgcn_update_dpp(0, __builtin_bit_cast(int, v), 0x140, 0xf, 0xf, false));
    { unsigned a_ = __builtin_bit_cast(unsigned, v), b_ = a_; asm volatile("" : "+v"(b_));
      const auto r = __builtin_amdgcn_permlane16_swap(a_, b_, false, false); const unsigned r0_ = r[0], r1_ = r[1]; v = __uint_as_float(r0_) + __uint_as_float(r1_); }
    { unsigned a_ = __builtin_bit_cast(unsigned, v), b_ = a_; asm volatile("" : "+v"(b_));
      const auto r = __builtin_amdgcn_permlane32_swap(a_, b_, false, false); const unsigned r0_ = r[0], r1_ = r[1]; v = __uint_as_float(r0_) + __uint_as_float(r1_); }
    return v;
}
__device__ __forceinline__ float bflo(unsigned w) { return __uint_as_float(w << 16); }
__device__ __forceinline__ float bfhi(unsigned w) { return __uint_as_float(w & 0xffff0000u); }
__device__ __forceinline__ void p0_transpose_item(const float* W, int K, int N, bf16* WT, int ldo, LAS float* scr, int item, int lane) {
    const int nblk = N / 32, kb = item / nblk, nb = item % nblk, k0 = 64 * kb, n0 = 32 * nb;
    { f32x4 v_[8];
#pragma unroll
      for (int i = 0; i < 8; ++i) v_[i] = *(const GAS f32x4*)(W + (size_t)(k0 + i * 8 + (lane >> 3)) * N + n0 + (lane & 7) * 4);
#pragma unroll
      for (int i = 0; i < 8; ++i) { LAS float* d_ = scr + (i * 8 + (lane >> 3)) * 33 + (lane & 7) * 4; d_[0] = v_[i].x; d_[1] = v_[i].y; d_[2] = v_[i].z; d_[3] = v_[i].w; } }
    LDS_WAIT(); asm volatile("" ::: "memory");
    const int c = lane & 7;
#pragma unroll
    for (int j = 0; j < 4; ++j) { const int n = (lane >> 3) + 8 * j; const LAS float* s = scr + (8 * c) * 33 + n;
        v4u o; o.x = pk2(s[0 * 33], s[1 * 33]); o.y = pk2(s[2 * 33], s[3 * 33]); o.z = pk2(s[4 * 33], s[5 * 33]); o.w = pk2(s[6 * 33], s[7 * 33]);
        *(GAS v4u*)(WT + (size_t)(n0 + n) * ldo + k0 + 8 * c) = o; }
    LDS_WAIT(); asm volatile("" ::: "memory");
}
__device__ __forceinline__ void p0_transpose_item_fp8(const float* W, int ldo8, int N, unsigned char* WT8, int ncol0, int nb, int kb, LAS float* scr, int lane, float sc) {
    const int k0 = 64 * kb, n0 = 32 * nb;
    { f32x4 v_[8];
#pragma unroll
      for (int i = 0; i < 8; ++i) v_[i] = *(const GAS f32x4*)(W + (size_t)(k0 + i * 8 + (lane >> 3)) * N + ncol0 + n0 + (lane & 7) * 4);
#pragma unroll
      for (int i = 0; i < 8; ++i) { LAS float* d_ = scr + (i * 8 + (lane >> 3)) * 33 + (lane & 7) * 4; d_[0] = v_[i].x; d_[1] = v_[i].y; d_[2] = v_[i].z; d_[3] = v_[i].w; } }
    LDS_WAIT(); asm volatile("" ::: "memory");
    const int c = lane & 3;
#pragma unroll
    for (int j = 0; j < 2; ++j) { const int n = (lane >> 2) + 16 * j; const LAS float* s = scr + (16 * c) * 33 + n; v4u o;
        int w0 = __builtin_amdgcn_cvt_pk_fp8_f32(s[0 * 33] * sc, s[1 * 33] * sc, 0, false); w0 = __builtin_amdgcn_cvt_pk_fp8_f32(s[2 * 33] * sc, s[3 * 33] * sc, w0, true);
        int w1 = __builtin_amdgcn_cvt_pk_fp8_f32(s[4 * 33] * sc, s[5 * 33] * sc, 0, false); w1 = __builtin_amdgcn_cvt_pk_fp8_f32(s[6 * 33] * sc, s[7 * 33] * sc, w1, true);
        int w2 = __builtin_amdgcn_cvt_pk_fp8_f32(s[8 * 33] * sc, s[9 * 33] * sc, 0, false); w2 = __builtin_amdgcn_cvt_pk_fp8_f32(s[10 * 33] * sc, s[11 * 33] * sc, w2, true);
        int w3 = __builtin_amdgcn_cvt_pk_fp8_f32(s[12 * 33] * sc, s[13 * 33] * sc, 0, false); w3 = __builtin_amdgcn_cvt_pk_fp8_f32(s[14 * 33] * sc, s[15 * 33] * sc, w3, true);
        o.x = (unsigned)w0; o.y = (unsigned)w1; o.z = (unsigned)w2; o.w = (unsigned)w3;
        *(GAS v4u*)(WT8 + (size_t)(n0 + n) * ldo8 + k0 + 16 * c) = o; }
    LDS_WAIT(); asm volatile("" ::: "memory");
}
__device__ __forceinline__ void rms_row_to_bf16(const float* xrow, const float* gain, bf16* orow, int lane, unsigned char* o8row = nullptr, float sc8 = 1.f) {
    const GAS f32x4* xr = (const GAS f32x4*)xrow + lane;
    f32x4 v[16]; float s = 0.f;
#pragma unroll
    for (int i = 0; i < 16; ++i) { v[i] = xr[64 * i]; s += (v[i].x * v[i].x + v[i].y * v[i].y) + (v[i].z * v[i].z + v[i].w * v[i].w); }
    const GAS f32x4* gr = (const GAS f32x4*)gain + lane;
    f32x4 gq[16];
#pragma unroll
    for (int i = 0; i < 16; ++i) gq[i] = gr[64 * i];
    const float rs = 1.0f / sqrtf(wave_sum(s) * (1.0f / DM) + EPS);
    asm volatile("" ::: "memory");
    GAS u32x2* o8 = (GAS u32x2*)orow + lane;
#pragma unroll
    for (int i = 0; i < 16; ++i) { const f32x4 g = gq[i]; const float y0 = v[i].x * rs * g.x, y1 = v[i].y * rs * g.y, y2 = v[i].z * rs * g.z, y3 = v[i].w * rs * g.w;
        if (orow) { u32x2 w; w.x = pk2(y0, y1); w.y = pk2(y2, y3); o8[64 * i] = w; }
        if (o8row) { int q; if (PROJ_INT8) q = pk_i8(y0 * sc8, y1 * sc8, y2 * sc8, y3 * sc8); else { q = __builtin_amdgcn_cvt_pk_fp8_f32(y0 * sc8, y1 * sc8, 0, false); q = __builtin_amdgcn_cvt_pk_fp8_f32(y2 * sc8, y3 * sc8, q, true); } ((GAS unsigned*)o8row)[64 * i + lane] = (unsigned)q; } }
}
__device__ __forceinline__ bf16x8 cvt8(const float* p) {
    const f32x4 a = *(const GAS f32x4*)p, b = *(const GAS f32x4*)(p + 4);
    v4u w; w.x = pk2(a.x, a.y); w.y = pk2(a.z, a.w); w.z = pk2(b.x, b.y); w.w = pk2(b.z, b.w);
    return __builtin_bit_cast(bf16x8, w);
}
__device__ __forceinline__ void p0_prologue(Frame& F) {
    LAS float* scr = (LAS float*)(F.lds + RING_OFF + F.wave * 16384);
    const int gw = F.vcu * NWAVES + F.wave, NGW = F.G * NWAVES;
    bf16* WINT = (bf16*)(F.ws + WS_WINT); bf16* WCOT = (bf16*)(F.ws + WS_WCOT);
    constexpr int I_1 = (DM / 64) * (INC / 32), I_2 = (CD / 64) * (DM / 32), I_3 = (AD / 64) * (DM / 32), I_4 = (DM / 64) * (DM / 32);
    constexpr int NITEMS = I_1 + I_2 + I_3 + I_4;
    struct TItem { const float* src; unsigned char* dst; int N, ldo, fp8; float sc; };
#define P0_KB(r, NB) (2 * (((r) >> 1) / (NB)) + ((r) & 1))
#define P0_NB(r, NB) (((r) >> 1) % (NB))
    auto decode = [&](int it) { TItem t; int r = it;
        if (r < I_1) { const int kb = P0_KB(r, INC / 32), nb = P0_NB(r, INC / 32); t.src = F.in[I_WIN] + (size_t)(64 * kb) * INC + 32 * nb; t.N = INC;
            if (nb < Z8_COL0 / 32) { t.fp8 = 0; t.ldo = 2 * LDP; t.dst = (unsigned char*)WINT + (size_t)(32 * nb) * (2 * LDP) + 2 * 64 * kb; t.sc = 1.f; }
            else { t.fp8 = LOWP; t.ldo = 2 * LDP8; t.dst = (unsigned char*)(F.ws + WS_WIN8) + (size_t)(32 * nb - Z8_COL0) * (2 * LDP8) + 64 * kb; t.sc = WIN8_SCALE; }
            return t; } r -= I_1;
        if (r < I_2) { const int kb = P0_KB(r, DM / 32), nb = P0_NB(r, DM / 32); t.src = F.in[I_WCO] + (size_t)(64 * kb) * DM + 32 * nb; t.N = DM;
            if (GEMM2_FUSED) { t.fp8 = 1; t.ldo = 2 * LDP8; t.dst = (unsigned char*)(F.ws + WS_WC) + (size_t)(32 * nb) * (2 * LDP8) + 64 * kb; t.sc = WCO8_SCALE; }
            else if (CONVOUT_INT8 || CONVOUT_FP8) { t.fp8 = CONVOUT_FP8 ? 1 : 2; t.ldo = 2 * LDH8; t.dst = (unsigned char*)WCOT + (size_t)(32 * nb) * (2 * LDH8) + 64 * kb; t.sc = WCO8_SCALE; }
            else { t.fp8 = 0; t.ldo = 2 * LDH; t.dst = (unsigned char*)WCOT + (size_t)(32 * nb) * (2 * LDH) + 2 * 64 * kb; t.sc = 1.f; }
            return t; } r -= I_2;
        if (r < I_3) { const int kb = P0_KB(r, DM / 32), nb = P0_NB(r, DM / 32); t.src = F.in[I_WAO] + (size_t)(64 * kb) * DM + 32 * nb; t.N = DM; t.fp8 = 1; t.sc = WAO8_SCALE;
            if (GEMM2_FUSED) { t.ldo = 2 * LDP8; t.dst = (unsigned char*)(F.ws + WS_WC) + (size_t)(32 * nb) * (2 * LDP8) + 2048 + 64 * kb; }
            else { t.ldo = 2 * LDH8; t.dst = (unsigned char*)(F.ws + WS_WAO8) + (size_t)(32 * nb) * (2 * LDH8) + 64 * kb; }
            return t; } r -= I_3;
        { const int kb = P0_KB(r, DM / 32), nb = P0_NB(r, DM / 32); t.src = F.in[I_WO] + (size_t)(64 * kb) * DM + 32 * nb; t.N = DM;
          if (GEMM3_FP8) { t.fp8 = LOWP; t.ldo = 2 * LDP8; t.dst = (unsigned char*)(F.ws + WS_WOT) + (size_t)(32 * nb) * (2 * LDP8) + 64 * kb; t.sc = WO8_SCALE; }
          else { t.fp8 = 0; t.ldo = 2 * LDP; t.dst = (unsigned char*)(F.ws + WS_WOT) + (size_t)(32 * nb) * (2 * LDP) + 2 * 64 * kb; t.sc = 1.f; } }
        return t; };
#define P0_LOAD(T, V) do { _Pragma("unroll") for (int i = 0; i < 8; ++i) V[i] = *(const GAS f32x4*)(T.src + (size_t)(i * 8 + (F.lane >> 3)) * T.N + (F.lane & 7) * 4); } while (0)
#define P0_PROC(T, V) do { _Pragma("unroll") for (int i = 0; i < 8; ++i) { LAS float* d_ = scr + (i * 8 + (F.lane >> 3)) * 33 + (F.lane & 7) * 4; d_[0] = V[i].x; d_[1] = V[i].y; d_[2] = V[i].z; d_[3] = V[i].w; } \
        LDS_WAIT(); asm volatile("" ::: "memory"); \
        if (T.fp8) { const int c = F.lane & 3; const float sc = T.sc; \
            _Pragma("unroll") for (int j = 0; j < 2; ++j) { const int n = (F.lane >> 2) + 16 * j; const LAS float* s = scr + (16 * c) * 33 + n; v4u o; \
                int w0, w1, w2, w3; \
                if (T.fp8 == 2) { w0 = pk_i8(s[0 * 33] * sc, s[1 * 33] * sc, s[2 * 33] * sc, s[3 * 33] * sc); w1 = pk_i8(s[4 * 33] * sc, s[5 * 33] * sc, s[6 * 33] * sc, s[7 * 33] * sc); w2 = pk_i8(s[8 * 33] * sc, s[9 * 33] * sc, s[10 * 33] * sc, s[11 * 33] * sc); w3 = pk_i8(s[12 * 33] * sc, s[13 * 33] * sc, s[14 * 33] * sc, s[15 * 33] * sc); } \
                else { w0 = __builtin_amdgcn_cvt_pk_fp8_f32(s[0 * 33] * sc, s[1 * 33] * sc, 0, false); w0 = __builtin_amdgcn_cvt_pk_fp8_f32(s[2 * 33] * sc, s[3 * 33] * sc, w0, true); \
                w1 = __builtin_amdgcn_cvt_pk_fp8_f32(s[4 * 33] * sc, s[5 * 33] * sc, 0, false); w1 = __builtin_amdgcn_cvt_pk_fp8_f32(s[6 * 33] * sc, s[7 * 33] * sc, w1, true); \
                w2 = __builtin_amdgcn_cvt_pk_fp8_f32(s[8 * 33] * sc, s[9 * 33] * sc, 0, false); w2 = __builtin_amdgcn_cvt_pk_fp8_f32(s[10 * 33] * sc, s[11 * 33] * sc, w2, true); \
                w3 = __builtin_amdgcn_cvt_pk_fp8_f32(s[12 * 33] * sc, s[13 * 33] * sc, 0, false); w3 = __builtin_amdgcn_cvt_pk_fp8_f32(s[14 * 33] * sc, s[15 * 33] * sc, w3, true); } \
                o.x = (unsigned)w0; o.y = (unsigned)w1; o.z = (unsigned)w2; o.w = (unsigned)w3; *(GAS v4u*)(T.dst + (size_t)n * T.ldo + 16 * c) = o; } } \
        else { const int c = F.lane & 7; \
            _Pragma("unroll") for (int j = 0; j < 4; ++j) { const int n = (F.lane >> 3) + 8 * j; const LAS float* s = scr + (8 * c) * 33 + n; v4u o; \
                o.x = pk2(s[0 * 33], s[1 * 33]); o.y = pk2(s[2 * 33], s[3 * 33]); o.z = pk2(s[4 * 33], s[5 * 33]); o.w = pk2(s[6 * 33], s[7 * 33]); *(GAS v4u*)(T.dst + (size_t)n * T.ldo + 16 * c) = o; } } \
        LDS_WAIT(); asm volatile("" ::: "memory"); } while (0)
    {
        int it = gw; TItem ta, tb; f32x4 va[8], vb[8];
        if (it < NITEMS) { ta = decode(it); P0_LOAD(ta, va); }
        while (it < NITEMS) {
            int itn = it + NGW; if (itn < NITEMS) { tb = decode(itn); P0_LOAD(tb, vb); }
            P0_PROC(ta, va); it = itn; if (it >= NITEMS) break;
            itn = it + NGW; if (itn < NITEMS) { ta = decode(itn); P0_LOAD(ta, va); }
            P0_PROC(tb, vb); it = itn;
        }
    }
#undef P0_KB
#undef P0_NB
#undef P0_LOAD
#undef P0_PROC
    bf16* HN = (bf16*)(F.ws + WS_HN);
    for (int m = gw; m < T_; m += NGW) rms_row_to_bf16(F.in[I_X] + (size_t)m * DM, F.in[I_NMIX], Z8_COL0 > 0 ? HN + (size_t)m * LDP : nullptr, F.lane, (unsigned char*)(F.ws + WS_HN8) + (size_t)m * (2 * LDP8), HN8_SCALE);
    {
        bf16* WF = (bf16*)(F.ws + WS_WPQF); const float* SK = F.in[I_SUBK]; const float* WQ = F.in[I_WPQ];
        const int l15 = F.lane & 15, l4 = F.lane >> 4;
        for (int task = gw; task < 2048; task += NGW) {
            const int combo = task & 127, kr = task >> 7, hc = combo >> 3, kt = combo & 7, n0 = hc * 128 + kt * 16;
            bf16x8 bfr[4];
#pragma unroll
            for (int ds = 0; ds < 4; ++ds) bfr[ds] = cvt8(SK + (size_t)(n0 + l15) * 128 + ds * 32 + 8 * l4);
#pragma unroll 1
            for (int kq = 0; kq < 4; ++kq) {
                f32x4 ra[4][4], rb[4][4];
#pragma unroll
                for (int g = 0; g < 4; ++g)
#pragma unroll
                    for (int ds = 0; ds < 4; ++ds) { const float* wp = WQ + (size_t)(kr * 256 + (kq * 4 + g) * 16 + l15) * 2048 + hc * 128 + ds * 32 + 8 * l4; ra[g][ds] = *(const GAS f32x4*)wp; rb[g][ds] = *(const GAS f32x4*)(wp + 4); }
#pragma unroll
                for (int g = 0; g < 4; ++g) {
                    const int k0 = kr * 256 + (kq * 4 + g) * 16;
                    pg8::f32x4 acc = {0.f, 0.f, 0.f, 0.f};
#pragma unroll
                    for (int ds = 0; ds < 4; ++ds) { v4u w; w.x = pk2(ra[g][ds].x, ra[g][ds].y); w.y = pk2(ra[g][ds].z, ra[g][ds].w); w.z = pk2(rb[g][ds].x, rb[g][ds].y); w.w = pk2(rb[g][ds].z, rb[g][ds].w);
                        acc = __builtin_amdgcn_mfma_f32_16x16x32_bf16(__builtin_bit_cast(bf16x8, w), bfr[ds], acc, 0, 0, 0); }
                    if (SCORES_INT8) *(GAS unsigned*)((unsigned char*)WF + (size_t)(n0 + l15) * (2 * LDP8) + k0 + 4 * l4) = (unsigned)pk_i8(acc[0] * WPQ8_SCALE, acc[1] * WPQ8_SCALE, acc[2] * WPQ8_SCALE, acc[3] * WPQ8_SCALE);
                    else { u32x2 w; w.x = pk2(acc[0], acc[1]); w.y = pk2(acc[2], acc[3]);
                    *(GAS u32x2*)(WF + (size_t)(n0 + l15) * LDP + k0 + 4 * l4) = w; }
                }
            }
        }
    }
    static_assert(PEER_USCALE == pg8::HK_USCALE && PEER_VSCALE == pg8::HK_VSCALE, "TblHook scales");
    if (!UV_IN_GEMM1) {
        const size_t n8 = (size_t)NEXP * DM / 8; const size_t gt = (size_t)F.vcu * (NWAVES * 64) + F.tid, nth = (size_t)F.G * (NWAVES * 64);
        unsigned char* UB = (unsigned char*)(F.ws + WS_UB); unsigned char* VB = (unsigned char*)(F.ws + WS_VB);
        auto cvt_chunk = [&](size_t i, const f32x4 a, const f32x4 b) { const bool isu = i < n8; const size_t j = isu ? i : i - n8; const float sc = isu ? PEER_USCALE : PEER_VSCALE;
            int w0, w1;
            if (isu) { w0 = pk_i8(a.x * sc, a.y * sc, a.z * sc, a.w * sc); w1 = pk_i8(b.x * sc, b.y * sc, b.z * sc, b.w * sc); }
            else { w0 = __builtin_amdgcn_cvt_pk_fp8_f32(a.x * sc, a.y * sc, 0, false); w0 = __builtin_amdgcn_cvt_pk_fp8_f32(a.z * sc, a.w * sc, w0, true);
                   w1 = __builtin_amdgcn_cvt_pk_fp8_f32(b.x * sc, b.y * sc, 0, false); w1 = __builtin_amdgcn_cvt_pk_fp8_f32(b.z * sc, b.w * sc, w1, true); }
            const size_t e = j >> 9, col = (j & 511) * 8, sl = col >> 10, c = col & 1023;
            u32x2 w; w.x = (unsigned)w0; w.y = (unsigned)w1; *(GAS u32x2*)((isu ? UB : VB) + (sl * NEXP + e) * 1024 + c) = w; };
        auto src_of = [&](size_t i) { const bool isu = i < n8; const size_t j = isu ? i : i - n8; return (isu ? F.in[I_UEMB] : F.in[I_VEMB]) + j * 8; };
        size_t i = gt;
        for (; i + 7 * nth < 2 * n8; i += 8 * nth) {
            f32x4 a_[8], b_[8];
#pragma unroll
            for (int c = 0; c < 8; ++c) { const float* sp = src_of(i + c * nth); a_[c] = *(const GAS f32x4*)sp; b_[c] = *(const GAS f32x4*)(sp + 4); }
#pragma unroll
            for (int c = 0; c < 8; ++c) cvt_chunk(i + c * nth, a_[c], b_[c]);
        }
        for (; i < 2 * n8; i += nth) { const float* s0 = src_of(i); const f32x4 a0 = *(const GAS f32x4*)s0, b0 = *(const GAS f32x4*)(s0 + 4); cvt_chunk(i, a0, b0); }
    }
}
__device__ __forceinline__ void p2_conv_kmean(Frame& F) {
    const bf16* Z = (const bf16*)(F.ws + WS_Z);
    float* KM = (float*)(F.ws + WS_KMEAN);
    LAS float* red = (LAS float*)(F.lds + RING_OFF);
    for (int u = F.vcu; u < 128; u += F.G) {
        const int bn = u >> 2, cg = u & 3, b = bn >> 3, n = bn & 7;
        const bf16* kp = Z + (size_t)(b * SEQ + n * 256 + F.wave * 32) * INC + ZC_K + cg * 512 + F.lane * 8;
        float s[8];
#pragma unroll
        for (int e = 0; e < 8; ++e) s[e] = 0.f;
#pragma unroll 16
        for (int t = 0; t < 32; ++t) { const v4u w = *(const GAS v4u*)(kp + (size_t)t * INC);
            s[0] += bflo(w.x); s[1] += bfhi(w.x); s[2] += bflo(w.y); s[3] += bfhi(w.y); s[4] += bflo(w.z); s[5] += bfhi(w.z); s[6] += bflo(w.w); s[7] += bfhi(w.w); }
        __syncthreads();
#pragma unroll
        for (int e = 0; e < 8; ++e) red[F.wave * 512 + F.lane * 8 + e] = s[e];
        __syncthreads();
        { float a = 0.f;
#pragma unroll
          for (int w = 0; w < 8; ++w) a += red[w * 512 + F.tid];
          const int col = cg * 512 + F.tid, h = col >> 7, d = col & 127;
          KM[((size_t)(b * NH + h) * NBLK + n) * HD + d] = a * (1.0f / 256.0f); }
    }
    const int gw = F.vcu * NWAVES + F.wave, NGW = F.G * NWAVES;
    bf16* BZ = (bf16*)(F.ws + WS_BZ); const float* CW = F.in[I_CONVW];
    for (int u = gw; u < (T_ / 16) * 4; u += NGW) {
        const int ch = u >> 2, cg = u & 3, t0 = ch * 16, c0 = cg * 512 + F.lane * 8;
        float w0[8], w1[8], w2[8];
#pragma unroll
        for (int e = 0; e < 8; ++e) { w0[e] = CW[c0 + e]; w1[e] = CW[CD + c0 + e]; w2[e] = CW[2 * CD + c0 + e]; }
        float p2[8], p1[8];
        const bool first = (t0 % SEQ) == 0;
#pragma unroll
        for (int e = 0; e < 8; ++e) { p2[e] = 0.f; p1[e] = 0.f; }
        if (!first) {
            const bf16* zr2 = Z + (size_t)(t0 - 2) * INC + c0; const bf16* zr1 = Z + (size_t)(t0 - 1) * INC + c0;
            const v4u c2 = *(const GAS v4u*)(zr2 + ZC_C), u2 = *(const GAS v4u*)(zr2 + ZC_U), c1 = *(const GAS v4u*)(zr1 + ZC_C), u1 = *(const GAS v4u*)(zr1 + ZC_U);
            p2[0] = bflo(c2.x) * bflo(u2.x); p2[1] = bfhi(c2.x) * bfhi(u2.x); p2[2] = bflo(c2.y) * bflo(u2.y); p2[3] = bfhi(c2.y) * bfhi(u2.y);
            p2[4] = bflo(c2.z) * bflo(u2.z); p2[5] = bfhi(c2.z) * bfhi(u2.z); p2[6] = bflo(c2.w) * bflo(u2.w); p2[7] = bfhi(c2.w) * bfhi(u2.w);
            p1[0] = bflo(c1.x) * bflo(u1.x); p1[1] = bfhi(c1.x) * bfhi(u1.x); p1[2] = bflo(c1.y) * bflo(u1.y); p1[3] = bfhi(c1.y) * bfhi(u1.y);
            p1[4] = bflo(c1.z) * bflo(u1.z); p1[5] = bfhi(c1.z) * bfhi(u1.z); p1[6] = bflo(c1.w) * bflo(u1.w); p1[7] = bfhi(c1.w) * bfhi(u1.w);
        }
        constexpr int CONV_TB = 4;
#pragma unroll 1
        for (int th = 0; th < 16; th += CONV_TB) {
        v4u ccv[CONV_TB], uuv[CONV_TB], bbv[CONV_TB];
#pragma unroll
        for (int t8 = 0; t8 < CONV_TB; ++t8) { const bf16* zr = Z + (size_t)(t0 + th + t8) * INC + c0; ccv[t8] = *(const GAS v4u*)(zr + ZC_C); uuv[t8] = *(const GAS v4u*)(zr + ZC_U); bbv[t8] = *(const GAS v4u*)(zr + ZC_B); }
        asm volatile("" ::: "memory");
#pragma unroll
        for (int t8 = 0; t8 < CONV_TB; ++t8) { const int t = th + t8;
            const v4u cc = ccv[t8], uu = uuv[t8], bb = bbv[t8];
            float p0[8], bg[8], o[8];
            p0[0] = bflo(cc.x) * bflo(uu.x); p0[1] = bfhi(cc.x) * bfhi(uu.x); p0[2] = bflo(cc.y) * bflo(uu.y); p0[3] = bfhi(cc.y) * bfhi(uu.y);
            p0[4] = bflo(cc.z) * bflo(uu.z); p0[5] = bfhi(cc.z) * bfhi(uu.z); p0[6] = bflo(cc.w) * bflo(uu.w); p0[7] = bfhi(cc.w) * bfhi(uu.w);
            bg[0] = bflo(bb.x); bg[1] = bfhi(bb.x); bg[2] = bflo(bb.y); bg[3] = bfhi(bb.y); bg[4] = bflo(bb.z); bg[5] = bfhi(bb.z); bg[6] = bflo(bb.w); bg[7] = bfhi(bb.w);
#pragma unroll
            for (int e = 0; e < 8; ++e) { o[e] = bg[e] * (w0[e] * p2[e] + w1[e] * p1[e] + w2[e] * p0[e]); p2[e] = p1[e]; p1[e] = p0[e]; }
            if (CONVOUT_FP8) { u32x2 w8; int q0 = __builtin_amdgcn_cvt_pk_fp8_f32(o[0] * BZ8_SCALE, o[1] * BZ8_SCALE, 0, false); q0 = __builtin_amdgcn_cvt_pk_fp8_f32(o[2] * BZ8_SCALE, o[3] * BZ8_SCALE, q0, true);
                int q1 = __builtin_amdgcn_cvt_pk_fp8_f32(o[4] * BZ8_SCALE, o[5] * BZ8_SCALE, 0, false); q1 = __builtin_amdgcn_cvt_pk_fp8_f32(o[6] * BZ8_SCALE, o[7] * BZ8_SCALE, q1, true); w8.x = (unsigned)q0; w8.y = (unsigned)q1;
                if (GEMM2_FUSED) *(GAS u32x2*)((unsigned char*)(F.ws + WS_AC) + (size_t)(t0 + t) * (2 * LDP8) + c0) = w8;
                else *(GAS u32x2*)((unsigned char*)BZ + (size_t)(t0 + t) * (2 * LDH8) + c0) = w8; }
            else if (CONVOUT_INT8) { u32x2 w8; w8.x = (unsigned)pk_i8(o[0] * BZ8_SCALE, o[1] * BZ8_SCALE, o[2] * BZ8_SCALE, o[3] * BZ8_SCALE); w8.y = (unsigned)pk_i8(o[4] * BZ8_SCALE, o[5] * BZ8_SCALE, o[6] * BZ8_SCALE, o[7] * BZ8_SCALE);
                *(GAS u32x2*)((unsigned char*)BZ + (size_t)(t0 + t) * (2 * LDH8) + c0) = w8; }
            else { v4u w; w.x = pk2(o[0], o[1]); w.y = pk2(o[2], o[3]); w.z = pk2(o[4], o[5]); w.w = pk2(o[6], o[7]);
            *(GAS v4u*)(BZ + (size_t)(t0 + t) * LDH + c0) = w; }
        }
        asm volatile("" ::: "memory");
        }
    }
}
__device__ __forceinline__ void p3_attention(Frame& F, char* lds) {
    const bf16* Z = (const bf16*)(F.ws + WS_Z); unsigned char* ATT = (unsigned char*)(F.ws + WS_ATT); const float* KM = (const float*)(F.ws + WS_KMEAN);
    for (int u = F.vcu; u < NBATCH * NH * 4; u += F.G) {
        const int bh = u >> 2, p = u & 3, b = bh / NH, h = bh % NH;
        const bf16* Kh = Z + (size_t)(b * SEQ) * INC + ZC_K + h * HD; const bf16* Vh = Z + (size_t)(b * SEQ) * INC + ZC_V + h * HD;
        const float* km = KM + (size_t)(b * NH + h) * NBLK * HD;
#pragma unroll 1
        for (int half = 0; half < 2; ++half) {
            const int qb = half == 0 ? 7 - p : p;
            const bf16* Qb = Z + (size_t)(b * SEQ + qb * 256) * INC + ZC_Q + h * HD;
            unsigned char* Ob = GEMM2_FUSED ? (unsigned char*)(F.ws + WS_AC) + (size_t)(b * SEQ + qb * 256) * (2 * LDP8) + 2048 + h * HD : ATT + (size_t)(b * SEQ + qb * 256) * (2 * LDH8) + h * HD;
            moba::moba_body(Qb, Kh, Vh, km, Ob, qb, lds);
        }
    }
}
__device__ __forceinline__ void rms_rowbf_to_bf16(const bf16* hrow, const float* gain, bf16* orow, int lane, unsigned char* q8row = nullptr) {
    const GAS v4u* hr = (const GAS v4u*)hrow + lane;
    v4u v[8]; float s = 0.f;
#pragma unroll
    for (int i = 0; i < 8; ++i) { v[i] = hr[64 * i];
        s += (bflo(v[i].x) * bflo(v[i].x) + bfhi(v[i].x) * bfhi(v[i].x)) + (bflo(v[i].y) * bflo(v[i].y) + bfhi(v[i].y) * bfhi(v[i].y)) + (bflo(v[i].z) * bflo(v[i].z) + bfhi(v[i].z) * bfhi(v[i].z)) + (bflo(v[i].w) * bflo(v[i].w) + bfhi(v[i].w) * bfhi(v[i].w)); }
    const float rs = 1.0f / sqrtf(wave_sum(s) * (1.0f / DM) + EPS);
    GAS v4u* o8 = (GAS v4u*)orow + lane;
#pragma unroll
    for (int i = 0; i < 8; ++i) { const f32x4 g0 = *(const GAS f32x4*)(gain + 512 * i + 8 * lane), g1 = *(const GAS f32x4*)(gain + 512 * i + 8 * lane + 4); v4u w;
        w.x = pk2(bflo(v[i].x) * rs * g0.x, bfhi(v[i].x) * rs * g0.y); w.y = pk2(bflo(v[i].y) * rs * g0.z, bfhi(v[i].y) * rs * g0.w);
        w.z = pk2(bflo(v[i].z) * rs * g1.x, bfhi(v[i].z) * rs * g1.y); w.w = pk2(bflo(v[i].w) * rs * g1.z, bfhi(v[i].w) * rs * g1.w);
        if (q8row) { const float q = rs * XN8_SCALE; u32x2 w8; w8.x = (unsigned)pk_i8(bflo(v[i].x) * q * g0.x, bfhi(v[i].x) * q * g0.y, bflo(v[i].y) * q * g0.z, bfhi(v[i].y) * q * g0.w); w8.y = (unsigned)pk_i8(bflo(v[i].z) * q * g1.x, bfhi(v[i].z) * q * g1.y, bflo(v[i].w) * q * g1.z, bfhi(v[i].w) * q * g1.w);
            ((GAS u32x2*)q8row)[64 * i + lane] = w8; }
        else o8[64 * i] = w; }
}
__device__ __forceinline__ void p6_rms(Frame& F) {
    const int gw = F.vcu * NWAVES + F.wave, NGW = F.G * NWAVES; bf16* XN = (bf16*)(F.ws + WS_XN); const bf16* HB = (const bf16*)(F.ws + WS_HB);
    for (int m = gw; m < T_; m += NGW) rms_rowbf_to_bf16(HB + (size_t)m * DM, F.in[I_NFFN], XN + (size_t)m * LDP, F.lane, SCORES_INT8 ? (unsigned char*)XN + (size_t)m * (2 * LDP8) : nullptr);
}
__device__ __forceinline__ int fkey(float f) { const int b = __float_as_int(f); return b ^ ((b >> 31) & 0x7fffffff); }
__device__ __forceinline__ float kval(int k) { return __int_as_float(k ^ ((k >> 31) & 0x7fffffff)); }
__device__ __forceinline__ int imax(int a, int b) { return a > b ? a : b; }
__device__ __forceinline__ int imin(int a, int b) { return a < b ? a : b; }
__device__ __forceinline__ void sort16_desc(int (&v)[16]) {
#pragma unroll
    for (int k = 2; k <= 16; k <<= 1)
#pragma unroll
        for (int j = k >> 1; j > 0; j >>= 1)
#pragma unroll
            for (int i = 0; i < 16; ++i) { const int l = i ^ j; if (l > i) { const int a = v[i], b = v[l]; const int mx = imax(a, b), mn = imin(a, b); const bool desc = (i & k) == 0; v[i] = desc ? mx : mn; v[l] = desc ? mn : mx; } }
}
__device__ __forceinline__ void merge_top16(int (&run)[16], const int (&grp)[16]) {
#pragma unroll
    for (int i = 0; i < 16; ++i) run[i] = imax(run[i], grp[15 - i]);
#pragma unroll
    for (int j = 8; j > 0; j >>= 1)
#pragma unroll
        for (int i = 0; i < 16; ++i) { const int l = i ^ j; if (l > i) { const int a = run[i], b = run[l]; run[i] = imax(a, b); run[l] = imin(a, b); } }
}
__device__ __forceinline__ void topk128(const float* sp, int (&run)[16]) {
#pragma unroll
    for (int i = 0; i < 16; ++i) run[i] = (int)0x80000000;
#pragma unroll 1
    for (int gg = 0; gg < 2; ++gg) {
        float raw[64];
#pragma unroll
        for (int i = 0; i < 64; ++i) raw[i] = sp[(size_t)(gg * 64 + i) * T_];
#pragma unroll
        for (int g = 0; g < 4; ++g) {
            int grp[16];
#pragma unroll
            for (int i = 0; i < 16; ++i) grp[i] = (fkey(raw[g * 16 + i]) & ~0x7F) | (gg * 64 + g * 16 + i);
            sort16_desc(grp);
            merge_top16(run, grp);
        }
    }
}
struct CandTab { int a[64], b[64]; };
__host__ __device__ constexpr CandTab make_cand() { CandTab t{}; int n = 0; for (int a = 0; a < 16; ++a) for (int b = 0; b < 16; ++b) if ((a + 1) * (b + 1) <= 16) { t.a[n] = a; t.b[n] = b; ++n; }
    for (; n < 64; ++n) { t.a[n] = -1; t.b[n] = -1; } return t; }
constexpr size_t WS_PART = WS_Z, WS_SSQ = WS_Z + 32 * MiB, WS_ES = WS_Z + 33 * MiB, WS_GS = WS_Z + 37 * MiB, WS_BST = WS_Z + 41 * MiB;
constexpr int NBUCK = 8, BUCK_SHIFT = 11;
__device__ __forceinline__ void p8_topk(Frame& F) {
    constexpr CandTab CT = make_cand();
    const float* ST = (const float*)(F.ws + WS_ST); int* EXP = (int*)(F.ws + WS_EXP); float* GATE = (float*)(F.ws + WS_GATE);
    int* ES = (int*)(F.ws + WS_ES); float* GS = (float*)(F.ws + WS_GS); int* BST = (int*)(F.ws + WS_BST);
    LAS int* EL = (LAS int*)(F.lds + RING_OFF); LAS float* GL = (LAS float*)(F.lds + RING_OFF + 16384);
    LAS int* tab = (LAS int*)(F.lds + RING_OFF + 32768 + F.wave * 8192);
    const int lane = F.lane, tl = lane & 31, c = lane >> 5, h = F.wave;
    for (int u = F.vcu; u < T_ / 32; u += F.G) {
        const int t = u * 32 + tl;
        int mine[16];
        topk128(ST + (size_t)((h * 2 + c) * 128) * T_ + t, mine);
        float s1[16], s2[16];
#pragma unroll
        for (int i = 0; i < 16; ++i) { const int other = __shfl_xor(mine[i], 32); const int k1 = c ? other : mine[i], k2 = c ? mine[i] : other;
            s1[i] = kval(k1 & ~0x7F); s2[i] = kval(k2 & ~0x7F); tab[i * 64 + lane] = k1 & 0x7F; tab[(16 + i) * 64 + lane] = k2 & 0x7F; }
        int c0[16], c1[16], c2[16], c3[16];
#pragma unroll
        for (int i = 0; i < 16; ++i) {
            c0[i] = CT.a[i] < 0 ? (int)0x80000000 : ((fkey(s1[CT.a[i] < 0 ? 0 : CT.a[i]] + s2[CT.b[i] < 0 ? 0 : CT.b[i]]) & ~0xFF) | (CT.a[i] * 16 + CT.b[i]));
            c1[i] = CT.a[16 + i] < 0 ? (int)0x80000000 : ((fkey(s1[CT.a[16 + i] < 0 ? 0 : CT.a[16 + i]] + s2[CT.b[16 + i] < 0 ? 0 : CT.b[16 + i]]) & ~0xFF) | (CT.a[16 + i] * 16 + CT.b[16 + i]));
            c2[i] = CT.a[32 + i] < 0 ? (int)0x80000000 : ((fkey(s1[CT.a[32 + i] < 0 ? 0 : CT.a[32 + i]] + s2[CT.b[32 + i] < 0 ? 0 : CT.b[32 + i]]) & ~0xFF) | (CT.a[32 + i] * 16 + CT.b[32 + i]));
            c3[i] = CT.a[48 + i] < 0 ? (int)0x80000000 : ((fkey(s1[CT.a[48 + i] < 0 ? 0 : CT.a[48 + i]] + s2[CT.b[48 + i] < 0 ? 0 : CT.b[48 + i]]) & ~0xFF) | (CT.a[48 + i] * 16 + CT.b[48 + i]));
        }
        sort16_desc(c0); sort16_desc(c1); sort16_desc(c2); sort16_desc(c3);
        merge_top16(c0, c1); merge_top16(c2, c3); merge_top16(c0, c2);
        LDS_WAIT();
        float rs = 1.0f;
        if (DEFER_FFN_NORM) { const float* sp_ = (const float*)(F.ws + WS_SSQP) + (size_t)t * 64; float a_ = 0.f;
#pragma unroll
            for (int j = 0; j < 16; ++j) { const f32x4 v_ = *(const GAS f32x4*)(sp_ + 4 * j); a_ += (v_.x + v_.y) + (v_.z + v_.w); }
            rs = 1.0f / sqrtf(a_ * (1.0f / DM) + EPS); if (h == 0 && c == 0) ((float*)(F.ws + WS_RS))[t] = rs; }
        int ex[16]; float gv[16]; float sum = 0.f; const float mx = kval(c0[0] & ~0xFF);
#pragma unroll
        for (int i = 0; i < 16; ++i) { const int ab = c0[i] & 0xFF, a = ab >> 4, b = ab & 15; const int i1 = tab[a * 64 + lane], i2 = tab[(16 + b) * 64 + lane];
            ex[i] = i1 * NKEYS + i2; gv[i] = __expf((kval(c0[i] & ~0xFF) - mx) * rs); sum += gv[i]; }
        const float inv = 1.0f / sum;
        if (c == 0) {
            int* ep = EXP + (size_t)t * NSEL + h * PTOPK; float* gp = GATE + (size_t)t * NSEL + h * PTOPK;
#pragma unroll
            for (int i = 0; i < 16; i += 4) { *(int4*)(ep + i) = make_int4(ex[i], ex[i + 1], ex[i + 2], ex[i + 3]); *(float4*)(gp + i) = make_float4(gv[i] * inv, gv[i + 1] * inv, gv[i + 2] * inv, gv[i + 3] * inv); }
#pragma unroll
            for (int i = 0; i < 16; ++i) { EL[tl * NSEL + h * PTOPK + i] = ex[i]; GL[tl * NSEL + h * PTOPK + i] = gv[i] * inv; }
        }
        __syncthreads();
#pragma unroll
        for (int q = 0; q < 4; ++q) {
            const int tq = F.wave * 4 + q; const size_t tt = (size_t)(u * 32 + tq);
            int k0 = (EL[tq * NSEL + lane] << 7) | lane, k1 = (EL[tq * NSEL + 64 + lane] << 7) | (64 + lane);
#pragma unroll
            for (int k = 2; k <= 128; k <<= 1)
#pragma unroll
                for (int j = k >> 1; j > 0; j >>= 1) {
                    if (j == 64) { const int lo = imin(k0, k1), hi = imax(k0, k1); k0 = lo; k1 = hi; }
                    else { const int p0 = __shfl_xor(k0, j), p1 = __shfl_xor(k1, j); const bool lower = (lane & j) == 0, up0 = (lane & k) == 0, up1 = ((64 + lane) & k) == 0;
                        k0 = (lower == up0) ? imin(k0, p0) : imax(k0, p0); k1 = (lower == up1) ? imin(k1, p1) : imax(k1, p1); }
                }
            const int e0 = k0 >> 7, e1 = k1 >> 7;
            ES[tt * NSEL + lane] = e0; ES[tt * NSEL + 64 + lane] = e1; GS[tt * NSEL + lane] = GL[tq * NSEL + (k0 & 127)]; GS[tt * NSEL + 64 + lane] = GL[tq * NSEL + (k1 & 127)];
            int bstv = 0;
#pragma unroll
            for (int b = 0; b <= NBUCK; ++b) { const int cnt = __popcll(__ballot(e0 < (b << BUCK_SHIFT))) + __popcll(__ballot(e1 < (b << BUCK_SHIFT))); bstv = (lane == b) ? cnt : bstv; }
            if (lane < 16) BST[tt * 16 + lane] = bstv;
        }
        __syncthreads();
    }
}
constexpr int P9_NSL = 4, P9_SLD = DM / P9_NSL, P9_TPS = 4;
constexpr int P9_TPU = 8;
constexpr int P9_WLDS = 9216;
__device__ __forceinline__ int rfl(int v) { return __builtin_amdgcn_readfirstlane(v); }
template <int CTRL, int RMASK> __device__ __forceinline__ float dppadd(float v) { return v + __builtin_bit_cast(float, __builtin_amdgcn_update_dpp(0, __builtin_bit_cast(int, v), CTRL, RMASK, 0xf, false)); }
__device__ __forceinline__ f32x2 fp8lo(unsigned w) { return __builtin_amdgcn_cvt_pk_f32_fp8((int)w, false); }
__device__ __forceinline__ f32x2 fp8hi(unsigned w) { return __builtin_amdgcn_cvt_pk_f32_fp8((int)w, true); }
#define P9_DESC(i) const int d_ = rfl(DS[i]); const int tkd = d_ & 7, pd = (d_ >> 3) & 127, nd = d_ >> 10; const int nm1 = imax(nd, 1) - 1
#define P9_ISSUE(i, W) do { P9_DESC(i); const int ev_ = EL[tkd * 128 + pd + imin(lane & 7, nm1)]; \
        _Pragma("unroll") for (int q = 0; q < 8; ++q) { const int e_ = __builtin_amdgcn_readlane(ev_, q); W[q] = *(const GAS v4u*)(TB + (size_t)e_ * P9_SLD); } } while (0)
#define P9_DOT16(W, K) __builtin_amdgcn_sdot4((int)W.x, xs[K].x, __builtin_amdgcn_sdot4((int)W.y, xs[K].y, __builtin_amdgcn_sdot4((int)W.z, xs[K].z, __builtin_amdgcn_sdot4((int)W.w, xs[K].w, 0, false), false), false), false)
__device__ __forceinline__ int ifold32(int a, int b) { const auto r = __builtin_amdgcn_permlane32_swap((unsigned)a, (unsigned)b, false, false); return (int)(r[0] + r[1]); }
__device__ __forceinline__ int ifold16(int a, int b) { const auto r = __builtin_amdgcn_permlane16_swap((unsigned)a, (unsigned)b, false, false); return (int)(r[0] + r[1]); }
template <int CTRL> __device__ __forceinline__ int idppadd(int v) { return v + __builtin_amdgcn_update_dpp(0, v, CTRL, 0xf, 0xf, false); }
#define P9_DQ(Q, K) ((Q) <= nm1 ? P9_DOT16(W_[Q], K) : 0)
#define P9_CONS_U_TK(K, W) { const v4u (&W_)[8] = W; const int d0 = P9_DOT16(W_[0], K), d1 = P9_DQ(1, K), d2 = P9_DQ(2, K), d3 = P9_DQ(3, K), d4 = P9_DQ(4, K), d5 = P9_DQ(5, K), d6 = P9_DQ(6, K), d7 = P9_DQ(7, K); \
        const int e0 = ifold32(d0, d1), e1 = ifold32(d2, d3), e2 = ifold32(d4, d5), e3 = ifold32(d6, d7); const int f0 = ifold16(e0, e1), f1 = ifold16(e2, e3); \
        const bool up8 = (lane & 8) != 0; int g = up8 ? f1 : f0; const int o = up8 ? f0 : f1; \
        g += __builtin_amdgcn_update_dpp(0, o, 0x128, 0xf, 0xf, false);     \
        g = idppadd<0xB1>(g); g = idppadd<0x4E>(g); g = idppadd<0x141>(g); \
        if ((lane & 7) == 0 && qmap <= nm1) HL[K * 128 + pd + qmap] = (float)g * (1.0f / (PEER_USCALE * (SCORES_INT8 ? XN8_SCALE : PEER_XSCALE))); }
#define P9_CONS_V_TK(K, W) { const float hvv_ = HL[K * 128 + pd + imin(lane & 7, nm1)]; \
        _Pragma("unroll") for (int q = 0; q < 8; ++q) if (q < nd) { const float hq = __builtin_bit_cast(float, __builtin_amdgcn_readlane(__builtin_bit_cast(int, hvv_), q)); const f32x2 h2 = {hq, hq}; const v4u ww = W[q]; \
            acc[K][0] = fp8lo(ww.x) * h2 + acc[K][0]; acc[K][1] = fp8hi(ww.x) * h2 + acc[K][1]; acc[K][2] = fp8lo(ww.y) * h2 + acc[K][2]; acc[K][3] = fp8hi(ww.y) * h2 + acc[K][3]; \
            acc[K][4] = fp8lo(ww.z) * h2 + acc[K][4]; acc[K][5] = fp8hi(ww.z) * h2 + acc[K][5]; acc[K][6] = fp8lo(ww.w) * h2 + acc[K][6]; acc[K][7] = fp8hi(ww.w) * h2 + acc[K][7]; __builtin_amdgcn_sched_barrier(0); } }
#define P9_CONSUME(i, W, CONS) do { P9_DESC(i); switch (tkd) { case 0: CONS(0, W); break; case 1: CONS(1, W); break; case 2: CONS(2, W); break; default: CONS(3, W); break; } } while (0)
#define P9_CONSUME8(i, W, CONS) do { P9_DESC(i); switch (tkd) { case 0: CONS(0, W); break; case 1: CONS(1, W); break; case 2: CONS(2, W); break; case 3: CONS(3, W); break; \
        case 4: CONS(4, W); break; case 5: CONS(5, W); break; case 6: CONS(6, W); break; default: CONS(7, W); break; } } while (0)
#define P9_PIPELINE(CONS) do { v4u wA[8], wB[8], wC[8]; P9_ISSUE(0, wA); P9_ISSUE(1, wB); \
        for (int i = 0; i < NBP; i += 3) { P9_ISSUE(i + 2, wC); P9_CONSUME(i, wA, CONS); P9_ISSUE(i + 3, wA); P9_CONSUME(i + 1, wB, CONS); P9_ISSUE(i + 4, wB); P9_CONSUME(i + 2, wC, CONS); } } while (0)
#define P9_PIPELINE8(CONS) do { v4u wA[8], wB[8], wC[8]; P9_ISSUE(0, wA); P9_ISSUE(1, wB); \
        for (int i = 0; i < NBP; i += 3) { P9_ISSUE(i + 2, wC); P9_CONSUME8(i, wA, CONS); P9_ISSUE(i + 3, wA); P9_CONSUME8(i + 1, wB, CONS); P9_ISSUE(i + 4, wB); P9_CONSUME8(i + 2, wC, CONS); } } while (0)
template <int TPS> __device__ __forceinline__ int p9_build_desc(const int* BST, int tb, int lane, LAS int* DS) {
    const int tkg = lane & (TPS - 1), bg = (lane / TPS) & 7; const int s0 = BST[(size_t)(tb + tkg) * 16 + bg], s1 = BST[(size_t)(tb + tkg) * 16 + bg + 1], cnt = lane < 8 * TPS ? s1 - s0 : 0, nb = (cnt + 7) >> 3;
    int inc = nb;
#pragma unroll
    for (int o = 1; o < 64; o <<= 1) { const int v = __shfl_up(inc, o); inc += (lane >= o) ? v : 0; }
    const int off = inc - nb, NBT = __builtin_amdgcn_readlane(inc, 63);
    for (int i = 0; i < nb; ++i) DS[off + i] = tkg | ((s0 + 8 * i) << 3) | (imin(8, cnt - 8 * i) << 10);
    const int NBP = ((NBT + 2) / 3) * 3;
    if (lane < NBP + 2 - NBT) DS[NBT + lane] = 0;
    LDS_WAIT();
    return NBP;
}
__device__ __forceinline__ void p9a_peer_u(Frame& F) {
    if (F.G % 8 != 0) return;
    const int lane = F.lane, sl = (blockIdx.x & 7) >> 1, rk = (blockIdx.x >> 3) * 2 + (blockIdx.x & 1), NR = F.G >> 2, TPR = T_ / NR;
    const bf16* XN = (const bf16*)(F.ws + WS_XN); const unsigned char* TB = (const unsigned char*)(F.ws + WS_UB) + (size_t)sl * NEXP * P9_SLD + lane * 16;
    const int* ES = (const int*)(F.ws + WS_ES); const int* BST = (const int*)(F.ws + WS_BST); float* PART = (float*)(F.ws + WS_PART) + (size_t)sl * T_ * NSEL;
    LAS int* EL = (LAS int*)(F.lds + RING_OFF + F.wave * P9_WLDS); LAS float* HL = (LAS float*)(EL + 1024); LAS int* DS = EL + 2048;
    const int qmap = 4 * ((lane >> 3) & 1) + 2 * ((lane >> 4) & 1) + (lane >> 5);
    for (int tb = rk * TPR + F.wave * P9_TPU; tb < (rk + 1) * TPR; tb += NWAVES * P9_TPU) {
        typedef int i32x4 __attribute__((ext_vector_type(4))); i32x4 xs[P9_TPU];
#pragma unroll
        for (int tk = 0; tk < P9_TPU; ++tk) { const size_t t = (size_t)(tb + tk);
            if (SCORES_INT8) { const v4u x8 = *(const GAS v4u*)((const unsigned char*)XN + t * (2 * LDP8) + sl * P9_SLD + lane * 16); xs[tk].x = (int)x8.x; xs[tk].y = (int)x8.y; xs[tk].z = (int)x8.z; xs[tk].w = (int)x8.w; }
            else { const bf16* xp = XN + t * LDP + sl * P9_SLD + lane * 16; const v4u x0 = *(const GAS v4u*)xp, x1 = *(const GAS v4u*)(xp + 8);
            xs[tk].x = pk_i8(bflo(x0.x) * PEER_XSCALE, bfhi(x0.x) * PEER_XSCALE, bflo(x0.y) * PEER_XSCALE, bfhi(x0.y) * PEER_XSCALE); xs[tk].y = pk_i8(bflo(x0.z) * PEER_XSCALE, bfhi(x0.z) * PEER_XSCALE, bflo(x0.w) * PEER_XSCALE, bfhi(x0.w) * PEER_XSCALE);
            xs[tk].z = pk_i8(bflo(x1.x) * PEER_XSCALE, bfhi(x1.x) * PEER_XSCALE, bflo(x1.y) * PEER_XSCALE, bfhi(x1.y) * PEER_XSCALE); xs[tk].w = pk_i8(bflo(x1.z) * PEER_XSCALE, bfhi(x1.z) * PEER_XSCALE, bflo(x1.w) * PEER_XSCALE, bfhi(x1.w) * PEER_XSCALE);
            }
            EL[tk * 128 + lane] = ES[t * NSEL + lane]; EL[tk * 128 + 64 + lane] = ES[t * NSEL + 64 + lane]; }
        const int NBP = p9_build_desc<P9_TPU>(BST, tb, lane, DS);
        P9_PIPELINE8(P9_CONS_U_TK);
        LDS_WAIT();
#pragma unroll
        for (int tk = 0; tk < P9_TPU; ++tk) { const size_t t = (size_t)(tb + tk); PART[t * NSEL + lane] = HL[tk * 128 + lane]; PART[t * NSEL + 64 + lane] = HL[tk * 128 + 64 + lane]; }
        LDS_WAIT();
    }
}
__device__ __forceinline__ void p9b_peer_v(Frame& F, float* yout, unsigned* ssqx) {
    if (F.G % 8 != 0) return;
    int lane_o = F.lane; asm volatile("" : "+v"(lane_o));
    const int lane = lane_o, sl = (blockIdx.x & 7) >> 1, rk = (blockIdx.x >> 3) * 2 + (blockIdx.x & 1), NR = F.G >> 2, TPR = T_ / NR;
    const unsigned char* TB = (const unsigned char*)(F.ws + WS_VB) + (size_t)sl * NEXP * P9_SLD + lane * 16;
    const int* ES = (const int*)(F.ws + WS_ES); const float* GS = (const float*)(F.ws + WS_GS); const int* BST = (const int*)(F.ws + WS_BST);
    const float* PART = (const float*)(F.ws + WS_PART); const float* nf = F.in[I_NFIN] + sl * P9_SLD + lane * 16;
    LAS int* EL = (LAS int*)(F.lds + RING_OFF + F.wave * P9_WLDS); LAS float* HL = (LAS float*)(EL + 1024); LAS int* DS = EL + 2048;
#define P9B_SETUP(TB) do { _Pragma("unroll") for (int tk = 0; tk < P9_TPS; ++tk) { const size_t t = (size_t)((TB) + tk); \
            EL[tk * 128 + lane] = ES[t * NSEL + lane]; EL[tk * 128 + 64 + lane] = ES[t * NSEL + 64 + lane]; \
            float a0 = 0.f, a1 = 0.f; \
            _Pragma("unroll") for (int s = 0; s < P9_NSL; ++s) { a0 += PART[((size_t)s * T_ + t) * NSEL + lane]; a1 += PART[((size_t)s * T_ + t) * NSEL + 64 + lane]; } \
            if (DEFER_FFN_NORM) { const float rs_ = ((const float*)(F.ws + WS_RS))[t]; a0 *= rs_; a1 *= rs_; } \
            HL[tk * 128 + lane] = 0.5f * a0 * (1.0f + erff(a0 * 0.70710678118654752f)) * GS[t * NSEL + lane]; HL[tk * 128 + 64 + lane] = 0.5f * a1 * (1.0f + erff(a1 * 0.70710678118654752f)) * GS[t * NSEL + 64 + lane]; } \
        NBP = p9_build_desc<P9_TPS>(BST, (TB), lane, DS); } while (0)
    const int tb0 = rk * TPR + F.wave * P9_TPS, tbe = (rk + 1) * TPR; int NBP = 0;
    f32x2 acc[P9_TPS][8];
    v4u wA[8], wB[8], wC[8];
    if (tb0 < tbe) { P9B_SETUP(tb0); P9_ISSUE(0, wA); P9_ISSUE(1, wB); }
    for (int tb = tb0; tb < tbe; tb += NWAVES * P9_TPS) {
#pragma unroll
        for (int tk = 0; tk < P9_TPS; ++tk)
#pragma unroll
            for (int k = 0; k < 8; ++k) acc[tk][k] = (f32x2){0.f, 0.f};
        for (int i = 0; i < NBP; i += 3) { P9_ISSUE(i + 2, wC); P9_CONSUME(i, wA, P9_CONS_V_TK); P9_ISSUE(i + 3, wA); P9_CONSUME(i + 1, wB, P9_CONS_V_TK); P9_ISSUE(i + 4, wB); P9_CONSUME(i + 2, wC, P9_CONS_V_TK); }
        float ssl[P9_TPS];
        v4u hva[P9_TPS], hvb[P9_TPS];
#pragma unroll
        for (int tk = 0; tk < P9_TPS; ++tk) { const bf16* hrow = (const bf16*)(F.ws + WS_HB) + (size_t)(tb + tk) * DM + sl * P9_SLD + lane * 16; hva[tk] = *(const GAS v4u*)hrow; hvb[tk] = *(const GAS v4u*)(hrow + 8); }
        asm volatile("" ::: "memory");
#pragma unroll
        for (int tk = 0; tk < P9_TPS; ++tk) { const size_t t = (size_t)(tb + tk); float ss = 0.f;
            const v4u hv0 = hva[tk], hv1 = hvb[tk];
#pragma unroll
            for (int c = 0; c < 4; ++c) { const unsigned ha = c == 0 ? hv0.x : c == 1 ? hv0.z : c == 2 ? hv1.x : hv1.z, hb2 = c == 0 ? hv0.y : c == 1 ? hv0.w : c == 2 ? hv1.y : hv1.w; const f32x4 x0 = {bflo(ha), bfhi(ha), bflo(hb2), bfhi(hb2)};
                acc[tk][2 * c].x = x0.x + acc[tk][2 * c].x * (1.0f / PEER_VSCALE); acc[tk][2 * c].y = x0.y + acc[tk][2 * c].y * (1.0f / PEER_VSCALE);
                acc[tk][2 * c + 1].x = x0.z + acc[tk][2 * c + 1].x * (1.0f / PEER_VSCALE); acc[tk][2 * c + 1].y = x0.w + acc[tk][2 * c + 1].y * (1.0f / PEER_VSCALE);
                ss += (acc[tk][2 * c].x * acc[tk][2 * c].x + acc[tk][2 * c].y * acc[tk][2 * c].y) + (acc[tk][2 * c + 1].x * acc[tk][2 * c + 1].x + acc[tk][2 * c + 1].y * acc[tk][2 * c + 1].y); }
            ss = fmaxf(wave_sum(ss), 1e-30f); ssl[tk] = ss;
            if (lane == 0) __hip_atomic_store(ssqx + t * P9_NSL + sl, __float_as_uint(ss), __ATOMIC_RELAXED, __HIP_MEMORY_SCOPE_AGENT); }
        LDS_WAIT();
        if (tb + NWAVES * P9_TPS < tbe) P9B_SETUP(tb + NWAVES * P9_TPS);
        unsigned wv = 1u;
        for (unsigned spin = 0; spin < (1u << 22); ++spin) {
            if (lane < P9_TPS * P9_NSL) wv = __hip_atomic_load(ssqx + (size_t)tb * P9_NSL + lane, __ATOMIC_RELAXED, __HIP_MEMORY_SCOPE_AGENT);
            if (__all(wv != 0u)) break;
            __builtin_amdgcn_s_sleep(2);
        }
        const float wf = (lane < P9_TPS * P9_NSL) ? __uint_as_float(wv) : 0.f;
        if (tb + NWAVES * P9_TPS < tbe) { P9_ISSUE(0, wA); P9_ISSUE(1, wB); }
        f32x4 gq[4];
#pragma unroll
        for (int c = 0; c < 4; ++c) gq[c] = *(const GAS f32x4*)(nf + 4 * c);
        asm volatile("" ::: "memory");
#pragma unroll
        for (int tk = 0; tk < P9_TPS; ++tk) { const size_t t = (size_t)(tb + tk); float* orow = yout + t * DM + sl * P9_SLD + lane * 16;
            float tot = 0.f;
#pragma unroll
            for (int s2 = 0; s2 < P9_NSL; ++s2) tot += (s2 == sl) ? ssl[tk] : __builtin_bit_cast(float, __builtin_amdgcn_readlane(__builtin_bit_cast(int, wf), tk * P9_NSL + s2));
            const float rs = 1.0f / sqrtf(tot * (1.0f / DM) + EPS);
#pragma unroll
            for (int c = 0; c < 4; ++c) { const f32x4 g = gq[c]; f32x4 y;
                y.x = acc[tk][2 * c].x * rs * g.x; y.y = acc[tk][2 * c].y * rs * g.y; y.z = acc[tk][2 * c + 1].x * rs * g.z; y.w = acc[tk][2 * c + 1].y * rs * g.w;
                *(GAS f32x4*)(orow + 4 * c) = y; } }
    }
#undef P9B_SETUP
}

struct Args { const float* in[N_IN]; float* out; unsigned char* ws; int ph_lo, ph_hi; };
static_assert(sizeof(Args) == N_IN * 8 + 8 + 8 + 8, "Args has no padding");
constexpr int N_PHASES = 11;
#ifndef MK_PER_PHASE
#define MK_PER_PHASE 0
#endif
__global__ void __launch_bounds__(NWAVES * 64, 2) fwd(Args args) {
    extern __shared__ __attribute__((aligned(16))) unsigned char lds[];
    Frame F;
    F.lds = (LAS unsigned char*)lds;
    F.MISC = (volatile LAS unsigned*)(F.lds + MISC_OFF);
    F.tid = threadIdx.x; F.lane = F.tid & 63; F.wave = __builtin_amdgcn_readfirstlane(F.tid >> 6);
    F.G = gridDim.x; { const int bx = blockIdx.x; F.vcu = (F.G % 8 == 0) ? (bx % 8) * (F.G / 8) + bx / 8 : bx; }
    F.ws = args.ws; F.out = args.out; F.ctl = (gu32*)(args.ws + WS_CTL);
#pragma unroll
    for (int i = 0; i < N_IN; ++i) F.in[i] = args.in[i];
    for (int u = F.tid; u < (LDS_BYTES - LDSCTL_OFF) / 4; u += NWAVES * 64) ((LAS unsigned*)(F.lds + LDSCTL_OFF))[u] = 0u;
    __syncthreads();
    XcdBarrier bar; bar.bar = (unsigned*)(F.ctl + CW_BAR); bar.x = 0; bar.st = nullptr;
    if (!MK_PER_PHASE) bar = xcd_barrier_post((unsigned*)(F.ctl + CW_BAR), F.MISC + 8);
    const int lo = args.ph_lo, hi = args.ph_hi;
#define IN(k) (lo <= (k) && (k) < hi)
#define SEAM(k) do { if (IN(k) && IN((k) + 1)) xcd_barrier(bar); } while (0)
    bf16* const HN = (bf16*)(F.ws + WS_HN); bf16* const Z = (bf16*)(F.ws + WS_Z); bf16* const BZ = (bf16*)(F.ws + WS_BZ); bf16* const ATT = (bf16*)(F.ws + WS_ATT);
    bf16* const MRG = (bf16*)(F.ws + WS_MRG); bf16* const XN = (bf16*)(F.ws + WS_XN); float* const ST = (float*)(F.ws + WS_ST);

#ifndef REPEAT_PHASE
#define REPEAT_PHASE -1
#endif
#define RUN(k, BODY) do { if (IN(k)) { BODY; if (REPEAT_PHASE == (k)) { xcd_barrier(bar); BODY; } } } while (0)
#define PH_GEMM1 { if (Z8_COL0 > 0) { pg8::Gemm g{HN, (const bf16*)(F.ws + WS_WINT), T_, Z8_COL0, DM, LDP}; pg8::StaticOrder S; S.init(T_, Z8_COL0, F.G, (int)blockIdx.x); pg8::EpiZ E{Z, F.in[I_BGATE], 0, 1.0f}; \
          pg8::gemm_phase<pg8::EpiZ, pg8::StaticOrder, true, true, false>(F.lds + RING_OFF, g, S, E); \
        __syncthreads(); } \
        { pg8::Gemm g{(const bf16*)(F.ws + WS_HN8), (const bf16*)(F.ws + WS_WIN8), T_, INC - Z8_COL0, DM / 2, LDP8}; pg8::StaticOrder S; S.init(T_, INC - Z8_COL0, F.G, (int)blockIdx.x); \
          pg8::EpiZ E{Z, F.in[I_BGATE], Z8_COL0, 1.0f / (HN8_SCALE * WIN8_SCALE)}; \
          pg8::TblHook hk{F.in[I_UEMB], F.in[I_VEMB], (unsigned char*)(F.ws + WS_UB), (unsigned char*)(F.ws + WS_KMEAN), F.vcu * NWAVES + F.wave, F.G * NWAVES}; \
          pg8::gemm_phase<pg8::EpiZ, pg8::StaticOrder, true, true, LOWP, UV_IN_GEMM1>(F.lds + RING_OFF, g, S, E, hk); } }
#define PH_GEMM2_FUSED { pg8::Gemm g{(const bf16*)(F.ws + WS_AC), (const bf16*)(F.ws + WS_WC), T_, DM, DM / 2, LDP8}; pg8::StaticOrder S; S.init(T_, DM, F.G, (int)blockIdx.x); \
        pg8::EpiMerge E{Z + ZC_GC, (unsigned char*)(F.ws + WS_MRG8)}; static_assert(CONVOUT_FP8 && GEMM3_FP8 && PROJ_INT8 && BZ8_SCALE * WCO8_SCALE * 4.f == ATT8_SCALE * WAO8_SCALE && ATT8_SCALE * WAO8_SCALE == 32768.f && MRG8_SCALE == 32.f && ZC_GA - ZC_GC == 4096, "EpiMerge constants"); \
        pg8::gemm_phase<pg8::EpiMerge, pg8::StaticOrder, true, true, 1>(F.lds + RING_OFF, g, S, E); }
#define PH_GEMM2_SPLIT { { pg8::Gemm g{BZ, (const bf16*)(F.ws + WS_WCOT), T_, DM, (CONVOUT_INT8 || CONVOUT_FP8) ? CD / 2 : CD, (CONVOUT_INT8 || CONVOUT_FP8) ? LDH8 : LDH}; pg8::StaticOrder S; S.init(T_, DM, F.G, (int)blockIdx.x); \
          typedef pg8::EpiGate<0, LDP, 2 * LDP8, (CONVOUT_INT8 || CONVOUT_FP8) ? 13 : 0, 0> EG0; EG0 E{MRG, Z + ZC_GC, nullptr}; static_assert(BZ8_SCALE * WCO8_SCALE == 8192.f, "EpiGate shift"); \
          pg8::gemm_phase<EG0, pg8::StaticOrder, true, true, CONVOUT_FP8 ? 1 : (CONVOUT_INT8 ? 2 : 0)>(F.lds + RING_OFF, g, S, E); } \
        __syncthreads(); \
        { pg8::Gemm g{ATT, (const bf16*)(F.ws + WS_WAO8), T_, DM, AD / 2, LDH8}; pg8::StaticOrder S; S.init(T_, DM, F.G, (int)blockIdx.x); typedef pg8::EpiGate<GEMM3_FP8 ? (PROJ_INT8 ? 3 : 2) : 1, LDP, 2 * LDP8, 15, 5> EG1; EG1 E{MRG, Z + ZC_GA, (unsigned char*)(F.ws + WS_MRG8)}; static_assert(ATT8_SCALE * WAO8_SCALE == 32768.f && MRG8_SCALE == 32.f, "EpiGate shifts"); \
          pg8::gemm_phase<EG1, pg8::StaticOrder, true, true, true>(F.lds + RING_OFF, g, S, E); } }
#define PH_GEMM3 { pg8::Gemm g{GEMM3_FP8 ? (const bf16*)(F.ws + WS_MRG8) : MRG, (const bf16*)(F.ws + WS_WOT), T_, DM, GEMM3_FP8 ? DM / 2 : DM, GEMM3_FP8 ? LDP8 : LDP}; pg8::StaticOrder S; S.init(T_, DM, F.G, (int)blockIdx.x); \
        if constexpr (DEFER_FFN_NORM) { typedef pg8::EpiHQ<HQ_SCALE, 2 * LDP8, WS_XN, WS_SSQP> EHQ; EHQ E{(bf16*)(F.ws + WS_HB), F.in[I_X], F.in[I_NFFN], F.ws, GEMM3_FP8 ? 1.0f / (MRG8_SCALE * WO8_SCALE) : 1.0f}; \
            pg8::gemm_phase<EHQ, pg8::StaticOrder, true, true, GEMM3_FP8 ? LOWP : 0>(F.lds + RING_OFF, g, S, E); } \
        else { pg8::EpiHB E{(bf16*)(F.ws + WS_HB), F.in[I_X], GEMM3_FP8 ? 1.0f / (MRG8_SCALE * WO8_SCALE) : 1.0f}; \
        pg8::gemm_phase<pg8::EpiHB, pg8::StaticOrder, true, true, GEMM3_FP8 ? LOWP : 0>(F.lds + RING_OFF, g, S, E); } }
#define PH_GEMM4 { pg8::Gemm g{(const bf16*)(F.ws + WS_WPQF), XN, 2048, T_, SCORES_INT8 ? DM / 2 : DM, SCORES_INT8 ? LDP8 : LDP}; pg8::StaticOrder S; S.init(2048, T_, F.G, (int)blockIdx.x); \
        pg8::EpiF32R E{ST, T_, nullptr, SCORES_INT8 ? 1.0f / (XN8_SCALE * WPQ8_SCALE) : 1.0f}; \
        pg8::gemm_phase<pg8::EpiF32R, pg8::StaticOrder, true, true, SCORES_INT8 ? 2 : 0>(F.lds + RING_OFF, g, S, E); }
    RUN(0, p0_prologue(F)); SEAM(0);
    RUN(1, PH_GEMM1); SEAM(1);
    RUN(2, p2_conv_kmean(F)); SEAM(2);
    RUN(3, p3_attention(F, (char*)lds + RING_OFF)); SEAM(3);
#if GEMM2_FUSED
    RUN(4, PH_GEMM2_FUSED); SEAM(4);
#else
    RUN(4, PH_GEMM2_SPLIT); SEAM(4);
#endif
    RUN(5, PH_GEMM3); SEAM(5);
#if !DEFER_FFN_NORM
    RUN(6, p6_rms(F)); SEAM(6);
#endif
    RUN(7, PH_GEMM4); SEAM(7);
    RUN(8, p8_topk(F)); SEAM(8);
    RUN(9, p9a_peer_u(F)); SEAM(9);
    if (IN(10)) {
        if (REPEAT_PHASE == 10) { p9b_peer_v(F, (float*)(F.ws + WS_WINT), (unsigned*)(F.ctl + CW_SSQX)); xcd_barrier(bar); }
        p9b_peer_v(F, F.out, (unsigned*)(F.ctl + CW_SSQX));
    }
#undef IN
#undef SEAM
}

extern "C" void kernel_launch(void* const* d_in, const int* in_sizes, int n_in, void* d_out, int out_size, void* d_ws, size_t ws_size, hipStream_t stream) {
    static int grid = 0;
    if (grid == 0) {
        if (n_in != N_IN || in_sizes[0] != T_ * DM || out_size != T_ * DM || ws_size < WS_END) { fprintf(stderr, "kernel_launch: shape mismatch (n_in %d in0 %d out %d ws %zu)\n", n_in, n_in > 0 ? in_sizes[0] : -1, out_size, ws_size); grid = -1; return; }
        int dev = 0, cus = 0, per_cu = 0;
        if (hipGetDevice(&dev) != hipSuccess || hipDeviceGetAttribute(&cus, hipDeviceAttributeMultiprocessorCount, dev) != hipSuccess) { grid = -1; return; }
        if (hipFuncSetAttribute((const void*)fwd, hipFuncAttributeMaxDynamicSharedMemorySize, LDS_BYTES) != hipSuccess) { fprintf(stderr, "kernel_launch: hipFuncSetAttribute failed\n"); grid = -1; return; }
        if (hipOccupancyMaxActiveBlocksPerMultiprocessor(&per_cu, (const void*)fwd, NWAVES * 64, LDS_BYTES) != hipSuccess || per_cu < 1)
            fprintf(stderr, "kernel_launch: note: occupancy query reports %d workgroups per CU\n", per_cu);
        (void)hipGetLastError();
        grid = cus;
    }
    if (grid < 0) return;
    if (hipMemsetAsync((char*)d_ws + WS_CTL, 0, CTL_ZERO_BYTES, stream) != hipSuccess) return;
    Args a{};
    for (int i = 0; i < N_IN; ++i) a.in[i] = (const float*)d_in[i];
    a.out = (float*)d_out; a.ws = (unsigned char*)d_ws;
#if MK_PER_PHASE
    for (int p = 0; p < N_PHASES; ++p) { a.ph_lo = p; a.ph_hi = p + 1; hipLaunchKernelGGL(fwd, dim3(grid), dim3(NWAVES * 64), LDS_BYTES, stream, a); }
#else
    a.ph_lo = 0; a.ph_hi = N_PHASES;
    hipLaunchKernelGGL(fwd, dim3(grid), dim3(NWAVES * 64), LDS_BYTES, stream, a);
#endif
    const hipError_t le = hipPeekAtLastError();
    if (le != hipSuccess) fprintf(stderr, "kernel_launch: launch failed: %s\n", hipGetErrorName(le));
}
```

```cpp
#include <hip/hip_runtime.h>
#include <cstdio>
#include <cstdint>
#ifndef RELAX_EPI
#define RELAX_EPI 0
#endif
namespace pg8 {
#define PG8_LAS __attribute__((address_space(3)))
typedef unsigned short bf16_t;
typedef short bf16x8 __attribute__((ext_vector_type(8)));
typedef float f32x4 __attribute__((ext_vector_type(4)));
typedef unsigned u32x4 __attribute__((ext_vector_type(4)));
constexpr int BM = 256, BK = 64, HALF = 128, HTB = HALF * BK * 2  , STAGE_BYTES = 8 * HTB, NXCD = 8, WGM = 8;

__host__ __device__ __forceinline__ int lds_byte(int r, int c) { const int st = (r >> 4) * 2 + (c >> 5), rr = r & 15, cc = c & 31, ob = rr * 64 + cc * 2; return st * 1024 + (ob ^ (((ob >> 9) & 1) << 5)); }
__host__ __device__ __forceinline__ void stage_rc(int b, int& R, int& C) { const int st = b / 1024, sb = b % 1024, swz = sb ^ (((sb >> 9) & 1) << 5); R = (st >> 1) * 16 + swz / 64; C = (st & 1) * 32 + (swz % 64) / 2; }
__host__ __device__ __forceinline__ int perm32(int rho) { const int n = rho >> 4, i = rho & 15; return 8 * (i >> 2) + 4 * n + (i & 3); }

struct Unit { int pm, pn; };
struct Gemm { const bf16_t* A; const bf16_t* Bt; int M, N, K, ld; };

struct StaticOrder {
    int nM, nN, nwg, G, c;
    __host__ __device__ void init(int M, int N, int G_, int c_) { nM = M / BM; nN = N / BM; nwg = nM * nN; G = G_; c = c_; }
    __host__ __device__ bool next(int i, Unit& u) const {
        const long L = (long)i * G + c; if (L >= nwg) return false;
        int wgid = (int)L; { const int q = nwg / NXCD, r = nwg % NXCD, xcd = wgid % NXCD, off = wgid / NXCD; wgid = (xcd < r ? xcd * (q + 1) : r * (q + 1) + (xcd - r) * q) + off; }
        const int nig = WGM * nN, gid = wgid / nig, fm = gid * WGM, gsz = (nM - fm) < WGM ? (nM - fm) : WGM;
        u.pm = fm + ((wgid % nig) % gsz); u.pn = (wgid % nig) / gsz; return true;
    }
    __device__ __forceinline__ void a_ready(const Unit&) const {}
    __device__ __forceinline__ void done(const Unit&) const {}
};

constexpr int HK_NCHUNK = 262144, HK_HALF = 131072; constexpr float HK_USCALE = 1024.0f, HK_VSCALE = 16.0f;
struct TblHook { const float* u; const float* v; unsigned char* ub; unsigned char* dummy; int gwave, ngw; };
constexpr int HK_LDS_OFF = 131584;
__device__ __forceinline__ void hook_issue(const TblHook& h, int it, int lane, PG8_LAS unsigned char* slot) {
    const int q = __builtin_amdgcn_readfirstlane(it * h.ngw + h.gwave); const int qq = q < HK_NCHUNK ? q : 0; const bool isu = qq < HK_HALF; const int j = isu ? qq : qq - HK_HALF;
    const __amdgpu_buffer_rsrc_t r = __builtin_amdgcn_make_buffer_rsrc((void*)(isu ? h.u : h.v), (short)0, 0x7fffffff, 0x00020000);
    const unsigned so = (unsigned)j * 2048u, l16 = (unsigned)lane * 16u;
    __builtin_amdgcn_raw_ptr_buffer_load_lds(r, (PG8_LAS void*)slot, 16, l16, so, 0, 0);
    __builtin_amdgcn_raw_ptr_buffer_load_lds(r, (PG8_LAS void*)(slot + 1024), 16, l16, so + 1024u, 0, 0);
}
__device__ __forceinline__ unsigned hook_u8(const f32x4 a) {
    const float lim = 127.0f / HK_USCALE; unsigned y[4];
#pragma unroll
    for (int i = 0; i < 4; ++i) y[i] = __float_as_uint(__builtin_fmaf(__builtin_amdgcn_fmed3f(a[i], -lim, lim), HK_USCALE, 12582912.0f));
    const unsigned lo = __builtin_amdgcn_perm(y[1], y[0], 0x0c0c0400u), hi = __builtin_amdgcn_perm(y[3], y[2], 0x04000c0cu);
    return lo | hi;
}
__device__ __forceinline__ unsigned hook_f8(const f32x4 a) { int w = __builtin_amdgcn_cvt_pk_fp8_f32(a[0] * HK_VSCALE, a[1] * HK_VSCALE, 0, false); return (unsigned)__builtin_amdgcn_cvt_pk_fp8_f32(a[2] * HK_VSCALE, a[3] * HK_VSCALE, w, true); }
__device__ __forceinline__ void hook_store(const TblHook& h, int it, int lane, const f32x4 a, const f32x4 b) {
    const int q = __builtin_amdgcn_readfirstlane(it * h.ngw + h.gwave); const bool act = q < HK_NCHUNK; const int qq = act ? q : 0;
    const bool isu = qq < HK_HALF; const int j = isu ? qq : qq - HK_HALF; const int e = j >> 3, c512 = j & 7, sl = c512 >> 1, c0 = (c512 & 1) * 512;
    unsigned char* dt = h.ub + (isu ? (size_t)0 : ((size_t)64 << 20)) + ((size_t)sl * 16384 + e) * 1024 + c0;
    unsigned char* d = act ? dt : h.dummy + (size_t)h.gwave * 512;
    const unsigned l4 = (unsigned)lane * 4u; unsigned w0, w1;
    if (isu) { w0 = hook_u8(a); w1 = hook_u8(b); } else { w0 = hook_f8(a); w1 = hook_f8(b); }
    *(unsigned*)(d + l4) = w0; *(unsigned*)(d + 256 + l4) = w1;
}
__device__ __forceinline__ unsigned cvt_pk_bf16(float lo, float hi) { unsigned r; asm volatile("v_cvt_pk_bf16_f32 %0, %1, %2" : "=v"(r) : "v"(lo), "v"(hi)); return r; }
typedef float f32x2 __attribute__((ext_vector_type(2)));
__device__ __forceinline__ float bf_lo(unsigned w) { return __uint_as_float(w << 16); }
__device__ __forceinline__ float bf_hi(unsigned w) { return __uint_as_float(w & 0xffff0000u); }
__device__ __forceinline__ float sigm(float x) { return __builtin_amdgcn_rcpf(1.0f + __builtin_amdgcn_exp2f(-1.4426950408889634f * x)); }
typedef int v8i32 __attribute__((ext_vector_type(8))); typedef int v4i32 __attribute__((ext_vector_type(4)));
__device__ __forceinline__ v8i32 cat8(bf16x8 a, bf16x8 b) { const v4i32 x = __builtin_bit_cast(v4i32, a), y = __builtin_bit_cast(v4i32, b); return (v8i32){x[0], x[1], x[2], x[3], y[0], y[1], y[2], y[3]}; }
constexpr int ZLD = 20480;
constexpr int ZGATE0 = 12288;
struct EpiZ {
    static constexpr bool PERM = true, AFTER_DRAIN = false, HAS_MID = false; static constexpr int NSTORE = 16;
    bf16_t* Z; const float* bgate; int col_off; float scale;
    __device__ __forceinline__ void operator()(const f32x4 (&acc)[2][2][4][2], const Unit& u, int wr, int wc, int fr, int fq) const {
        const int row0 = u.pm * BM + wr * 64 + fr, col0 = col_off + u.pn * BM + wc * 32 + 8 * fq;
        const bool gate = (col_off + u.pn * BM) >= ZGATE0;
        f32x4 bv[2][2];
#pragma unroll
        for (int bj = 0; bj < 2; ++bj)
#pragma unroll
            for (int n = 0; n < 2; ++n) bv[bj][n] = gate ? *(const f32x4*)(bgate + (col0 - ZGATE0) + bj * HALF + 4 * n) : (f32x4){0.f, 0.f, 0.f, 0.f};
#pragma unroll
        for (int ai = 0; ai < 2; ++ai)
#pragma unroll
            for (int m = 0; m < 4; ++m) { bf16_t* rowp = Z + (size_t)(row0 + ai * HALF + m * 16) * ZLD + col0;
#pragma unroll
                for (int bj = 0; bj < 2; ++bj) { f32x4 v0 = acc[ai][bj][m][0] * scale + bv[bj][0], v1 = acc[ai][bj][m][1] * scale + bv[bj][1];
                    if (gate) {
#pragma unroll
                        for (int j = 0; j < 4; ++j) { v0[j] = sigm(v0[j]); v1[j] = sigm(v1[j]); } }
                    u32x4 w; w.x = cvt_pk_bf16(v0[0], v0[1]); w.y = cvt_pk_bf16(v0[2], v0[3]); w.z = cvt_pk_bf16(v1[0], v1[1]); w.w = cvt_pk_bf16(v1[2], v1[3]);
                    *(u32x4*)(rowp + bj * HALF) = w; } }
    }
};
template <int MODE, int ldo, int ldo8, int ACC_SHIFT, int OUT_SHIFT> struct EpiGate {
    static constexpr bool PERM = true, AFTER_DRAIN = false, HAS_MID = false; static constexpr int NSTORE = 16;
    static constexpr float scale = 1.0f / (float)(1 << ACC_SHIFT), oscale = (float)(1 << OUT_SHIFT);
    bf16_t* O; const bf16_t* Zg; unsigned char* O8;
    __device__ __forceinline__ void operator()(const f32x4 (&acc)[2][2][4][2], const Unit& u, int wr, int wc, int fr, int fq) const {
        const int row0 = u.pm * BM + wr * 64 + fr, col0 = u.pn * BM + wc * 32 + 8 * fq;
#pragma unroll
        for (int ai = 0; ai < 2; ++ai)
#pragma unroll
            for (int m = 0; m < 4; ++m) { const size_t r = (size_t)(row0 + ai * HALF + m * 16); bf16_t* rowp = O + r * ldo + col0; const bf16_t* gp = Zg + r * ZLD + col0;
#pragma unroll
                for (int bj = 0; bj < 2; ++bj) { const u32x4 g = *(const u32x4*)(gp + bj * HALF); const f32x4 v0 = acc[ai][bj][m][0] * scale, v1 = acc[ai][bj][m][1] * scale;
                    float o0 = v0[0] * bf_lo(g.x), o1 = v0[1] * bf_hi(g.x), o2 = v0[2] * bf_lo(g.y), o3 = v0[3] * bf_hi(g.y);
                    float o4 = v1[0] * bf_lo(g.z), o5 = v1[1] * bf_hi(g.z), o6 = v1[2] * bf_lo(g.w), o7 = v1[3] * bf_hi(g.w);
                    if (MODE >= 1) { const u32x4 p = *(const u32x4*)(rowp + bj * HALF);
                        o0 += bf_lo(p.x); o1 += bf_hi(p.x); o2 += bf_lo(p.y); o3 += bf_hi(p.y); o4 += bf_lo(p.z); o5 += bf_hi(p.z); o6 += bf_lo(p.w); o7 += bf_hi(p.w); }
                    if (MODE == 3) {
                        int q_[8]; const float ov_[8] = {o0, o1, o2, o3, o4, o5, o6, o7};
#pragma unroll
                        for (int j = 0; j < 8; ++j) { int q = __float2int_rn(ov_[j] * oscale); q_[j] = (q < -127 ? -127 : (q > 127 ? 127 : q)) & 0xff; }
                        typedef unsigned u32x2e __attribute__((ext_vector_type(2))); u32x2e w8; w8.x = (unsigned)(q_[0] | (q_[1] << 8) | (q_[2] << 16) | (q_[3] << 24)); w8.y = (unsigned)(q_[4] | (q_[5] << 8) | (q_[6] << 16) | (q_[7] << 24));
                        *(u32x2e*)(O8 + r * ldo8 + col0 + bj * HALF) = w8; }
                    if (MODE == 2) {
                        int w0 = __builtin_amdgcn_cvt_pk_fp8_f32(o0 * oscale, o1 * oscale, 0, false); w0 = __builtin_amdgcn_cvt_pk_fp8_f32(o2 * oscale, o3 * oscale, w0, true);
                        int w1 = __builtin_amdgcn_cvt_pk_fp8_f32(o4 * oscale, o5 * oscale, 0, false); w1 = __builtin_amdgcn_cvt_pk_fp8_f32(o6 * oscale, o7 * oscale, w1, true);
                        typedef unsigned u32x2e __attribute__((ext_vector_type(2))); u32x2e w8; w8.x = (unsigned)w0; w8.y = (unsigned)w1;
                        *(u32x2e*)(O8 + r * ldo8 + col0 + bj * HALF) = w8; }
                    if (MODE < 2) { u32x4 w; w.x = cvt_pk_bf16(o0, o1); w.y = cvt_pk_bf16(o2, o3); w.z = cvt_pk_bf16(o4, o5); w.w = cvt_pk_bf16(o6, o7);
                        *(u32x4*)(rowp + bj * HALF) = w; } } }
    }
};
struct EpiF32R {
    static constexpr bool PERM = false, AFTER_DRAIN = false, HAS_MID = false; static constexpr int NSTORE = 32;
    float* C; int ldc; const float* R; float scale;
    __device__ __forceinline__ void operator()(const f32x4 (&acc)[2][2][4][2], const Unit& u, int wr, int wc, int fr, int fq) const {
        const int row0 = u.pm * BM + wr * 64 + fr, col0 = u.pn * BM + wc * 32 + 4 * fq;
#pragma unroll
        for (int ai = 0; ai < 2; ++ai)
#pragma unroll
            for (int m = 0; m < 4; ++m) { const size_t off = (size_t)(row0 + ai * HALF + m * 16) * ldc + col0;
#pragma unroll
                for (int bj = 0; bj < 2; ++bj)
#pragma unroll
                    for (int n = 0; n < 2; ++n) { f32x4 v = acc[ai][bj][m][n] * scale; if (R) v += *(const f32x4*)(R + off + bj * HALF + n * 16); *(f32x4*)(C + off + bj * HALF + n * 16) = v; } }
    }
};

struct EpiHB {
    static constexpr bool PERM = false, AFTER_DRAIN = false, HAS_MID = false; static constexpr int NSTORE = 32;
    bf16_t* HB; const float* R; float scale;
    __device__ __forceinline__ void operator()(const f32x4 (&acc)[2][2][4][2], const Unit& u, int wr, int wc, int fr, int fq) const {
        const int row0 = u.pm * BM + wr * 64 + fr, col0 = u.pn * BM + wc * 32 + 4 * fq;
        typedef unsigned u32x2e __attribute__((ext_vector_type(2)));
#pragma unroll
        for (int ai = 0; ai < 2; ++ai)
#pragma unroll
            for (int m = 0; m < 4; ++m) { const size_t off = (size_t)(row0 + ai * HALF + m * 16) * 4096 + col0;
#pragma unroll
                for (int bj = 0; bj < 2; ++bj)
#pragma unroll
                    for (int n = 0; n < 2; ++n) { const f32x4 v = acc[ai][bj][m][n] * scale + *(const f32x4*)(R + off + bj * HALF + n * 16);
                        u32x2e w; w.x = cvt_pk_bf16(v[0], v[1]); w.y = cvt_pk_bf16(v[2], v[3]); *(u32x2e*)(HB + off + bj * HALF + n * 16) = w; } }
    }
};

__device__ __forceinline__ unsigned q8x4(const f32x4 a, const f32x4 g, float s) {
    unsigned y[4];
#pragma unroll
    for (int i = 0; i < 4; ++i) y[i] = __float_as_uint(__builtin_fmaf(__builtin_amdgcn_fmed3f(a[i] * g[i] * s, -127.0f, 127.0f), 1.0f, 12582912.0f));
    return __builtin_amdgcn_perm(y[1], y[0], 0x0c0c0400u) | __builtin_amdgcn_perm(y[3], y[2], 0x04000c0cu);
}
template <int HQS, int LDQ8  , size_t OFF_Q8, size_t OFF_SSQP> struct EpiHQ {
    static constexpr bool PERM = true, AFTER_DRAIN = false, HAS_MID = false; static constexpr int NSTORE = 32;
    bf16_t* HB; const float* R; const float* gain; unsigned char* ws; float scale;
    __device__ __forceinline__ void operator()(const f32x4 (&acc)[2][2][4][2], const Unit& u, int wr, int wc, int fr, int fq) const {
        const int row0 = u.pm * BM + wr * 64 + fr, col0 = u.pn * BM + wc * 32 + 8 * fq;
        typedef unsigned u32x2e __attribute__((ext_vector_type(2)));
        f32x4 gv[2][2];
#pragma unroll
        for (int bj = 0; bj < 2; ++bj)
#pragma unroll
            for (int n = 0; n < 2; ++n) gv[bj][n] = *(const f32x4*)(gain + col0 + bj * HALF + 4 * n);
        float* SSQP = (float*)(ws + OFF_SSQP); unsigned char* Q8 = ws + OFF_Q8;
#pragma unroll
        for (int ai = 0; ai < 2; ++ai)
#pragma unroll
            for (int m = 0; m < 4; ++m) { const size_t r = (size_t)(row0 + ai * HALF + m * 16); float ss = 0.f;
#pragma unroll
                for (int bj = 0; bj < 2; ++bj) { const size_t off = r * 4096 + col0 + bj * HALF;
                    const f32x4 v0 = acc[ai][bj][m][0] * scale + *(const f32x4*)(R + off), v1 = acc[ai][bj][m][1] * scale + *(const f32x4*)(R + off + 4);
                    ss += (v0[0] * v0[0] + v0[1] * v0[1]) + (v0[2] * v0[2] + v0[3] * v0[3]) + (v1[0] * v1[0] + v1[1] * v1[1]) + (v1[2] * v1[2] + v1[3] * v1[3]);
                    u32x4 w; w.x = cvt_pk_bf16(v0[0], v0[1]); w.y = cvt_pk_bf16(v0[2], v0[3]); w.z = cvt_pk_bf16(v1[0], v1[1]); w.w = cvt_pk_bf16(v1[2], v1[3]);
                    *(u32x4*)(HB + off) = w;
                    u32x2e q; q.x = q8x4(v0, gv[bj][0], (float)HQS); q.y = q8x4(v1, gv[bj][1], (float)HQS);
                    *(u32x2e*)(Q8 + r * LDQ8 + col0 + bj * HALF) = q; }
                ss += __shfl_xor(ss, 16); ss += __shfl_xor(ss, 32);
                if (fq == 0) SSQP[r * 64 + u.pn * 4 + wc] = ss; }
    }
};

struct EpiMerge {
    static constexpr bool PERM = true, AFTER_DRAIN = false, HAS_MID = true; static constexpr int NSTORE = 16;
    const bf16_t* Zgc; unsigned char* O8;
    static constexpr int ldo8 = 4224;
    __device__ __forceinline__ void mid(f32x4 (&acc)[2][2][4][2], const Unit& u, int wr, int wc, int fr, int fq) const {
        asm volatile("" : "+v"(fr), "+v"(fq));
        const int row0 = u.pm * BM + wr * 64 + fr, col0 = u.pn * BM + wc * 32 + 8 * fq;
#pragma unroll
        for (int ai = 0; ai < 2; ++ai)
#pragma unroll
            for (int m = 0; m < 4; ++m) { const bf16_t* gp = Zgc + (size_t)(row0 + ai * HALF + m * 16) * ZLD + col0;
#pragma unroll
                for (int bj = 0; bj < 2; ++bj) { const u32x4 c = *(const u32x4*)(gp + bj * HALF), a = *(const u32x4*)(gp + 4096 + bj * HALF);
                    f32x4 r0, r1;
                    r0[0] = 4.0f * bf_lo(c.x) * __builtin_amdgcn_rcpf(bf_lo(a.x)); r0[1] = 4.0f * bf_hi(c.x) * __builtin_amdgcn_rcpf(bf_hi(a.x)); r0[2] = 4.0f * bf_lo(c.y) * __builtin_amdgcn_rcpf(bf_lo(a.y)); r0[3] = 4.0f * bf_hi(c.y) * __builtin_amdgcn_rcpf(bf_hi(a.y));
                    r1[0] = 4.0f * bf_lo(c.z) * __builtin_amdgcn_rcpf(bf_lo(a.z)); r1[1] = 4.0f * bf_hi(c.z) * __builtin_amdgcn_rcpf(bf_hi(a.z)); r1[2] = 4.0f * bf_lo(c.w) * __builtin_amdgcn_rcpf(bf_lo(a.w)); r1[3] = 4.0f * bf_hi(c.w) * __builtin_amdgcn_rcpf(bf_hi(a.w));
                    acc[ai][bj][m][0] *= r0; acc[ai][bj][m][1] *= r1; }
                if (m == 3) __builtin_amdgcn_sched_barrier(0); }
    }
    __device__ __forceinline__ void operator()(const f32x4 (&acc)[2][2][4][2], const Unit& u, int wr, int wc, int fr, int fq) const {
        const int row0 = u.pm * BM + wr * 64 + fr, col0 = u.pn * BM + wc * 32 + 8 * fq;
        typedef unsigned u32x2e __attribute__((ext_vector_type(2)));
#pragma unroll
        for (int ai = 0; ai < 2; ++ai)
#pragma unroll
            for (int m = 0; m < 4; ++m) { const size_t r = (size_t)(row0 + ai * HALF + m * 16); const bf16_t* gp = Zgc + r * ZLD + col0 + 4096;
                u32x4 ab[2];
#pragma unroll
                for (int bj = 0; bj < 2; ++bj) ab[bj] = *(const u32x4*)(gp + bj * HALF);
#pragma unroll
                for (int bj = 0; bj < 2; ++bj) { const u32x4 a = ab[bj];
                    const f32x4 g0 = {bf_lo(a.x), bf_hi(a.x), bf_lo(a.y), bf_hi(a.y)}, g1 = {bf_lo(a.z), bf_hi(a.z), bf_lo(a.w), bf_hi(a.w)};
                    u32x2e q; q.x = q8x4(acc[ai][bj][m][0], g0, 32.0f / 32768.0f); q.y = q8x4(acc[ai][bj][m][1], g1, 32.0f / 32768.0f);
                    *(u32x2e*)(O8 + r * ldo8 + col0 + bj * HALF) = q; } }
    }
};
template <class Epi, class Sched, bool ALIGN_EPI = false, bool SP2 = false, int FP8 = 0  , int HOOK = 0  >
__device__ __forceinline__ void gemm_phase(PG8_LAS unsigned char* lds, const Gemm g, const Sched& S, const Epi& E, const TblHook hk = TblHook{}) {
    const int tid = threadIdx.x, wid = __builtin_amdgcn_readfirstlane(tid >> 6), lane = tid & 63, wr = wid >> 2, wc = wid & 3, fr = lane & 15, fq = lane >> 4;
    const int K = g.K, nt = K / BK, LD = g.ld;
    unsigned voffA[2], voffB[2];
#pragma unroll
    for (int i = 0; i < 2; ++i) { int R, C; stage_rc(tid * 16 + i * 8192, R, C); const int Rb = Epi::PERM ? ((R & ~31) + perm32(R & 31)) : R;
        voffA[i] = (unsigned)(R * LD + C) * 2u; voffB[i] = (unsigned)(Rb * LD + C) * 2u; }
    const unsigned kstep = (unsigned)(BK * 2);
    const unsigned hstep = (unsigned)HALF * LD * 2;
    const unsigned tstep = 2 * hstep;
    const __amdgpu_buffer_rsrc_t rA = __builtin_amdgcn_make_buffer_rsrc((void*)g.A, (short)0, 0x7fffffff, 0x00020000), rB = __builtin_amdgcn_make_buffer_rsrc((void*)g.Bt, (short)0, 0x7fffffff, 0x00020000);
    const unsigned ldsw = (unsigned)wid * 1024u;
    const int aoff = lds_byte(wr * 64 + fr, fq * 8), boff = lds_byte(wc * 32 + fr, fq * 8);
#define PG8_SA(b, h) (((b) * 2 + (h)) * HTB)
#define PG8_SB(b, h) ((4 + (b) * 2 + (h)) * HTB)
#define PG8_STAGE(bufoff, rsrc, soff, voff) do { _Pragma("unroll") for (int _i = 0; _i < 2; ++_i) \
        __builtin_amdgcn_raw_ptr_buffer_load_lds(rsrc, (PG8_LAS void*)(lds + (bufoff) + ldsw + _i * 8192), 16, (voff)[_i], (soff), 0, 0); } while (0)
#define PG8_LDA(dst, b, h) do { _Pragma("unroll") for (int m = 0; m < 4; ++m) _Pragma("unroll") for (int k = 0; k < 2; ++k) dst[m][k] = *(const PG8_LAS bf16x8*)(lds + PG8_SA(b, h) + aoff + m * 2048 + k * 1024); } while (0)
#define PG8_LDB(dst, b, h) do { _Pragma("unroll") for (int n = 0; n < 2; ++n) _Pragma("unroll") for (int k = 0; k < 2; ++k) dst[n][k] = *(const PG8_LAS bf16x8*)(lds + PG8_SB(b, h) + boff + n * 2048 + k * 1024); } while (0)
#define PG8_MMA(ai, bj, At, Bt) do { __builtin_amdgcn_s_setprio(1); _Pragma("unroll") for (int m = 0; m < 4; ++m) _Pragma("unroll") for (int n = 0; n < 2; ++n) { \
        if constexpr (FP8 == 2) { _Pragma("unroll") for (int k = 0; k < 2; ++k) asm volatile("v_mfma_i32_16x16x64_i8 %0, %1, %2, %0" : "+v"(acc[ai][bj][m][n]) : "v"(Bt[n][k]), "v"(At[m][k]));   } \
        else if constexpr (FP8 == 1) { const v8i32 b8_ = cat8(Bt[n][0], Bt[n][1]), a8_ = cat8(At[m][0], At[m][1]);   \
            asm volatile("v_mfma_scale_f32_16x16x128_f8f6f4 %0, %1, %2, %0, %3, %3 op_sel_hi:[0,0,0]" : "+v"(acc[ai][bj][m][n]) : "v"(b8_), "v"(a8_), "v"(one_scale)); } \
        else { _Pragma("unroll") for (int k = 0; k < 2; ++k) asm volatile("v_mfma_f32_16x16x32_bf16 %0, %1, %2, %0" : "+v"(acc[ai][bj][m][n]) : "v"(Bt[n][k]), "v"(At[m][k])); } } __builtin_amdgcn_s_setprio(0); } while (0)
#define PG8_WAIT_V(n) asm volatile("s_waitcnt vmcnt(" #n ")" ::: "memory")
#define PG8_WAIT_VI(n) asm volatile("s_waitcnt vmcnt(%0)" :: "n"(n) : "memory")
#define PG8_WAIT_L(n) asm volatile("s_waitcnt lgkmcnt(" #n ")" ::: "memory")
#define PG8_BAR __builtin_amdgcn_s_barrier()
#define PG8_SCHED __builtin_amdgcn_sched_barrier(0)
    Unit cur, nxt; int ui = 0; int hit = 0;
#define PG8_HOOK_REST do { if constexpr (HOOK) { for (; hit * hk.ngw + hk.gwave < HK_NCHUNK; ++hit) { const int q_ = hit * hk.ngw + hk.gwave; const float* hp_ = (q_ < HK_HALF ? hk.u + (size_t)q_ * 512 : hk.v + (size_t)(q_ - HK_HALF) * 512) + lane * 4; \
        const f32x4 a_ = *(const f32x4*)hp_, b_ = *(const f32x4*)(hp_ + 256); hook_store(hk, hit, lane, a_, b_); } } } while (0)
    if (!S.next(0, cur)) { PG8_HOOK_REST; return; }
    const int one_scale = 0x7f7f7f7f;
    f32x4 acc[2][2][4][2];
#pragma unroll
    for (int a = 0; a < 2; ++a)
#pragma unroll
        for (int b = 0; b < 2; ++b)
#pragma unroll
            for (int m = 0; m < 4; ++m)
#pragma unroll
                for (int n = 0; n < 2; ++n) acc[a][b][m][n] = (f32x4){0.f, 0.f, 0.f, 0.f};
    bf16x8 At[4][2], B0[2][2], B1[2][2];
    unsigned cA = (unsigned)cur.pm * tstep, cB = (unsigned)cur.pn * tstep;
    S.a_ready(cur);
    if constexpr (SP2) {
        PG8_STAGE(PG8_SB(0, 0), rB, cB, voffB); PG8_STAGE(PG8_SB(0, 1), rB, cB + hstep, voffB); PG8_STAGE(PG8_SA(0, 0), rA, cA, voffA); PG8_STAGE(PG8_SA(0, 1), rA, cA + hstep, voffA);
        if (wr == 1) PG8_BAR;
        PG8_WAIT_V(2); PG8_BAR;
        PG8_STAGE(PG8_SB(1, 0), rB, cB + kstep, voffB); PG8_STAGE(PG8_SA(1, 0), rA, cA + kstep, voffA); PG8_STAGE(PG8_SB(1, 1), rB, cB + hstep + kstep, voffB);
        PG8_WAIT_V(6); PG8_BAR;
    } else {
        PG8_STAGE(PG8_SB(0, 0), rB, cB, voffB); PG8_STAGE(PG8_SA(0, 0), rA, cA, voffA); PG8_STAGE(PG8_SB(0, 1), rB, cB + hstep, voffB); PG8_STAGE(PG8_SA(0, 1), rA, cA + hstep, voffA);
        if (wr == 1) PG8_BAR;
        PG8_WAIT_V(4); PG8_BAR;
        PG8_STAGE(PG8_SB(1, 0), rB, cB + kstep, voffB); PG8_STAGE(PG8_SA(1, 0), rA, cA + kstep, voffA); PG8_STAGE(PG8_SB(1, 1), rB, cB + hstep + kstep, voffB);
        PG8_WAIT_V(6); PG8_BAR;
    }
    for (;;) {
        const bool has_next = S.next(ui + 1, nxt);
        const unsigned nA = has_next ? (unsigned)nxt.pm * tstep : cA, nB = has_next ? (unsigned)nxt.pn * tstep : cB;
        const bool hon = HOOK && ((hit + nt / 2 - 1) * hk.ngw + hk.gwave < HK_NCHUNK);
        for (int t = 0; t < nt; t += 2) {
            if constexpr (Epi::HAS_MID) { if (t == nt / 2) { asm volatile("s_nop 7\n\ts_nop 7\n\ts_nop 7" ::: "memory"); E.mid(acc, cur, wr, wc, fr, fq); } }
            const bool last = (t == nt - 2);
            const unsigned a1 = cA + (unsigned)(t + 1) * kstep;
            const unsigned a2 = last ? nA : cA + (unsigned)(t + 2) * kstep, b2 = last ? nB : cB + (unsigned)(t + 2) * kstep;
            const unsigned a3 = a2 + kstep, b3 = b2 + kstep;
            if (last && has_next) S.a_ready(nxt);
            constexpr int EPI_NS = Epi::NSTORE; const bool relax = RELAX_EPI && (t == 0) && (ui > 0);
            if constexpr (SP2) {
            PG8_LDB(B0, 0, 0); PG8_LDB(B1, 0, 1); PG8_SCHED; PG8_LDA(At, 0, 0); PG8_STAGE(PG8_SA(1, 1), rA, a1 + hstep, voffA);
            if constexpr (HOOK) { if (hon) hook_issue(hk, hit, lane, lds + HK_LDS_OFF + wid * 2048); }
            if (relax) PG8_WAIT_VI(8 + EPI_NS); else if (hon) PG8_WAIT_V(10); else PG8_WAIT_V(8);
            PG8_WAIT_L(0); PG8_BAR; PG8_MMA(0, 0, At, B0); PG8_MMA(0, 1, At, B1); PG8_BAR; PG8_SCHED;
            PG8_LDA(At, 0, 1); PG8_STAGE(PG8_SB(0, 0), rB, b2, voffB); PG8_STAGE(PG8_SB(0, 1), rB, b2 + hstep, voffB); PG8_STAGE(PG8_SA(0, 0), rA, a2, voffA);
            if (relax) PG8_WAIT_VI(8 + EPI_NS); else if (hon) PG8_WAIT_V(10); else PG8_WAIT_V(8);
            PG8_WAIT_L(0); PG8_BAR; PG8_MMA(1, 0, At, B0); PG8_MMA(1, 1, At, B1); PG8_BAR; PG8_SCHED;
            PG8_LDB(B0, 1, 0); PG8_LDB(B1, 1, 1); PG8_SCHED; PG8_LDA(At, 1, 0); PG8_STAGE(PG8_SA(0, 1), rA, a2 + hstep, voffA);
            if (hon) PG8_WAIT_V(10); else PG8_WAIT_V(8);
            PG8_WAIT_L(0); PG8_BAR; PG8_MMA(0, 0, At, B0); PG8_MMA(0, 1, At, B1); PG8_BAR; PG8_SCHED;
            PG8_LDA(At, 1, 1); PG8_STAGE(PG8_SB(1, 0), rB, b3, voffB); PG8_STAGE(PG8_SB(1, 1), rB, b3 + hstep, voffB); PG8_STAGE(PG8_SA(1, 0), rA, a3, voffA);
            PG8_WAIT_V(8); if constexpr (HOOK) { if (hon) { const PG8_LAS unsigned char* sl_ = lds + HK_LDS_OFF + wid * 2048; const f32x4 ha_ = *(const PG8_LAS f32x4*)(sl_ + lane * 16), hb_ = *(const PG8_LAS f32x4*)(sl_ + 1024 + lane * 16); hook_store(hk, hit, lane, ha_, hb_); ++hit; } }
            PG8_WAIT_L(0); PG8_BAR; PG8_MMA(1, 0, At, B0); PG8_MMA(1, 1, At, B1); PG8_BAR; PG8_SCHED;
            } else {
            PG8_LDB(B0, 0, 0); PG8_SCHED; PG8_LDA(At, 0, 0); PG8_STAGE(PG8_SA(1, 1), rA, a1 + hstep, voffA);
            PG8_WAIT_L(8); PG8_BAR; PG8_WAIT_L(0); PG8_MMA(0, 0, At, B0); PG8_BAR; PG8_SCHED;
            PG8_LDB(B1, 0, 1); PG8_STAGE(PG8_SB(0, 0), rB, b2, voffB);
            PG8_BAR; PG8_WAIT_L(0); PG8_MMA(0, 1, At, B1); PG8_BAR;
            PG8_LDA(At, 0, 1); PG8_STAGE(PG8_SA(0, 0), rA, a2, voffA);
            PG8_BAR; PG8_WAIT_L(0); PG8_MMA(1, 0, At, B0); PG8_BAR; PG8_SCHED;
            PG8_STAGE(PG8_SB(0, 1), rB, b2 + hstep, voffB);
            PG8_WAIT_V(6); PG8_BAR; PG8_MMA(1, 1, At, B1); PG8_BAR;
            PG8_LDB(B0, 1, 0); PG8_SCHED; PG8_LDA(At, 1, 0); PG8_STAGE(PG8_SA(0, 1), rA, a2 + hstep, voffA);
            PG8_WAIT_L(8); PG8_BAR; PG8_WAIT_L(0); PG8_MMA(0, 0, At, B0); PG8_BAR; PG8_SCHED;
            PG8_LDB(B1, 1, 1); PG8_STAGE(PG8_SB(1, 0), rB, b3, voffB);
            PG8_BAR; PG8_WAIT_L(0); PG8_MMA(0, 1, At, B1); PG8_BAR;
            PG8_LDA(At, 1, 1); PG8_STAGE(PG8_SA(1, 0), rA, a3, voffA);
            PG8_BAR; PG8_WAIT_L(0); PG8_MMA(1, 0, At, B0); PG8_BAR; PG8_SCHED;
            PG8_STAGE(PG8_SB(1, 1), rB, b3 + hstep, voffB);
            PG8_WAIT_V(6); PG8_BAR; PG8_MMA(1, 1, At, B1); PG8_BAR;
            }
        }
        asm volatile("s_nop 7\n\ts_nop 7\n\ts_nop 7" ::: "memory");
        if constexpr (FP8 == 2) {
#pragma unroll
            for (int a = 0; a < 2; ++a)
#pragma unroll
                for (int b = 0; b < 2; ++b)
#pragma unroll
                    for (int m = 0; m < 4; ++m)
#pragma unroll
                        for (int n = 0; n < 2; ++n) { const v4i32 q_ = __builtin_bit_cast(v4i32, acc[a][b][m][n]); acc[a][b][m][n] = (f32x4){(float)q_[0], (float)q_[1], (float)q_[2], (float)q_[3]}; } }
        if constexpr (ALIGN_EPI) { if (wr == 0) PG8_BAR; }
        if constexpr (!Epi::AFTER_DRAIN) { E(acc, cur, wr, wc, fr, fq); S.done(cur); }
        if (!has_next) break;
#pragma unroll
        for (int a = 0; a < 2; ++a)
#pragma unroll
            for (int b = 0; b < 2; ++b)
#pragma unroll
                for (int m = 0; m < 4; ++m)
#pragma unroll
                    for (int n = 0; n < 2; ++n) acc[a][b][m][n] = (f32x4){0.f, 0.f, 0.f, 0.f};
        cur = nxt; cA = nA; cB = nB; ++ui;
        if constexpr (ALIGN_EPI) { if (wr == 1) PG8_BAR; }
    }
    PG8_WAIT_V(0);
    if constexpr (!ALIGN_EPI) { if (wr == 0) PG8_BAR; }
    PG8_BAR;
    if constexpr (Epi::AFTER_DRAIN) { E.fused(acc, cur, wr, wc, fr, fq, lds, wid, lane); S.done(cur); }
    PG8_HOOK_REST;
#undef PG8_HOOK_REST
#undef PG8_SA
#undef PG8_SB
#undef PG8_STAGE
#undef PG8_LDA
#undef PG8_LDB
#undef PG8_MMA
#undef PG8_WAIT_V
#undef PG8_WAIT_L
#undef PG8_BAR
#undef PG8_SCHED
}
}
namespace moba {
typedef unsigned short bf16;
constexpr int   D = 128, NW = 8, QBLK = 32, KVBLK = 64;
constexpr float SCALE = 0.088388347648318440f;
constexpr float THR = 8.f;
constexpr int SDEPTH = 1;
#ifndef GEMM2_FUSED
#define GEMM2_FUSED 1
#endif
constexpr int LDQ = 20480, LDK = 20480, LDO = GEMM2_FUSED ? 4096 + 128 : 2048 + 128;
constexpr size_t SHM_V = KVBLK * D * 2, SHM_K = KVBLK * D * 2, SHM_ATTN = 2 * SHM_V + 2 * SHM_K + NW * 64 * 4;
constexpr float NEG = -1e30f;
constexpr float OSCALE = 64.0f;
using bf16x8 = __attribute__((ext_vector_type(8))) short;
using s16x4  = __attribute__((ext_vector_type(4))) short;
using f32x16 = __attribute__((ext_vector_type(16))) float;
using f32x8  = __attribute__((ext_vector_type(8))) float;
using u32x4  = __attribute__((ext_vector_type(4))) unsigned;
#define KSWZ(row, colB) ((row) * 256 + ((colB) ^ (((row) & 7) << 4)))
#define SBAR() __builtin_amdgcn_sched_barrier(0)
__device__ __forceinline__ int crow(int r, int hi) { return (r & 3) + 8 * (r >> 2) + 4 * hi; }
__device__ __forceinline__ unsigned cvtpk(float lo, float hi) {
  unsigned r; asm volatile("v_cvt_pk_bf16_f32 %0, %1, %2" : "=v"(r) : "v"(lo), "v"(hi)); return r;
}
template <typename TIn> struct Stage;
template <> struct Stage<bf16>  { using T = bf16x8;
  __device__ static __forceinline__ T ld8(const bf16* p) { return *reinterpret_cast<const bf16x8*>(p); }
  __device__ static __forceinline__ bf16x8 tobf(T x) { return x; } };

__device__ __forceinline__ void partialSM(f32x16& p0, f32x16& p1, float& m_reg, float& mn, float& alpha) {
  constexpr float C = SCALE * 1.4426950408889634f;
  float pmax = p0[0]; for (int r = 1; r < 16; ++r) pmax = fmaxf(pmax, p0[r]); for (int r = 0; r < 16; ++r) pmax = fmaxf(pmax, p1[r]);
  { auto rr = __builtin_amdgcn_permlane32_swap(__float_as_uint(pmax), __float_as_uint(pmax), false, false);
    pmax = fmaxf(__uint_as_float(rr[0]), __uint_as_float(rr[1])); }
  if (__builtin_expect(__all(pmax - m_reg <= THR / SCALE), 1)) { mn = m_reg; alpha = 1.f; }
  else { mn = fmaxf(m_reg, pmax); alpha = __builtin_amdgcn_exp2f((m_reg - mn) * C); m_reg = mn; }
  float mnC = -mn * C;
  for (int r = 0; r < 16; ++r) p0[r] = fmaf(p0[r], C, mnC); for (int r = 0; r < 16; ++r) p1[r] = fmaf(p1[r], C, mnC);
  for (int r = 0; r < 16; ++r) p0[r] = __builtin_amdgcn_exp2f(p0[r]);
}
__device__ __forceinline__ void finishSM(f32x16& p0, f32x16& p1, float alpha, float& l_reg, bf16x8& pa0, bf16x8& pa1, bf16x8& pa2, bf16x8& pa3) {
  for (int r = 0; r < 16; ++r) p1[r] = __builtin_amdgcn_exp2f(p1[r]);
  float ps = 0; for (int r = 0; r < 16; ++r) ps += p0[r]; for (int r = 0; r < 16; ++r) ps += p1[r];
  { auto rr = __builtin_amdgcn_permlane32_swap(__float_as_uint(ps), __float_as_uint(ps), false, false);
    ps = __uint_as_float(rr[0]) + __uint_as_float(rr[1]); }
  l_reg = l_reg * alpha + ps;
#define PK4(P, BASE, OUT) do { unsigned a0 = cvtpk(P[BASE + 0], P[BASE + 1]), a1 = cvtpk(P[BASE + 2], P[BASE + 3]);   \
    unsigned b0 = cvtpk(P[BASE + 4], P[BASE + 5]), b1 = cvtpk(P[BASE + 6], P[BASE + 7]);                              \
    auto r0 = __builtin_amdgcn_permlane32_swap(a0, b0, false, false); auto r1 = __builtin_amdgcn_permlane32_swap(a1, b1, false, false); \
    u32x4 w = {r0[0], r1[0], r0[1], r1[1]}; OUT = *reinterpret_cast<bf16x8*>(&w); } while (0)
  PK4(p0, 0, pa0); PK4(p0, 8, pa1); PK4(p1, 0, pa2); PK4(p1, 8, pa3);
#undef PK4
}
__device__ __forceinline__ void qkt(f32x16& p0, f32x16& p1, const bf16* Ks, const bf16x8* qr, int r32, int hi) {
  p0 = f32x16{}; p1 = f32x16{};
  for (int d0 = 0; d0 < 8; ++d0) { int cb = (d0 * 16 + hi * 8) * 2;
    bf16x8 b0 = *reinterpret_cast<const bf16x8*>((const char*)Ks + KSWZ(r32, cb));
    bf16x8 b1 = *reinterpret_cast<const bf16x8*>((const char*)Ks + KSWZ(32 + r32, cb));
    p0 = __builtin_amdgcn_mfma_f32_32x32x16_bf16(b0, qr[d0], p0, 0, 0, 0);
    p1 = __builtin_amdgcn_mfma_f32_32x32x16_bf16(b1, qr[d0], p1, 0, 0, 0); }
}
__device__ __forceinline__ int v_st(int k, int c) { const int kk = (k & ~0xC) | ((k & 4) << 1) | ((k & 8) >> 1); return ((kk >> 3) * 4 + (c >> 5)) * 512 + ((kk & 7) * 32 + (c & 31)) * 2; }
__device__ __forceinline__ int v_rd_base(int lane) { return ((lane & 3) << 3) | (((lane >> 2) & 3) << 6) | (((lane >> 4) & 1) << 5) | (((lane >> 5) & 1) << 8); }
constexpr int v_rd_off(int d0, int ks, int half) { return d0 * 512 + ks * 4096 + half * 2048; }
template <int OFF> __device__ __forceinline__ s16x4 tr_read(int vb) {
  s16x4 r; asm volatile("ds_read_b64_tr_b16 %0, %1 offset:%2" : "=&v"(r) : "v"(vb), "i"(OFF) : "memory"); return r;
}
template <int D0> __device__ __forceinline__ void pv_one(f32x16& od, int vb, bf16x8 pa0, bf16x8 pa1, bf16x8 pa2, bf16x8 pa3) {
  const s16x4 l0 = tr_read<v_rd_off(D0, 0, 0)>(vb), h0 = tr_read<v_rd_off(D0, 0, 1)>(vb), l1 = tr_read<v_rd_off(D0, 1, 0)>(vb), h1 = tr_read<v_rd_off(D0, 1, 1)>(vb);
  const s16x4 l2 = tr_read<v_rd_off(D0, 2, 0)>(vb), h2 = tr_read<v_rd_off(D0, 2, 1)>(vb), l3 = tr_read<v_rd_off(D0, 3, 0)>(vb), h3 = tr_read<v_rd_off(D0, 3, 1)>(vb);
  asm volatile("s_waitcnt lgkmcnt(0)" ::: "memory"); SBAR();
#define PK(L, H) (bf16x8){L[0], L[1], L[2], L[3], H[0], H[1], H[2], H[3]}
  od = __builtin_amdgcn_mfma_f32_32x32x16_bf16(pa0, PK(l0, h0), od, 0, 0, 0);
  od = __builtin_amdgcn_mfma_f32_32x32x16_bf16(pa1, PK(l1, h1), od, 0, 0, 0);
  od = __builtin_amdgcn_mfma_f32_32x32x16_bf16(pa2, PK(l2, h2), od, 0, 0, 0);
  od = __builtin_amdgcn_mfma_f32_32x32x16_bf16(pa3, PK(l3, h3), od, 0, 0, 0);
#undef PK
}
__device__ __forceinline__ void pv_d0(f32x16* o, int vb, bf16x8 pa0, bf16x8 pa1, bf16x8 pa2, bf16x8 pa3) {
  pv_one<0>(o[0], vb, pa0, pa1, pa2, pa3); pv_one<1>(o[1], vb, pa0, pa1, pa2, pa3); pv_one<2>(o[2], vb, pa0, pa1, pa2, pa3); pv_one<3>(o[3], vb, pa0, pa1, pa2, pa3);
}


__device__ __forceinline__ float bf2f(short s) { return __uint_as_float(((unsigned)(unsigned short)s) << 16); }
__device__ __forceinline__ int koff(int j, int qb) { return (j < 4) ? qb * 256 + j * 64 : (j - 4) * 64; }
__device__ __forceinline__ void init_tile(f32x16& p0, f32x16& p1, int j, unsigned selmask, int rowi, int wid, int hi) {
  if (j < 4) {
    if (64 * j + 63 <= wid * 32) {
#pragma unroll
      for (int r = 0; r < 16; ++r) { p0[r] = 0.f; p1[r] = 0.f; }
    } else if (64 * j > wid * 32 + 31) {
#pragma unroll
      for (int r = 0; r < 16; ++r) { p0[r] = NEG; p1[r] = NEG; }
    } else {
      int tz = threadIdx.x; asm volatile("" : "+v"(tz));
      const int limh = (tz >> 6) * 32 + (tz & 31) - 4 * ((tz >> 5) & 1) - 64 * j; const float neg = NEG;
#define MOBA_MSK(P, R, CONST) asm volatile("v_cmp_gt_i32 vcc, %2, %1\n\tv_cndmask_b32 %0, 0, %3, vcc" : "=v"(P[R]) : "v"(limh), "n"(CONST), "v"(neg) : "vcc")
#define MOBA_MSK2(R) MOBA_MSK(p0, R, ((R) & 3) + 8 * ((R) >> 2)); MOBA_MSK(p1, R, 32 + ((R) & 3) + 8 * ((R) >> 2))
      MOBA_MSK2(0); MOBA_MSK2(1); MOBA_MSK2(2); MOBA_MSK2(3); MOBA_MSK2(4); MOBA_MSK2(5); MOBA_MSK2(6); MOBA_MSK2(7);
      MOBA_MSK2(8); MOBA_MSK2(9); MOBA_MSK2(10); MOBA_MSK2(11); MOBA_MSK2(12); MOBA_MSK2(13); MOBA_MSK2(14); MOBA_MSK2(15);
#undef MOBA_MSK2
#undef MOBA_MSK
    }
  } else {
    const float iv = ((selmask >> ((j - 4) >> 2)) & 1u) ? 0.f : NEG;
#pragma unroll
    for (int r = 0; r < 16; ++r) { p0[r] = iv; p1[r] = iv; }
  }
}
__device__ __forceinline__ void qktm(f32x16& p0, f32x16& p1, const bf16* Ks, const bf16x8* qr, int r32, int hi, int j, unsigned selmask, int rowi, int wid) {
  init_tile(p0, p1, j, selmask, rowi, wid, hi);
  for (int d0 = 0; d0 < 8; ++d0) { int cb = (d0 * 16 + hi * 8) * 2;
    bf16x8 b0 = *reinterpret_cast<const bf16x8*>((const char*)Ks + KSWZ(r32, cb));
    bf16x8 b1 = *reinterpret_cast<const bf16x8*>((const char*)Ks + KSWZ(32 + r32, cb));
    p0 = __builtin_amdgcn_mfma_f32_32x32x16_bf16(b0, qr[d0], p0, 0, 0, 0);
    p1 = __builtin_amdgcn_mfma_f32_32x32x16_bf16(b1, qr[d0], p1, 0, 0, 0); }
}

__device__ __forceinline__ void moba_body(const bf16* __restrict__ Qb, const bf16* __restrict__ Kh, const bf16* __restrict__ Vh, const float* __restrict__ km,
                                          unsigned char* __restrict__ Ob, int qb, char* lds) {
  using St = Stage<bf16>;
  int tid = threadIdx.x; asm volatile("" : "+v"(tid));
  const int wid = tid >> 6, lane = tid & 63, r32 = lane & 31, hi = lane >> 5;
  bf16* V_lds = (bf16*)lds; bf16* K_lds = (bf16*)(lds + 2 * SHM_V);
  float* ws = (float*)(lds + 2 * SHM_V + 2 * SHM_K) + wid * 64; float* li_l = ws; float* al_l = ws + 32;
  float m_reg = -1e30f, l_reg = 0; f32x16 o[4] = {}; bf16x8 qr[8];
  __syncthreads();
  float* kml = (float*)(lds + SHM_ATTN);
  if (tid < 224) *reinterpret_cast<float4*>(kml + tid * 4) = *reinterpret_cast<const float4*>(km + tid * 4);
  const bf16* Qw = Qb + (long)(wid * QBLK + r32) * LDQ + hi * 8;
#pragma unroll
  for (int d0 = 0; d0 < 8; ++d0) qr[d0] = St::ld8(Qw + d0 * 16);
  {
    const int sr0 = tid >> 4, sc0 = (tid & 15) * 8, k00 = koff(0, qb);
    const typename St::T tv0 = St::ld8(&Vh[(long)(k00 + sr0) * LDK + sc0]), tv1 = St::ld8(&Vh[(long)(k00 + 32 + sr0) * LDK + sc0]);
    const typename St::T tk0 = St::ld8(&Kh[(long)(k00 + sr0) * LDK + sc0]), tk1 = St::ld8(&Kh[(long)(k00 + 32 + sr0) * LDK + sc0]);
    asm volatile("s_waitcnt vmcnt(0)" ::: "memory");
    *(bf16x8*)((char*)V_lds + v_st(sr0, sc0)) = St::tobf(tv0); *(bf16x8*)((char*)V_lds + v_st(32 + sr0, sc0)) = St::tobf(tv1);
    *(bf16x8*)((char*)K_lds + KSWZ(sr0, sc0 * 2)) = St::tobf(tk0); *(bf16x8*)((char*)K_lds + KSWZ(32 + sr0, sc0 * 2)) = St::tobf(tk1); }
  __syncthreads();
  asm volatile("" : "+v"(tid));
  unsigned selmask = 0u;
  {
    float g[7];
#pragma unroll
    for (int n = 0; n < 7; ++n) {
      float s = 0.f;
      if (n < qb) {
        const float* kp = kml + n * 128 + hi * 8;
#pragma unroll
        for (int d0 = 0; d0 < 8; ++d0) {
          const float4 k0 = *reinterpret_cast<const float4*>(kp + d0 * 16), k1 = *reinterpret_cast<const float4*>(kp + d0 * 16 + 4);
          s += bf2f(qr[d0][0]) * k0.x + bf2f(qr[d0][1]) * k0.y + bf2f(qr[d0][2]) * k0.z + bf2f(qr[d0][3]) * k0.w
             + bf2f(qr[d0][4]) * k1.x + bf2f(qr[d0][5]) * k1.y + bf2f(qr[d0][6]) * k1.z + bf2f(qr[d0][7]) * k1.w;
        }
        s += __shfl_xor(s, 32);
      }
      g[n] = (n < qb) ? s : -INFINITY;
    }
#pragma unroll
    for (int n = 0; n < 7; ++n) {
      int rank = 0;
#pragma unroll
      for (int m = 0; m < 7; ++m) if (m != n) rank += (g[m] > g[n] || (g[m] == g[n] && m < n)) ? 1 : 0;
      if (n < qb && rank < 3) selmask |= (1u << n);
    }
  }
  const int rowi = wid * QBLK + r32;
  const int sr = tid >> 4, sc = (tid & 15) * 8, vst0 = v_st(sr, sc), vst1 = v_st(32 + sr, sc);
  const int vb0 = (int)(uintptr_t)V_lds + v_rd_base(lane);
  struct { typename St::T vs0, vs1, ks0, ks1; } sr_[SDEPTH];
#define SLOAD(i, k0) do { sr_[i].vs0 = St::ld8(&Vh[(long)((k0) + sr) * LDK + sc]); sr_[i].vs1 = St::ld8(&Vh[(long)((k0) + 32 + sr) * LDK + sc]); \
    sr_[i].ks0 = St::ld8(&Kh[(long)((k0) + sr) * LDK + sc]); sr_[i].ks1 = St::ld8(&Kh[(long)((k0) + 32 + sr) * LDK + sc]); } while (0)
#define SWRITE(b, i) do { *(bf16x8*)((char*)V_lds + (b) * SHM_V + vst0) = St::tobf(sr_[i].vs0);          \
    *(bf16x8*)((char*)V_lds + (b) * SHM_V + vst1) = St::tobf(sr_[i].vs1); int kc = sc * 2;               \
    *(bf16x8*)((char*)K_lds + (b) * SHM_K + KSWZ(sr, kc)) = St::tobf(sr_[i].ks0);                       \
    *(bf16x8*)((char*)K_lds + (b) * SHM_K + KSWZ(32 + sr, kc)) = St::tobf(sr_[i].ks1); } while (0)
#define SWAIT() do { if constexpr (SDEPTH == 2) asm volatile("s_waitcnt vmcnt(4)" ::: "memory"); else asm volatile("s_waitcnt vmcnt(0)" ::: "memory"); } while (0)
#define RESC(a) do { if (__any((a) < 1.f)) { if (hi == 0) al_l[r32] = (a); asm volatile("s_waitcnt lgkmcnt(0)" ::: "memory"); \
    for (int d = 0; d < 4; ++d) for (int r = 0; r < 16; ++r) o[d][r] *= al_l[crow(r, hi)]; } } while (0)
  f32x16 pA0, pA1, pB0, pB1; float mnA, mnB, alA, alB; bf16x8 pa0, pa1, pa2, pa3; const int NT = 4 * (qb + 1);
  constexpr int SE = 0, SO = SDEPTH - 1;
  static_assert(SDEPTH == 1, "prologue order"); SLOAD(SO, koff(1, qb));
  qktm(pA0, pA1, K_lds, qr, r32, hi, 0, selmask, rowi, wid); partialSM(pA0, pA1, m_reg, mnA, alA);
  SWAIT(); SWRITE(1, SO); __syncthreads();
  for (int j = 1; j + 1 < NT; j += 2) {
    SBAR(); qktm(pB0, pB1, (bf16*)((char*)K_lds + SHM_K), qr, r32, hi, j, selmask, rowi, wid);
    finishSM(pA0, pA1, alA, l_reg, pa0, pa1, pa2, pa3); SBAR();
    SLOAD(SO, koff(j + SDEPTH, qb)); SBAR();
    pv_d0(o, vb0, pa0, pa1, pa2, pa3); partialSM(pB0, pB1, m_reg, mnB, alB);
    __syncthreads(); SWAIT(); SWRITE(0, SE);
    RESC(alB); __syncthreads();
    SBAR(); qktm(pA0, pA1, K_lds, qr, r32, hi, j + 1, selmask, rowi, wid);
    finishSM(pB0, pB1, alB, l_reg, pa0, pa1, pa2, pa3); SBAR();
    if (SDEPTH == 1 || j + 3 < NT) SLOAD(SE, koff(j + 1 + SDEPTH, qb)); SBAR();
    pv_d0(o, vb0 + (int)SHM_V, pa0, pa1, pa2, pa3); partialSM(pA0, pA1, m_reg, mnA, alA);
    __syncthreads(); SWAIT(); SWRITE(1, SO);
    RESC(alA); __syncthreads();
  }
  SBAR(); qktm(pB0, pB1, (bf16*)((char*)K_lds + SHM_K), qr, r32, hi, NT - 1, selmask, rowi, wid);
  finishSM(pA0, pA1, alA, l_reg, pa0, pa1, pa2, pa3); SBAR();
  pv_d0(o, vb0, pa0, pa1, pa2, pa3); partialSM(pB0, pB1, m_reg, mnB, alB);
  __syncthreads(); RESC(alB);
  finishSM(pB0, pB1, alB, l_reg, pa0, pa1, pa2, pa3); SBAR();
  pv_d0(o, vb0 + (int)SHM_V, pa0, pa1, pa2, pa3);
  if (hi == 0) li_l[r32] = l_reg; asm volatile("s_waitcnt lgkmcnt(0)" ::: "memory");
  float rli[16];
#pragma unroll
  for (int r = 0; r < 16; ++r) rli[r] = __builtin_amdgcn_rcpf(li_l[crow(r, hi)]);
  unsigned char* Ow = Ob + (long)(wid * QBLK) * LDO;
#pragma unroll
  for (int r = 0; r < 16; ++r) { int orow = crow(r, hi);
    for (int d0 = 0; d0 < 4; ++d0) { const float v = o[d0][r] * rli[r] * OSCALE; const int q8 = __builtin_amdgcn_cvt_pk_fp8_f32(v, v, 0, false); Ow[(long)orow * LDO + d0 * 32 + r32] = (unsigned char)(q8 & 0xff); } }
#undef SLOAD
#undef SWRITE
#undef SWAIT
#undef RESC
}
#undef KSWZ
#undef SBAR
}
constexpr int NWAVES = 8;
constexpr int T_ = 8192, DM = 4096, INC = 20480, CD = 2048, AD = 2048, NH = 16, HD = 128, SEQ = 2048, NBATCH = 4, NBLK = 8;
constexpr int PH = 8, NKEYS = 128, NEXP = 16384, PTOPK = 16, NSEL = PH * PTOPK;
constexpr float EPS = 1e-6f;
enum { I_X = 0, I_NMIX, I_WIN, I_BGATE, I_CONVW, I_WCO, I_WAO, I_WO, I_NFFN, I_WPQ, I_SUBK, I_UEMB, I_VEMB, I_NFIN, N_IN };
#ifndef ALL_LOWP_GEMM1
#define ALL_LOWP_GEMM1 1
#endif
constexpr int Z8_COL0 = ALL_LOWP_GEMM1 ? 0 : 6144;
#ifndef PROJ_INT8
#define PROJ_INT8 1
#endif
constexpr float HN8_SCALE = PROJ_INT8 ? 32.0f : 16.0f, WIN8_SCALE = PROJ_INT8 ? 2048.0f : 1024.0f, ATT8_SCALE = 64.0f, WAO8_SCALE = 512.0f, MRG8_SCALE = 32.0f, WO8_SCALE = PROJ_INT8 ? 2048.0f : 1024.0f;
#ifndef SCORES_INT8
#define SCORES_INT8 1
#endif
#ifndef CONVOUT_INT8
#define CONVOUT_INT8 0
#endif
#ifndef CONVOUT_FP8
#define CONVOUT_FP8 1
#endif
#ifndef DEFER_FFN_NORM
#define DEFER_FFN_NORM 1
#endif
constexpr int HQ_SCALE = 24;
constexpr float XN8_SCALE = DEFER_FFN_NORM ? (float)HQ_SCALE : 32.0f, WPQ8_SCALE = 2048.0f, BZ8_SCALE = CONVOUT_FP8 ? 4.0f : 8.0f, WCO8_SCALE = CONVOUT_FP8 ? 2048.0f : 1024.0f;
#ifndef UV_IN_GEMM1
#define UV_IN_GEMM1 1
#endif
constexpr int LOWP = PROJ_INT8 ? 2 : 1;
constexpr int ZC_B = 0, ZC_C = 2048, ZC_U = 4096, ZC_Q = 6144, ZC_K = 8192, ZC_V = 10240, ZC_GC = 12288, ZC_GA = 16384;

constexpr size_t MiB = 1u << 20;
#ifndef GEMM3_FP8
#define GEMM3_FP8 1
#endif
constexpr int LDP = DM + 64;
constexpr int LDP8 = (DM + 128) / 2;
constexpr int LDH = CD + 64;
constexpr int LDH8 = (AD + 128) / 2;
constexpr size_t WS_CTL = 0, CTL_ZERO_BYTES = 1 * MiB;
constexpr size_t WS_KMEAN = 1 * MiB;
constexpr size_t WS_WINT = 2 * MiB;
constexpr size_t WS_WIN8 = (ALL_LOWP_GEMM1 ? 2 : 51) * MiB;
constexpr size_t WS_WIN8_OLD_ = 51 * MiB;
constexpr size_t WS_HN8  = 109 * MiB;
constexpr size_t WS_WAO8 = 142 * MiB;
constexpr size_t WS_WCOT = 151 * MiB;
constexpr size_t WS_WOT  = 168 * MiB;
constexpr size_t WS_WPQF = 201 * MiB;
constexpr size_t WS_HN   = 218 * MiB;
constexpr size_t WS_Z    = 283 * MiB;
constexpr size_t WS_BZ   = 603 * MiB;
constexpr size_t WS_ATT  = 636 * MiB;
constexpr size_t WS_MRG  = 653 * MiB;
constexpr size_t WS_HB   = WS_Z + 64 * MiB;
constexpr size_t WS_MRG8 = WS_HN;
constexpr size_t WS_XN   = 718 * MiB;
constexpr size_t WS_ST   = 783 * MiB;
constexpr size_t WS_EXP  = 847 * MiB;
constexpr size_t WS_GATE = 851 * MiB;
constexpr size_t WS_UB   = 855 * MiB;
constexpr size_t WS_VB   = 919 * MiB;
constexpr size_t WS_END  = 983 * MiB;
constexpr size_t WS_AC = WS_MRG, WS_WC = WS_WCOT;
static_assert((size_t)4096 * LDP8 * 2 <= 17 * MiB && (size_t)8192 * LDP8 * 2 <= 65 * MiB, "fused GEMM2 operands");
constexpr size_t WS_SSQP = WS_ATT, WS_RS = WS_ATT + 2 * MiB;
static_assert((size_t)20480 * LDP8 * 2 <= 107 * MiB && (size_t)6144 * LDP * 2 <= 49 * MiB && (size_t)14336 * LDP8 * 2 <= 58 * MiB && (size_t)8192 * LDP8 * 2 <= 33 * MiB && (size_t)4096 * LDH8 * 2 <= 9 * MiB && (size_t)4096 * LDH * 2 <= 17 * MiB, "ws map 1");
static_assert((size_t)4096 * LDP * 2 <= 33 * MiB && (size_t)2048 * LDP * 2 <= 17 * MiB && (size_t)8192 * LDP * 2 <= 65 * MiB && (size_t)8192 * LDH * 2 <= 33 * MiB && (size_t)8192 * LDH8 * 2 <= 17 * MiB, "ws map 2");
constexpr int CW_TMO = 0, CW_CODE = 1, CW_BAR = 4096;
constexpr int CW_SSQX = 131072;

constexpr int RING_OFF = 0, RING_BYTES = 131072;
constexpr int LDSCTL_OFF = RING_BYTES, MISC_OFF = LDSCTL_OFF + 320;
constexpr int LDS_BYTES = 147968;
static_assert(MISC_OFF + 128 <= pg8::HK_LDS_OFF && pg8::HK_LDS_OFF + 8 * 2048 <= LDS_BYTES && RING_OFF == 0, "LDS map");
static_assert(WS_VB - WS_UB == 64 * MiB, "TblHook: v table 64 MiB behind u");
#define GAS __attribute__((address_space(1)))
#define LAS __attribute__((address_space(3)))
typedef unsigned short bf16;
typedef unsigned v4u __attribute__((ext_vector_type(4)));
typedef float f32x4 __attribute__((ext_vector_type(4)));
typedef short bf16x8 __attribute__((ext_vector_type(8)));
typedef GAS unsigned gu32;
typedef GAS unsigned long long gu64;
#define RLX_AGENT __ATOMIC_RELAXED, __HIP_MEMORY_SCOPE_AGENT
#define LDS_WAIT() asm volatile("s_waitcnt lgkmcnt(0)" ::: "memory")
#define VM_WAIT() asm volatile("s_waitcnt vmcnt(0)" ::: "memory")
__device__ __forceinline__ unsigned long long rt() { return __builtin_amdgcn_s_memrealtime(); }
__device__ __forceinline__ unsigned f2bf(float f) { unsigned u = __builtin_bit_cast(unsigned, f); return (u + 0x7fffu + ((u >> 16) & 1u)) >> 16; }
__device__ __forceinline__ unsigned pk2(float lo, float hi) { return f2bf(lo) | (f2bf(hi) << 16); }
#define XB_TMO      128
#define XB_XCNT(j)  (256  + 64 * (j))
#define XB_XSUB(j)  (1280 + 64 * (j))
#define XB_XGEN(j)  (2304 + 64 * (j))
#define XB_TOP      3328
#define XB_TOPGEN   3392
#define XCD_BAR_WORDS 3456
#define XB_SPIN_CAP (1u << 18)

__device__ __forceinline__ unsigned xb_ld(unsigned* p)              { return __hip_atomic_load(p, __ATOMIC_RELAXED, __HIP_MEMORY_SCOPE_AGENT); }
__device__ __forceinline__ unsigned xb_add(unsigned* p, unsigned v) { return __hip_atomic_fetch_add(p, v, __ATOMIC_RELAXED, __HIP_MEMORY_SCOPE_AGENT); }
__device__ __forceinline__ unsigned xb_xcc_id() { return (unsigned)__builtin_amdgcn_s_getreg((3 << 11) | 20) & 0xFu; }
#define XB_SPIN(cond, bar) do { unsigned _sp = 0; while (cond) { __builtin_amdgcn_s_sleep(1); \
    if ((++_sp & 255u) == 0u) { if (xb_ld(&(bar)[XB_TMO])) break; if (_sp > XB_SPIN_CAP) { atomicAdd(&(bar)[XB_TMO], 1u); break; } } } } while (0)

struct XcdBarrier {
    unsigned* bar; unsigned x;
    volatile LAS unsigned* st;
};

__device__ __forceinline__ XcdBarrier xcd_barrier_post(unsigned* bar, volatile LAS unsigned* st) {
    XcdBarrier b; b.bar = bar; b.x = xb_xcc_id(); b.st = st;
    if (threadIdx.x == 0) (void)xb_add(&bar[XB_XCNT(b.x)], 1u);
    return b;
}
__device__ __forceinline__ void xcd_barrier_complete(unsigned* bar, unsigned x, unsigned& nloc, unsigned& nx) {
    const unsigned G = gridDim.x * gridDim.y * gridDim.z;
    unsigned sum, cnt, mine, sp = 0u;
    for (;;) {
        sum = 0u; cnt = 0u; mine = 0u;
#pragma unroll
        for (unsigned j = 0; j < 16; ++j) { const unsigned c = xb_ld(&bar[XB_XCNT(j)]); sum += c; cnt += (c > 0u) ? 1u : 0u; mine = (j == x) ? c : mine; }
        if (sum == G) break;
        __builtin_amdgcn_s_sleep(1);
        if ((++sp & 255u) == 0u) { if (xb_ld(&bar[XB_TMO])) break; if (sp > XB_SPIN_CAP) { atomicAdd(&bar[XB_TMO], 1u); break; } }
    }
    nloc = mine > 0u ? mine : 1u; nx = cnt > 0u ? cnt : 1u;
}

__device__ __forceinline__ void xcd_barrier(const XcdBarrier& b) {
    asm volatile("s_waitcnt vmcnt(0)" ::: "memory");
    __syncthreads();
    if (threadIdx.x == 0) {
        unsigned* bar = b.bar;
        __builtin_amdgcn_s_waitcnt(0);
        unsigned nloc = b.st[0], nx = b.st[1];
        if (nloc == 0u) { xcd_barrier_complete(bar, b.x, nloc, nx); b.st[0] = nloc; b.st[1] = nx; }
        const unsigned old = xb_add(&bar[XB_XSUB(b.x)], 1u);
        const unsigned gen = old / nloc;
        if (old + 1u == (gen + 1u) * nloc) {
            __builtin_amdgcn_fence(__ATOMIC_RELEASE, "agent");
            asm volatile("s_waitcnt vmcnt(0)" ::: "memory");
            const unsigned og = xb_add(&bar[XB_TOP], 1u);
            const unsigned tg = og / nx;
            if (og + 1u == (tg + 1u) * nx) xb_add(&bar[XB_TOPGEN], 1u);
            else XB_SPIN(xb_ld(&bar[XB_TOPGEN]) == tg, bar);
            __builtin_amdgcn_fence(__ATOMIC_ACQUIRE, "agent");
            xb_add(&bar[XB_XGEN(b.x)], 1u);
            asm volatile("s_waitcnt vmcnt(0)" ::: "memory");
        } else {
            XB_SPIN(xb_ld(&bar[XB_XGEN(b.x)]) == gen, bar);
            __builtin_amdgcn_fence(__ATOMIC_ACQUIRE, "agent");
            asm volatile("s_waitcnt vmcnt(0)" ::: "memory");
        }
    }
    __syncthreads();
}
typedef unsigned u32x2 __attribute__((ext_vector_type(2)));
typedef __bf16 bfx2 __attribute__((ext_vector_type(2)));
typedef float f32x2 __attribute__((ext_vector_type(2)));
constexpr float PEER_USCALE = 1024.0f, PEER_VSCALE = 16.0f, PEER_XSCALE = 16.0f;
__device__ __forceinline__ int q_i8(float v) { const int q = __float2int_rn(v); return q < -127 ? -127 : (q > 127 ? 127 : q); }
__device__ __forceinline__ int pk_i8(float a, float b, float c, float d) { return (int)((unsigned)(q_i8(a) & 0xff) | ((unsigned)(q_i8(b) & 0xff) << 8) | ((unsigned)(q_i8(c) & 0xff) << 16) | ((unsigned)(q_i8(d) & 0xff) << 24)); }
struct Frame {
    LAS unsigned char* lds;
    volatile LAS unsigned* MISC;
    gu32* ctl;
    int tid, lane, wave;
    int vcu, G;
    const float* in[N_IN]; float* out; unsigned char* ws;
};
__device__ __forceinline__ float wave_sum(float v) {
    v += __builtin_bit_cast(float, __builtin_amdgcn_update_dpp(0, __builtin_bit_cast(int, v), 0xB1, 0xf, 0xf, false));
    v += __builtin_bit_cast(float, __builtin_amdgcn_update_dpp(0, __builtin_bit_cast(int, v), 0x4E, 0xf, 0xf, false));
    v += __builtin_bit_cast(float, __builtin_amdgcn_update_dpp(0, __builtin_bit_cast(int, v), 0x141, 0xf, 0xf, false));
    v += __builtin_bit_cast(float, __builtin_amdgcn_update_dpp(0, __builtin_bit_cast(int, v), 0x140, 0xf, 0xf, false));
    { unsigned a_ = __builtin_bit_cast(unsigned, v), b_ = a_; asm volatile("" : "+v"(b_));
      const auto r = __builtin_amdgcn_permlane16_swap(a_, b_, false, false); const unsigned r0_ = r[0], r1_ = r[1]; v = __uint_as_float(r0_) + __uint_as_float(r1_); }
    { unsigned a_ = __builtin_bit_cast(unsigned, v), b_ = a_; asm volatile("" : "+v"(b_));
      const auto r = __builtin_amdgcn_permlane32_swap(a_, b_, false, false); const unsigned r0_ = r[0], r1_ = r[1]; v = __uint_as_float(r0_) + __uint_as_float(r1_); }
    return v;
}
__device__ __forceinline__ float bflo(unsigned w) { return __uint_as_float(w << 16); }
__device__ __forceinline__ float bfhi(unsigned w) { return __uint_as_float(w & 0xffff0000u); }
__device__ __forceinline__ void p0_transpose_item(const float* W, int K, int N, bf16* WT, int ldo, LAS float* scr, int item, int lane) {
    const int nblk = N / 32, kb = item / nblk, nb = item % nblk, k0 = 64 * kb, n0 = 32 * nb;
    { f32x4 v_[8];
#pragma unroll
      for (int i = 0; i < 8; ++i) v_[i] = *(const GAS f32x4*)(W + (size_t)(k0 + i * 8 + (lane >> 3)) * N + n0 + (lane & 7) * 4);
#pragma unroll
      for (int i = 0; i < 8; ++i) { LAS float* d_ = scr + (i * 8 + (lane >> 3)) * 33 + (lane & 7) * 4; d_[0] = v_[i].x; d_[1] = v_[i].y; d_[2] = v_[i].z; d_[3] = v_[i].w; } }
    LDS_WAIT(); asm volatile("" ::: "memory");
    const int c = lane & 7;
#pragma unroll
    for (int j = 0; j < 4; ++j) { const int n = (lane >> 3) + 8 * j; const LAS float* s = scr + (8 * c) * 33 + n;
        v4u o; o.x = pk2(s[0 * 33], s[1 * 33]); o.y = pk2(s[2 * 33], s[3 * 33]); o.z = pk2(s[4 * 33], s[5 * 33]); o.w = pk2(s[6 * 33], s[7 * 33]);
        *(GAS v4u*)(WT + (size_t)(n0 + n) * ldo + k0 + 8 * c) = o; }
    LDS_WAIT(); asm volatile("" ::: "memory");
}
__device__ __forceinline__ void p0_transpose_item_fp8(const float* W, int ldo8, int N, unsigned char* WT8, int ncol0, int nb, int kb, LAS float* scr, int lane, float sc) {
    const int k0 = 64 * kb, n0 = 32 * nb;
    { f32x4 v_[8];
#pragma unroll
      for (int i = 0; i < 8; ++i) v_[i] = *(const GAS f32x4*)(W + (size_t)(k0 + i * 8 + (lane >> 3)) * N + ncol0 + n0 + (lane & 7) * 4);
#pragma unroll
      for (int i = 0; i < 8; ++i) { LAS float* d_ = scr + (i * 8 + (lane >> 3)) * 33 + (lane & 7) * 4; d_[0] = v_[i].x; d_[1] = v_[i].y; d_[2] = v_[i].z; d_[3] = v_[i].w; } }
    LDS_WAIT(); asm volatile("" ::: "memory");
    const int c = lane & 3;
#pragma unroll
    for (int j = 0; j < 2; ++j) { const int n = (lane >> 2) + 16 * j; const LAS float* s = scr + (16 * c) * 33 + n; v4u o;
        int w0 = __builtin_amdgcn_cvt_pk_fp8_f32(s[0 * 33] * sc, s[1 * 33] * sc, 0, false); w0 = __builtin_amdgcn_cvt_pk_fp8_f32(s[2 * 33] * sc, s[3 * 33] * sc, w0, true);
        int w1 = __builtin_amdgcn_cvt_pk_fp8_f32(s[4 * 33] * sc, s[5 * 33] * sc, 0, false); w1 = __builtin_amdgcn_cvt_pk_fp8_f32(s[6 * 33] * sc, s[7 * 33] * sc, w1, true);
        int w2 = __builtin_amdgcn_cvt_pk_fp8_f32(s[8 * 33] * sc, s[9 * 33] * sc, 0, false); w2 = __builtin_amdgcn_cvt_pk_fp8_f32(s[10 * 33] * sc, s[11 * 33] * sc, w2, true);
        int w3 = __builtin_amdgcn_cvt_pk_fp8_f32(s[12 * 33] * sc, s[13 * 33] * sc, 0, false); w3 = __builtin_amdgcn_cvt_pk_fp8_f32(s[14 * 33] * sc, s[15 * 33] * sc, w3, true);
        o.x = (unsigned)w0; o.y = (unsigned)w1; o.z = (unsigned)w2; o.w = (unsigned)w3;
        *(GAS v4u*)(WT8 + (size_t)(n0 + n) * ldo8 + k0 + 16 * c) = o; }
    LDS_WAIT(); asm volatile("" ::: "memory");
}
__device__ __forceinline__ void rms_row_to_bf16(const float* xrow, const float* gain, bf16* orow, int lane, unsigned char* o8row = nullptr, float sc8 = 1.f) {
    const GAS f32x4* xr = (const GAS f32x4*)xrow + lane;
    f32x4 v[16]; float s = 0.f;
#pragma unroll
    for (int i = 0; i < 16; ++i) { v[i] = xr[64 * i]; s += (v[i].x * v[i].x + v[i].y * v[i].y) + (v[i].z * v[i].z + v[i].w * v[i].w); }
    const GAS f32x4* gr = (const GAS f32x4*)gain + lane;
    f32x4 gq[16];
#pragma unroll
    for (int i = 0; i < 16; ++i) gq[i] = gr[64 * i];
    const float rs = 1.0f / sqrtf(wave_sum(s) * (1.0f / DM) + EPS);
    asm volatile("" ::: "memory");
    GAS u32x2* o8 = (GAS u32x2*)orow + lane;
#pragma unroll
    for (int i = 0; i < 16; ++i) { const f32x4 g = gq[i]; const float y0 = v[i].x * rs * g.x, y1 = v[i].y * rs * g.y, y2 = v[i].z * rs * g.z, y3 = v[i].w * rs * g.w;
        if (orow) { u32x2 w; w.x = pk2(y0, y1); w.y = pk2(y2, y3); o8[64 * i] = w; }
        if (o8row) { int q; if (PROJ_INT8) q = pk_i8(y0 * sc8, y1 * sc8, y2 * sc8, y3 * sc8); else { q = __builtin_amdgcn_cvt_pk_fp8_f32(y0 * sc8, y1 * sc8, 0, false); q = __builtin_amdgcn_cvt_pk_fp8_f32(y2 * sc8, y3 * sc8, q, true); } ((GAS unsigned*)o8row)[64 * i + lane] = (unsigned)q; } }
}
__device__ __forceinline__ bf16x8 cvt8(const float* p) {
    const f32x4 a = *(const GAS f32x4*)p, b = *(const GAS f32x4*)(p + 4);
    v4u w; w.x = pk2(a.x, a.y); w.y = pk2(a.z, a.w); w.z = pk2(b.x, b.y); w.w = pk2(b.z, b.w);
    return __builtin_bit_cast(bf16x8, w);
}
__device__ __forceinline__ void p0_prologue(Frame& F) {
    LAS float* scr = (LAS float*)(F.lds + RING_OFF + F.wave * 16384);
    const int gw = F.vcu * NWAVES + F.wave, NGW = F.G * NWAVES;
    bf16* WINT = (bf16*)(F.ws + WS_WINT); bf16* WCOT = (bf16*)(F.ws + WS_WCOT);
    constexpr int I_1 = (DM / 64) * (INC / 32), I_2 = (CD / 64) * (DM / 32), I_3 = (AD / 64) * (DM / 32), I_4 = (DM / 64) * (DM / 32);
    constexpr int NITEMS = I_1 + I_2 + I_3 + I_4;
    struct TItem { const float* src; unsigned char* dst; int N, ldo, fp8; float sc; };
#define P0_KB(r, NB) (2 * (((r) >> 1) / (NB)) + ((r) & 1))
#define P0_NB(r, NB) (((r) >> 1) % (NB))
    auto decode = [&](int it) { TItem t; int r = it;
        if (r < I_1) { const int kb = P0_KB(r, INC / 32), nb = P0_NB(r, INC / 32); t.src = F.in[I_WIN] + (size_t)(64 * kb) * INC + 32 * nb; t.N = INC;
            if (nb < Z8_COL0 / 32) { t.fp8 = 0; t.ldo = 2 * LDP; t.dst = (unsigned char*)WINT + (size_t)(32 * nb) * (2 * LDP) + 2 * 64 * kb; t.sc = 1.f; }
            else { t.fp8 = LOWP; t.ldo = 2 * LDP8; t.dst = (unsigned char*)(F.ws + WS_WIN8) + (size_t)(32 * nb - Z8_COL0) * (2 * LDP8) + 64 * kb; t.sc = WIN8_SCALE; }
            return t; } r -= I_1;
        if (r < I_2) { const int kb = P0_KB(r, DM / 32), nb = P0_NB(r, DM / 32); t.src = F.in[I_WCO] + (size_t)(64 * kb) * DM + 32 * nb; t.N = DM;
            if (GEMM2_FUSED) { t.fp8 = 1; t.ldo = 2 * LDP8; t.dst = (unsigned char*)(F.ws + WS_WC) + (size_t)(32 * nb) * (2 * LDP8) + 64 * kb; t.sc = WCO8_SCALE; }
            else if (CONVOUT_INT8 || CONVOUT_FP8) { t.fp8 = CONVOUT_FP8 ? 1 : 2; t.ldo = 2 * LDH8; t.dst = (unsigned char*)WCOT + (size_t)(32 * nb) * (2 * LDH8) + 64 * kb; t.sc = WCO8_SCALE; }
            else { t.fp8 = 0; t.ldo = 2 * LDH; t.dst = (unsigned char*)WCOT + (size_t)(32 * nb) * (2 * LDH) + 2 * 64 * kb; t.sc = 1.f; }
            return t; } r -= I_2;
        if (r < I_3) { const int kb = P0_KB(r, DM / 32), nb = P0_NB(r, DM / 32); t.src = F.in[I_WAO] + (size_t)(64 * kb) * DM + 32 * nb; t.N = DM; t.fp8 = 1; t.sc = WAO8_SCALE;
            if (GEMM2_FUSED) { t.ldo = 2 * LDP8; t.dst = (unsigned char*)(F.ws + WS_WC) + (size_t)(32 * nb) * (2 * LDP8) + 2048 + 64 * kb; }
            else { t.ldo = 2 * LDH8; t.dst = (unsigned char*)(F.ws + WS_WAO8) + (size_t)(32 * nb) * (2 * LDH8) + 64 * kb; }
            return t; } r -= I_3;
        { const int kb = P0_KB(r, DM / 32), nb = P0_NB(r, DM / 32); t.src = F.in[I_WO] + (size_t)(64 * kb) * DM + 32 * nb; t.N = DM;
          if (GEMM3_FP8) { t.fp8 = LOWP; t.ldo = 2 * LDP8; t.dst = (unsigned char*)(F.ws + WS_WOT) + (size_t)(32 * nb) * (2 * LDP8) + 64 * kb; t.sc = WO8_SCALE; }
          else { t.fp8 = 0; t.ldo = 2 * LDP; t.dst = (unsigned char*)(F.ws + WS_WOT) + (size_t)(32 * nb) * (2 * LDP) + 2 * 64 * kb; t.sc = 1.f; } }
        return t; };
#define P0_LOAD(T, V) do { _Pragma("unroll") for (int i = 0; i < 8; ++i) V[i] = *(const GAS f32x4*)(T.src + (size_t)(i * 8 + (F.lane >> 3)) * T.N + (F.lane & 7) * 4); } while (0)
#define P0_PROC(T, V) do { _Pragma("unroll") for (int i = 0; i < 8; ++i) { LAS float* d_ = scr + (i * 8 + (F.lane >> 3)) * 33 + (F.lane & 7) * 4; d_[0] = V[i].x; d_[1] = V[i].y; d_[2] = V[i].z; d_[3] = V[i].w; } \
        LDS_WAIT(); asm volatile("" ::: "memory"); \
        if (T.fp8) { const int c = F.lane & 3; const float sc = T.sc; \
            _Pragma("unroll") for (int j = 0; j < 2; ++j) { const int n = (F.lane >> 2) + 16 * j; const LAS float* s = scr + (16 * c) * 33 + n; v4u o; \
                int w0, w1, w2, w3; \
                if (T.fp8 == 2) { w0 = pk_i8(s[0 * 33] * sc, s[1 * 33] * sc, s[2 * 33] * sc, s[3 * 33] * sc); w1 = pk_i8(s[4 * 33] * sc, s[5 * 33] * sc, s[6 * 33] * sc, s[7 * 33] * sc); w2 = pk_i8(s[8 * 33] * sc, s[9 * 33] * sc, s[10 * 33] * sc, s[11 * 33] * sc); w3 = pk_i8(s[12 * 33] * sc, s[13 * 33] * sc, s[14 * 33] * sc, s[15 * 33] * sc); } \
                else { w0 = __builtin_amdgcn_cvt_pk_fp8_f32(s[0 * 33] * sc, s[1 * 33] * sc, 0, false); w0 = __builtin_amdgcn_cvt_pk_fp8_f32(s[2 * 33] * sc, s[3 * 33] * sc, w0, true); \
                w1 = __builtin_amdgcn_cvt_pk_fp8_f32(s[4 * 33] * sc, s[5 * 33] * sc, 0, false); w1 = __builtin_amdgcn_cvt_pk_fp8_f32(s[6 * 33] * sc, s[7 * 33] * sc, w1, true); \
                w2 = __builtin_amdgcn_cvt_pk_fp8_f32(s[8 * 33] * sc, s[9 * 33] * sc, 0, false); w2 = __builtin_amdgcn_cvt_pk_fp8_f32(s[10 * 33] * sc, s[11 * 33] * sc, w2, true); \
                w3 = __builtin_amdgcn_cvt_pk_fp8_f32(s[12 * 33] * sc, s[13 * 33] * sc, 0, false); w3 = __builtin_amdgcn_cvt_pk_fp8_f32(s[14 * 33] * sc, s[15 * 33] * sc, w3, true); } \
                o.x = (unsigned)w0; o.y = (unsigned)w1; o.z = (unsigned)w2; o.w = (unsigned)w3; *(GAS v4u*)(T.dst + (size_t)n * T.ldo + 16 * c) = o; } } \
        else { const int c = F.lane & 7; \
            _Pragma("unroll") for (int j = 0; j < 4; ++j) { const int n = (F.lane >> 3) + 8 * j; const LAS float* s = scr + (8 * c) * 33 + n; v4u o; \
                o.x = pk2(s[0 * 33], s[1 * 33]); o.y = pk2(s[2 * 33], s[3 * 33]); o.z = pk2(s[4 * 33], s[5 * 33]); o.w = pk2(s[6 * 33], s[7 * 33]); *(GAS v4u*)(T.dst + (size_t)n * T.ldo + 16 * c) = o; } } \
        LDS_WAIT(); asm volatile("" ::: "memory"); } while (0)
    {
        int it = gw; TItem ta, tb; f32x4 va[8], vb[8];
        if (it < NITEMS) {
            ta = decode(it); P0_LOAD(ta, va);
            for (;;) {
                { const int itn = it + NGW; tb = decode(itn < NITEMS ? itn : gw); P0_LOAD(tb, vb); }
                P0_PROC(ta, va); it += NGW; if (it >= NITEMS) break;
                { const int itn = it + NGW; ta = decode(itn < NITEMS ? itn : gw); P0_LOAD(ta, va); }
                P0_PROC(tb, vb); it += NGW; if (it >= NITEMS) break;
            }
        }
    }
#undef P0_KB
#undef P0_NB
#undef P0_LOAD
#undef P0_PROC
    bf16* HN = (bf16*)(F.ws + WS_HN);
    {
        const GAS f32x4* gr = (const GAS f32x4*)F.in[I_NMIX] + F.lane; f32x4 gq[16];
#pragma unroll
        for (int i = 0; i < 16; ++i) gq[i] = gr[64 * i];
#define HN_LOAD(V, M) do { const GAS f32x4* xr_ = (const GAS f32x4*)(F.in[I_X] + (size_t)(M) * DM) + F.lane; _Pragma("unroll") for (int i = 0; i < 16; ++i) V[i] = xr_[64 * i]; } while (0)
#define HN_PROC(V, M) do { float s_ = 0.f; _Pragma("unroll") for (int i = 0; i < 16; ++i) s_ += (V[i].x * V[i].x + V[i].y * V[i].y) + (V[i].z * V[i].z + V[i].w * V[i].w); \
        const float rs_ = 1.0f / sqrtf(wave_sum(s_) * (1.0f / DM) + EPS); \
        GAS u32x2* ob_ = (GAS u32x2*)(HN + (size_t)(M) * LDP) + F.lane; GAS unsigned* o8_ = (GAS unsigned*)((unsigned char*)(F.ws + WS_HN8) + (size_t)(M) * (2 * LDP8)) + F.lane; \
        _Pragma("unroll") for (int i = 0; i < 16; ++i) { const f32x4 g = gq[i]; const float y0 = V[i].x * rs_ * g.x, y1 = V[i].y * rs_ * g.y, y2 = V[i].z * rs_ * g.z, y3 = V[i].w * rs_ * g.w; \
            if (Z8_COL0 > 0) { u32x2 w; w.x = pk2(y0, y1); w.y = pk2(y2, y3); ob_[64 * i] = w; } \
            int q; if (PROJ_INT8) q = pk_i8(y0 * HN8_SCALE, y1 * HN8_SCALE, y2 * HN8_SCALE, y3 * HN8_SCALE); else { q = __builtin_amdgcn_cvt_pk_fp8_f32(y0 * HN8_SCALE, y1 * HN8_SCALE, 0, false); q = __builtin_amdgcn_cvt_pk_fp8_f32(y2 * HN8_SCALE, y3 * HN8_SCALE, q, true); } \
            o8_[64 * i] = (unsigned)q; } } while (0)
        int m = gw;
        if (m < T_) {
            f32x4 va[16], vb[16]; HN_LOAD(va, m);
            for (;;) {
                { const int mn = m + NGW; HN_LOAD(vb, mn < T_ ? mn : gw); }
                HN_PROC(va, m); m += NGW; if (m >= T_) break;
                { const int mn = m + NGW; HN_LOAD(va, mn < T_ ? mn : gw); }
                HN_PROC(vb, m); m += NGW; if (m >= T_) break;
            }
        }
#undef HN_LOAD
#undef HN_PROC
    }
    {
        bf16* WF = (bf16*)(F.ws + WS_WPQF); const float* SK = F.in[I_SUBK]; const float* WQ = F.in[I_WPQ];
        const int l15 = F.lane & 15, l4 = F.lane >> 4;
        for (int task = gw; task < 2048; task += NGW) {
            const int combo = task & 127, kr = task >> 7, hc = combo >> 3, kt = combo & 7, n0 = hc * 128 + kt * 16;
            bf16x8 bfr[4];
#pragma unroll
            for (int ds = 0; ds < 4; ++ds) bfr[ds] = cvt8(SK + (size_t)(n0 + l15) * 128 + ds * 32 + 8 * l4);
#pragma unroll 1
            for (int kq = 0; kq < 4; ++kq) {
                f32x4 ra[4][4], rb[4][4];
#pragma unroll
                for (int g = 0; g < 4; ++g)
#pragma unroll
                    for (int ds = 0; ds < 4; ++ds) { const float* wp = WQ + (size_t)(kr * 256 + (kq * 4 + g) * 16 + l15) * 2048 + hc * 128 + ds * 32 + 8 * l4; ra[g][ds] = *(const GAS f32x4*)wp; rb[g][ds] = *(const GAS f32x4*)(wp + 4); }
#pragma unroll
                for (int g = 0; g < 4; ++g) {
                    const int k0 = kr * 256 + (kq * 4 + g) * 16;
                    pg8::f32x4 acc = {0.f, 0.f, 0.f, 0.f};
#pragma unroll
                    for (int ds = 0; ds < 4; ++ds) { v4u w; w.x = pk2(ra[g][ds].x, ra[g][ds].y); w.y = pk2(ra[g][ds].z, ra[g][ds].w); w.z = pk2(rb[g][ds].x, rb[g][ds].y); w.w = pk2(rb[g][ds].z, rb[g][ds].w);
                        acc = __builtin_amdgcn_mfma_f32_16x16x32_bf16(__builtin_bit_cast(bf16x8, w), bfr[ds], acc, 0, 0, 0); }
                    if (SCORES_INT8) *(GAS unsigned*)((unsigned char*)WF + (size_t)(n0 + l15) * (2 * LDP8) + k0 + 4 * l4) = (unsigned)pk_i8(acc[0] * WPQ8_SCALE, acc[1] * WPQ8_SCALE, acc[2] * WPQ8_SCALE, acc[3] * WPQ8_SCALE);
                    else { u32x2 w; w.x = pk2(acc[0], acc[1]); w.y = pk2(acc[2], acc[3]);
                    *(GAS u32x2*)(WF + (size_t)(n0 + l15) * LDP + k0 + 4 * l4) = w; }
                }
            }
        }
    }
    static_assert(PEER_USCALE == pg8::HK_USCALE && PEER_VSCALE == pg8::HK_VSCALE, "TblHook scales");
    if (!UV_IN_GEMM1) {
        const size_t n8 = (size_t)NEXP * DM / 8; const size_t gt = (size_t)F.vcu * (NWAVES * 64) + F.tid, nth = (size_t)F.G * (NWAVES * 64);
        unsigned char* UB = (unsigned char*)(F.ws + WS_UB); unsigned char* VB = (unsigned char*)(F.ws + WS_VB);
        auto cvt_chunk = [&](size_t i, const f32x4 a, const f32x4 b) { const bool isu = i < n8; const size_t j = isu ? i : i - n8; const float sc = isu ? PEER_USCALE : PEER_VSCALE;
            int w0, w1;
            if (isu) { w0 = pk_i8(a.x * sc, a.y * sc, a.z * sc, a.w * sc); w1 = pk_i8(b.x * sc, b.y * sc, b.z * sc, b.w * sc); }
            else { w0 = __builtin_amdgcn_cvt_pk_fp8_f32(a.x * sc, a.y * sc, 0, false); w0 = __builtin_amdgcn_cvt_pk_fp8_f32(a.z * sc, a.w * sc, w0, true);
                   w1 = __builtin_amdgcn_cvt_pk_fp8_f32(b.x * sc, b.y * sc, 0, false); w1 = __builtin_amdgcn_cvt_pk_fp8_f32(b.z * sc, b.w * sc, w1, true); }
            const size_t e = j >> 9, col = (j & 511) * 8, sl = col >> 10, c = col & 1023;
            u32x2 w; w.x = (unsigned)w0; w.y = (unsigned)w1; *(GAS u32x2*)((isu ? UB : VB) + (sl * NEXP + e) * 1024 + c) = w; };
        auto src_of = [&](size_t i) { const bool isu = i < n8; const size_t j = isu ? i : i - n8; return (isu ? F.in[I_UEMB] : F.in[I_VEMB]) + j * 8; };
        size_t i = gt;
        for (; i + 7 * nth < 2 * n8; i += 8 * nth) {
            f32x4 a_[8], b_[8];
#pragma unroll
            for (int c = 0; c < 8; ++c) { const float* sp = src_of(i + c * nth); a_[c] = *(const GAS f32x4*)sp; b_[c] = *(const GAS f32x4*)(sp + 4); }
#pragma unroll
            for (int c = 0; c < 8; ++c) cvt_chunk(i + c * nth, a_[c], b_[c]);
        }
        for (; i < 2 * n8; i += nth) { const float* s0 = src_of(i); const f32x4 a0 = *(const GAS f32x4*)s0, b0 = *(const GAS f32x4*)(s0 + 4); cvt_chunk(i, a0, b0); }
    }
}
__device__ __forceinline__ void p2_conv_kmean(Frame& F) {
    const bf16* Z = (const bf16*)(F.ws + WS_Z);
    float* KM = (float*)(F.ws + WS_KMEAN);
    LAS float* red = (LAS float*)(F.lds + RING_OFF);
    for (int u = F.vcu; u < 128; u += F.G) {
        const int bn = u >> 2, cg = u & 3, b = bn >> 3, n = bn & 7;
        const bf16* kp = Z + (size_t)(b * SEQ + n * 256 + F.wave * 32) * INC + ZC_K + cg * 512 + F.lane * 8;
        float s[8];
#pragma unroll
        for (int e = 0; e < 8; ++e) s[e] = 0.f;
#pragma unroll 16
        for (int t = 0; t < 32; ++t) { const v4u w = *(const GAS v4u*)(kp + (size_t)t * INC);
            s[0] += bflo(w.x); s[1] += bfhi(w.x); s[2] += bflo(w.y); s[3] += bfhi(w.y); s[4] += bflo(w.z); s[5] += bfhi(w.z); s[6] += bflo(w.w); s[7] += bfhi(w.w); }
        __syncthreads();
#pragma unroll
        for (int e = 0; e < 8; ++e) red[F.wave * 512 + F.lane * 8 + e] = s[e];
        __syncthreads();
        { float a = 0.f;
#pragma unroll
          for (int w = 0; w < 8; ++w) a += red[w * 512 + F.tid];
          const int col = cg * 512 + F.tid, h = col >> 7, d = col & 127;
          KM[((size_t)(b * NH + h) * NBLK + n) * HD + d] = a * (1.0f / 256.0f); }
    }
    const int gw = F.vcu * NWAVES + F.wave, NGW = F.G * NWAVES;
    bf16* BZ = (bf16*)(F.ws + WS_BZ); const float* CW = F.in[I_CONVW];
    for (int u = gw; u < (T_ / 16) * 4; u += NGW) {
        const int ch = u >> 2, cg = u & 3, t0 = ch * 16, c0 = cg * 512 + F.lane * 8;
        float w0[8], w1[8], w2[8];
#pragma unroll
        for (int e = 0; e < 8; ++e) { w0[e] = CW[c0 + e]; w1[e] = CW[CD + c0 + e]; w2[e] = CW[2 * CD + c0 + e]; }
        float p2[8], p1[8];
        const bool first = (t0 % SEQ) == 0;
#pragma unroll
        for (int e = 0; e < 8; ++e) { p2[e] = 0.f; p1[e] = 0.f; }
        if (!first) {
            const bf16* zr2 = Z + (size_t)(t0 - 2) * INC + c0; const bf16* zr1 = Z + (size_t)(t0 - 1) * INC + c0;
            const v4u c2 = *(const GAS v4u*)(zr2 + ZC_C), u2 = *(const GAS v4u*)(zr2 + ZC_U), c1 = *(const GAS v4u*)(zr1 + ZC_C), u1 = *(const GAS v4u*)(zr1 + ZC_U);
            p2[0] = bflo(c2.x) * bflo(u2.x); p2[1] = bfhi(c2.x) * bfhi(u2.x); p2[2] = bflo(c2.y) * bflo(u2.y); p2[3] = bfhi(c2.y) * bfhi(u2.y);
            p2[4] = bflo(c2.z) * bflo(u2.z); p2[5] = bfhi(c2.z) * bfhi(u2.z); p2[6] = bflo(c2.w) * bflo(u2.w); p2[7] = bfhi(c2.w) * bfhi(u2.w);
            p1[0] = bflo(c1.x) * bflo(u1.x); p1[1] = bfhi(c1.x) * bfhi(u1.x); p1[2] = bflo(c1.y) * bflo(u1.y); p1[3] = bfhi(c1.y) * bfhi(u1.y);
            p1[4] = bflo(c1.z) * bflo(u1.z); p1[5] = bfhi(c1.z) * bfhi(u1.z); p1[6] = bflo(c1.w) * bflo(u1.w); p1[7] = bfhi(c1.w) * bfhi(u1.w);
        }
        constexpr int CONV_TB = 4;
#pragma unroll 1
        for (int th = 0; th < 16; th += CONV_TB) {
        v4u ccv[CONV_TB], uuv[CONV_TB], bbv[CONV_TB];
#pragma unroll
        for (int t8 = 0; t8 < CONV_TB; ++t8) { const bf16* zr = Z + (size_t)(t0 + th + t8) * INC + c0; ccv[t8] = *(const GAS v4u*)(zr + ZC_C); uuv[t8] = *(const GAS v4u*)(zr + ZC_U); bbv[t8] = *(const GAS v4u*)(zr + ZC_B); }
        asm volatile("" ::: "memory");
#pragma unroll
        for (int t8 = 0; t8 < CONV_TB; ++t8) { const int t = th + t8;
            const v4u cc = ccv[t8], uu = uuv[t8], bb = bbv[t8];
            float p0[8], bg[8], o[8];
            p0[0] = bflo(cc.x) * bflo(uu.x); p0[1] = bfhi(cc.x) * bfhi(uu.x); p0[2] = bflo(cc.y) * bflo(uu.y); p0[3] = bfhi(cc.y) * bfhi(uu.y);
            p0[4] = bflo(cc.z) * bflo(uu.z); p0[5] = bfhi(cc.z) * bfhi(uu.z); p0[6] = bflo(cc.w) * bflo(uu.w); p0[7] = bfhi(cc.w) * bfhi(uu.w);
            bg[0] = bflo(bb.x); bg[1] = bfhi(bb.x); bg[2] = bflo(bb.y); bg[3] = bfhi(bb.y); bg[4] = bflo(bb.z); bg[5] = bfhi(bb.z); bg[6] = bflo(bb.w); bg[7] = bfhi(bb.w);
#pragma unroll
            for (int e = 0; e < 8; ++e) { o[e] = bg[e] * (w0[e] * p2[e] + w1[e] * p1[e] + w2[e] * p0[e]); p2[e] = p1[e]; p1[e] = p0[e]; }
            if (CONVOUT_FP8) { u32x2 w8; int q0 = __builtin_amdgcn_cvt_pk_fp8_f32(o[0] * BZ8_SCALE, o[1] * BZ8_SCALE, 0, false); q0 = __builtin_amdgcn_cvt_pk_fp8_f32(o[2] * BZ8_SCALE, o[3] * BZ8_SCALE, q0, true);
                int q1 = __builtin_amdgcn_cvt_pk_fp8_f32(o[4] * BZ8_SCALE, o[5] * BZ8_SCALE, 0, false); q1 = __builtin_amdgcn_cvt_pk_fp8_f32(o[6] * BZ8_SCALE, o[7] * BZ8_SCALE, q1, true); w8.x = (unsigned)q0; w8.y = (unsigned)q1;
                if (GEMM2_FUSED) *(GAS u32x2*)((unsigned char*)(F.ws + WS_AC) + (size_t)(t0 + t) * (2 * LDP8) + c0) = w8;
                else *(GAS u32x2*)((unsigned char*)BZ + (size_t)(t0 + t) * (2 * LDH8) + c0) = w8; }
            else if (CONVOUT_INT8) { u32x2 w8; w8.x = (unsigned)pk_i8(o[0] * BZ8_SCALE, o[1] * BZ8_SCALE, o[2] * BZ8_SCALE, o[3] * BZ8_SCALE); w8.y = (unsigned)pk_i8(o[4] * BZ8_SCALE, o[5] * BZ8_SCALE, o[6] * BZ8_SCALE, o[7] * BZ8_SCALE);
                *(GAS u32x2*)((unsigned char*)BZ + (size_t)(t0 + t) * (2 * LDH8) + c0) = w8; }
            else { v4u w; w.x = pk2(o[0], o[1]); w.y = pk2(o[2], o[3]); w.z = pk2(o[4], o[5]); w.w = pk2(o[6], o[7]);
            *(GAS v4u*)(BZ + (size_t)(t0 + t) * LDH + c0) = w; }
        }
        asm volatile("" ::: "memory");
        }
    }
}
__device__ __forceinline__ void p3_attention(Frame& F, char* lds) {
    const bf16* Z = (const bf16*)(F.ws + WS_Z); unsigned char* ATT = (unsigned char*)(F.ws + WS_ATT); const float* KM = (const float*)(F.ws + WS_KMEAN);
    for (int u = F.vcu; u < NBATCH * NH * 4; u += F.G) {
        const int bh = u >> 2, p = u & 3, b = bh / NH, h = bh % NH;
        const bf16* Kh = Z + (size_t)(b * SEQ) * INC + ZC_K + h * HD; const bf16* Vh = Z + (size_t)(b * SEQ) * INC + ZC_V + h * HD;
        const float* km = KM + (size_t)(b * NH + h) * NBLK * HD;
#pragma unroll 1
        for (int half = 0; half < 2; ++half) {
            const int qb = half == 0 ? 7 - p : p;
            const bf16* Qb = Z + (size_t)(b * SEQ + qb * 256) * INC + ZC_Q + h * HD;
            unsigned char* Ob = GEMM2_FUSED ? (unsigned char*)(F.ws + WS_AC) + (size_t)(b * SEQ + qb * 256) * (2 * LDP8) + 2048 + h * HD : ATT + (size_t)(b * SEQ + qb * 256) * (2 * LDH8) + h * HD;
            moba::moba_body(Qb, Kh, Vh, km, Ob, qb, lds);
        }
    }
}
__device__ __forceinline__ void rms_rowbf_to_bf16(const bf16* hrow, const float* gain, bf16* orow, int lane, unsigned char* q8row = nullptr) {
    const GAS v4u* hr = (const GAS v4u*)hrow + lane;
    v4u v[8]; float s = 0.f;
#pragma unroll
    for (int i = 0; i < 8; ++i) { v[i] = hr[64 * i];
        s += (bflo(v[i].x) * bflo(v[i].x) + bfhi(v[i].x) * bfhi(v[i].x)) + (bflo(v[i].y) * bflo(v[i].y) + bfhi(v[i].y) * bfhi(v[i].y)) + (bflo(v[i].z) * bflo(v[i].z) + bfhi(v[i].z) * bfhi(v[i].z)) + (bflo(v[i].w) * bflo(v[i].w) + bfhi(v[i].w) * bfhi(v[i].w)); }
    const float rs = 1.0f / sqrtf(wave_sum(s) * (1.0f / DM) + EPS);
    GAS v4u* o8 = (GAS v4u*)orow + lane;
#pragma unroll
    for (int i = 0; i < 8; ++i) { const f32x4 g0 = *(const GAS f32x4*)(gain + 512 * i + 8 * lane), g1 = *(const GAS f32x4*)(gain + 512 * i + 8 * lane + 4); v4u w;
        w.x = pk2(bflo(v[i].x) * rs * g0.x, bfhi(v[i].x) * rs * g0.y); w.y = pk2(bflo(v[i].y) * rs * g0.z, bfhi(v[i].y) * rs * g0.w);
        w.z = pk2(bflo(v[i].z) * rs * g1.x, bfhi(v[i].z) * rs * g1.y); w.w = pk2(bflo(v[i].w) * rs * g1.z, bfhi(v[i].w) * rs * g1.w);
        if (q8row) { const float q = rs * XN8_SCALE; u32x2 w8; w8.x = (unsigned)pk_i8(bflo(v[i].x) * q * g0.x, bfhi(v[i].x) * q * g0.y, bflo(v[i].y) * q * g0.z, bfhi(v[i].y) * q * g0.w); w8.y = (unsigned)pk_i8(bflo(v[i].z) * q * g1.x, bfhi(v[i].z) * q * g1.y, bflo(v[i].w) * q * g1.z, bfhi(v[i].w) * q * g1.w);
            ((GAS u32x2*)q8row)[64 * i + lane] = w8; }
        else o8[64 * i] = w; }
}
__device__ __forceinline__ void p6_rms(Frame& F) {
    const int gw = F.vcu * NWAVES + F.wave, NGW = F.G * NWAVES; bf16* XN = (bf16*)(F.ws + WS_XN); const bf16* HB = (const bf16*)(F.ws + WS_HB);
    for (int m = gw; m < T_; m += NGW) rms_rowbf_to_bf16(HB + (size_t)m * DM, F.in[I_NFFN], XN + (size_t)m * LDP, F.lane, SCORES_INT8 ? (unsigned char*)XN + (size_t)m * (2 * LDP8) : nullptr);
}
__device__ __forceinline__ int fkey(float f) { const int b = __float_as_int(f); return b ^ ((b >> 31) & 0x7fffffff); }
__device__ __forceinline__ float kval(int k) { return __int_as_float(k ^ ((k >> 31) & 0x7fffffff)); }
__device__ __forceinline__ int imax(int a, int b) { return a > b ? a : b; }
__device__ __forceinline__ int imin(int a, int b) { return a < b ? a : b; }
__device__ __forceinline__ void sort16_desc(int (&v)[16]) {
#pragma unroll
    for (int k = 2; k <= 16; k <<= 1)
#pragma unroll
        for (int j = k >> 1; j > 0; j >>= 1)
#pragma unroll
            for (int i = 0; i < 16; ++i) { const int l = i ^ j; if (l > i) { const int a = v[i], b = v[l]; const int mx = imax(a, b), mn = imin(a, b); const bool desc = (i & k) == 0; v[i] = desc ? mx : mn; v[l] = desc ? mn : mx; } }
}
__device__ __forceinline__ void merge_top16(int (&run)[16], const int (&grp)[16]) {
#pragma unroll
    for (int i = 0; i < 16; ++i) run[i] = imax(run[i], grp[15 - i]);
#pragma unroll
    for (int j = 8; j > 0; j >>= 1)
#pragma unroll
        for (int i = 0; i < 16; ++i) { const int l = i ^ j; if (l > i) { const int a = run[i], b = run[l]; run[i] = imax(a, b); run[l] = imin(a, b); } }
}
__device__ __forceinline__ void topk128(const float* sp, int (&run)[16]) {
#pragma unroll
    for (int i = 0; i < 16; ++i) run[i] = (int)0x80000000;
#pragma unroll 1
    for (int gg = 0; gg < 2; ++gg) {
        float raw[64];
#pragma unroll
        for (int i = 0; i < 64; ++i) raw[i] = sp[(size_t)(gg * 64 + i) * T_];
#pragma unroll
        for (int g = 0; g < 4; ++g) {
            int grp[16];
#pragma unroll
            for (int i = 0; i < 16; ++i) grp[i] = (fkey(raw[g * 16 + i]) & ~0x7F) | (gg * 64 + g * 16 + i);
            sort16_desc(grp);
            merge_top16(run, grp);
        }
    }
}
struct CandTab { int a[64], b[64]; };
__host__ __device__ constexpr CandTab make_cand() { CandTab t{}; int n = 0; for (int a = 0; a < 16; ++a) for (int b = 0; b < 16; ++b) if ((a + 1) * (b + 1) <= 16) { t.a[n] = a; t.b[n] = b; ++n; }
    for (; n < 64; ++n) { t.a[n] = -1; t.b[n] = -1; } return t; }
constexpr size_t WS_PART = WS_Z, WS_SSQ = WS_Z + 32 * MiB, WS_ES = WS_Z + 33 * MiB, WS_GS = WS_Z + 37 * MiB, WS_BST = WS_Z + 41 * MiB;
constexpr int NBUCK = 8, BUCK_SHIFT = 11;
__device__ __forceinline__ void p8_topk(Frame& F) {
    constexpr CandTab CT = make_cand();
    const float* ST = (const float*)(F.ws + WS_ST); int* EXP = (int*)(F.ws + WS_EXP); float* GATE = (float*)(F.ws + WS_GATE);
    int* ES = (int*)(F.ws + WS_ES); float* GS = (float*)(F.ws + WS_GS); int* BST = (int*)(F.ws + WS_BST);
    LAS int* EL = (LAS int*)(F.lds + RING_OFF); LAS float* GL = (LAS float*)(F.lds + RING_OFF + 16384);
    LAS int* tab = (LAS int*)(F.lds + RING_OFF + 32768 + F.wave * 8192);
    const int lane = F.lane, tl = lane & 31, c = lane >> 5, h = F.wave;
    for (int u = F.vcu; u < T_ / 32; u += F.G) {
        const int t = u * 32 + tl;
        int mine[16];
        topk128(ST + (size_t)((h * 2 + c) * 128) * T_ + t, mine);
        float s1[16], s2[16];
#pragma unroll
        for (int i = 0; i < 16; ++i) { const int other = __shfl_xor(mine[i], 32); const int k1 = c ? other : mine[i], k2 = c ? mine[i] : other;
            s1[i] = kval(k1 & ~0x7F); s2[i] = kval(k2 & ~0x7F); tab[i * 64 + lane] = k1 & 0x7F; tab[(16 + i) * 64 + lane] = k2 & 0x7F; }
        int c0[16], c1[16], c2[16], c3[16];
#pragma unroll
        for (int i = 0; i < 16; ++i) {
            c0[i] = CT.a[i] < 0 ? (int)0x80000000 : ((fkey(s1[CT.a[i] < 0 ? 0 : CT.a[i]] + s2[CT.b[i] < 0 ? 0 : CT.b[i]]) & ~0xFF) | (CT.a[i] * 16 + CT.b[i]));
            c1[i] = CT.a[16 + i] < 0 ? (int)0x80000000 : ((fkey(s1[CT.a[16 + i] < 0 ? 0 : CT.a[16 + i]] + s2[CT.b[16 + i] < 0 ? 0 : CT.b[16 + i]]) & ~0xFF) | (CT.a[16 + i] * 16 + CT.b[16 + i]));
            c2[i] = CT.a[32 + i] < 0 ? (int)0x80000000 : ((fkey(s1[CT.a[32 + i] < 0 ? 0 : CT.a[32 + i]] + s2[CT.b[32 + i] < 0 ? 0 : CT.b[32 + i]]) & ~0xFF) | (CT.a[32 + i] * 16 + CT.b[32 + i]));
            c3[i] = CT.a[48 + i] < 0 ? (int)0x80000000 : ((fkey(s1[CT.a[48 + i] < 0 ? 0 : CT.a[48 + i]] + s2[CT.b[48 + i] < 0 ? 0 : CT.b[48 + i]]) & ~0xFF) | (CT.a[48 + i] * 16 + CT.b[48 + i]));
        }
        sort16_desc(c0); sort16_desc(c1); sort16_desc(c2); sort16_desc(c3);
        merge_top16(c0, c1); merge_top16(c2, c3); merge_top16(c0, c2);
        LDS_WAIT();
        float rs = 1.0f;
        if (DEFER_FFN_NORM) { const float* sp_ = (const float*)(F.ws + WS_SSQP) + (size_t)t * 64; float a_ = 0.f;
#pragma unroll
            for (int j = 0; j < 16; ++j) { const f32x4 v_ = *(const GAS f32x4*)(sp_ + 4 * j); a_ += (v_.x + v_.y) + (v_.z + v_.w); }
            rs = 1.0f / sqrtf(a_ * (1.0f / DM) + EPS); if (h == 0 && c == 0) ((float*)(F.ws + WS_RS))[t] = rs; }
        int ex[16]; float gv[16]; float sum = 0.f; const float mx = kval(c0[0] & ~0xFF);
#pragma unroll
        for (int i = 0; i < 16; ++i) { const int ab = c0[i] & 0xFF, a = ab >> 4, b = ab & 15; const int i1 = tab[a * 64 + lane], i2 = tab[(16 + b) * 64 + lane];
            ex[i] = i1 * NKEYS + i2; gv[i] = __expf((kval(c0[i] & ~0xFF) - mx) * rs); sum += gv[i]; }
        const float inv = 1.0f / sum;
        if (c == 0) {
            int* ep = EXP + (size_t)t * NSEL + h * PTOPK; float* gp = GATE + (size_t)t * NSEL + h * PTOPK;
#pragma unroll
            for (int i = 0; i < 16; i += 4) { *(int4*)(ep + i) = make_int4(ex[i], ex[i + 1], ex[i + 2], ex[i + 3]); *(float4*)(gp + i) = make_float4(gv[i] * inv, gv[i + 1] * inv, gv[i + 2] * inv, gv[i + 3] * inv); }
#pragma unroll
            for (int i = 0; i < 16; ++i) { EL[tl * NSEL + h * PTOPK + i] = ex[i]; GL[tl * NSEL + h * PTOPK + i] = gv[i] * inv; }
        }
        __syncthreads();
#pragma unroll
        for (int q = 0; q < 4; ++q) {
            const int tq = F.wave * 4 + q; const size_t tt = (size_t)(u * 32 + tq);
            int k0 = (EL[tq * NSEL + lane] << 7) | lane, k1 = (EL[tq * NSEL + 64 + lane] << 7) | (64 + lane);
#pragma unroll
            for (int k = 2; k <= 128; k <<= 1)
#pragma unroll
                for (int j = k >> 1; j > 0; j >>= 1) {
                    if (j == 64) { const int lo = imin(k0, k1), hi = imax(k0, k1); k0 = lo; k1 = hi; }
                    else { const int p0 = __shfl_xor(k0, j), p1 = __shfl_xor(k1, j); const bool lower = (lane & j) == 0, up0 = (lane & k) == 0, up1 = ((64 + lane) & k) == 0;
                        k0 = (lower == up0) ? imin(k0, p0) : imax(k0, p0); k1 = (lower == up1) ? imin(k1, p1) : imax(k1, p1); }
                }
            const int e0 = k0 >> 7, e1 = k1 >> 7;
            ES[tt * NSEL + lane] = e0; ES[tt * NSEL + 64 + lane] = e1; GS[tt * NSEL + lane] = GL[tq * NSEL + (k0 & 127)]; GS[tt * NSEL + 64 + lane] = GL[tq * NSEL + (k1 & 127)];
            int bstv = 0;
#pragma unroll
            for (int b = 0; b <= NBUCK; ++b) { const int cnt = __popcll(__ballot(e0 < (b << BUCK_SHIFT))) + __popcll(__ballot(e1 < (b << BUCK_SHIFT))); bstv = (lane == b) ? cnt : bstv; }
            if (lane < 16) BST[tt * 16 + lane] = bstv;
        }
        __syncthreads();
    }
}
constexpr int P9_NSL = 4, P9_SLD = DM / P9_NSL, P9_TPS = 4;
constexpr int P9_TPU = 8;
constexpr int P9_WLDS = 9216;
__device__ __forceinline__ int rfl(int v) { return __builtin_amdgcn_readfirstlane(v); }
template <int CTRL, int RMASK> __device__ __forceinline__ float dppadd(float v) { return v + __builtin_bit_cast(float, __builtin_amdgcn_update_dpp(0, __builtin_bit_cast(int, v), CTRL, RMASK, 0xf, false)); }
__device__ __forceinline__ f32x2 fp8lo(unsigned w) { return __builtin_amdgcn_cvt_pk_f32_fp8((int)w, false); }
__device__ __forceinline__ f32x2 fp8hi(unsigned w) { return __builtin_amdgcn_cvt_pk_f32_fp8((int)w, true); }
#define P9_DESC(i) const int d_ = rfl(DS[i]); const int tkd = d_ & 7, pd = (d_ >> 3) & 127, nd = d_ >> 10; const int nm1 = imax(nd, 1) - 1
#define P9_ISSUE(i, W) do { P9_DESC(i); const int ev_ = EL[tkd * 128 + pd + imin(lane & 7, nm1)]; \
        _Pragma("unroll") for (int q = 0; q < 8; ++q) { const int e_ = __builtin_amdgcn_readlane(ev_, q); W[q] = *(const GAS v4u*)(TB + (size_t)e_ * P9_SLD); } } while (0)
#define P9_DOT16(W, K) __builtin_amdgcn_sdot4((int)W.x, xs[K].x, __builtin_amdgcn_sdot4((int)W.y, xs[K].y, __builtin_amdgcn_sdot4((int)W.z, xs[K].z, __builtin_amdgcn_sdot4((int)W.w, xs[K].w, 0, false), false), false), false)
__device__ __forceinline__ int ifold32(int a, int b) { const auto r = __builtin_amdgcn_permlane32_swap((unsigned)a, (unsigned)b, false, false); return (int)(r[0] + r[1]); }
__device__ __forceinline__ int ifold16(int a, int b) { const auto r = __builtin_amdgcn_permlane16_swap((unsigned)a, (unsigned)b, false, false); return (int)(r[0] + r[1]); }
template <int CTRL> __device__ __forceinline__ int idppadd(int v) { return v + __builtin_amdgcn_update_dpp(0, v, CTRL, 0xf, 0xf, false); }
#define P9_DQ(Q, K) ((Q) <= nm1 ? P9_DOT16(W_[Q], K) : 0)
#define P9_CONS_U_TK(K, W) { const v4u (&W_)[8] = W; const int d0 = P9_DOT16(W_[0], K), d1 = P9_DQ(1, K), d2 = P9_DQ(2, K), d3 = P9_DQ(3, K), d4 = P9_DQ(4, K), d5 = P9_DQ(5, K), d6 = P9_DQ(6, K), d7 = P9_DQ(7, K); \
        const int e0 = ifold32(d0, d1), e1 = ifold32(d2, d3), e2 = ifold32(d4, d5), e3 = ifold32(d6, d7); const int f0 = ifold16(e0, e1), f1 = ifold16(e2, e3); \
        const bool up8 = (lane & 8) != 0; int g = up8 ? f1 : f0; const int o = up8 ? f0 : f1; \
        g += __builtin_amdgcn_update_dpp(0, o, 0x128, 0xf, 0xf, false);     \
        g = idppadd<0xB1>(g); g = idppadd<0x4E>(g); g = idppadd<0x141>(g); \
        if ((lane & 7) == 0 && qmap <= nm1) HL[K * 128 + pd + qmap] = (float)g * (1.0f / (PEER_USCALE * (SCORES_INT8 ? XN8_SCALE : PEER_XSCALE))); }
#define P9_CONS_V_TK(K, W) { const float hvv_ = HL[K * 128 + pd + imin(lane & 7, nm1)]; \
        _Pragma("unroll") for (int q = 0; q < 8; ++q) if (q < nd) { const float hq = __builtin_bit_cast(float, __builtin_amdgcn_readlane(__builtin_bit_cast(int, hvv_), q)); const f32x2 h2 = {hq, hq}; const v4u ww = W[q]; \
            acc[K][0] = fp8lo(ww.x) * h2 + acc[K][0]; acc[K][1] = fp8hi(ww.x) * h2 + acc[K][1]; acc[K][2] = fp8lo(ww.y) * h2 + acc[K][2]; acc[K][3] = fp8hi(ww.y) * h2 + acc[K][3]; \
            acc[K][4] = fp8lo(ww.z) * h2 + acc[K][4]; acc[K][5] = fp8hi(ww.z) * h2 + acc[K][5]; acc[K][6] = fp8lo(ww.w) * h2 + acc[K][6]; acc[K][7] = fp8hi(ww.w) * h2 + acc[K][7]; __builtin_amdgcn_sched_barrier(0); } }
#define P9_CONSUME(i, W, CONS) do { P9_DESC(i); switch (tkd) { case 0: CONS(0, W); break; case 1: CONS(1, W); break; case 2: CONS(2, W); break; default: CONS(3, W); break; } } while (0)
#define P9_CONSUME8(i, W, CONS) do { P9_DESC(i); switch (tkd) { case 0: CONS(0, W); break; case 1: CONS(1, W); break; case 2: CONS(2, W); break; case 3: CONS(3, W); break; \
        case 4: CONS(4, W); break; case 5: CONS(5, W); break; case 6: CONS(6, W); break; default: CONS(7, W); break; } } while (0)
#define P9_PIPELINE(CONS) do { v4u wA[8], wB[8], wC[8]; P9_ISSUE(0, wA); P9_ISSUE(1, wB); \
        for (int i = 0; i < NBP; i += 3) { P9_ISSUE(i + 2, wC); P9_CONSUME(i, wA, CONS); P9_ISSUE(i + 3, wA); P9_CONSUME(i + 1, wB, CONS); P9_ISSUE(i + 4, wB); P9_CONSUME(i + 2, wC, CONS); } } while (0)
#define P9_PIPELINE8(CONS) do { v4u wA[8], wB[8], wC[8]; P9_ISSUE(0, wA); P9_ISSUE(1, wB); \
        for (int i = 0; i < NBP; i += 3) { P9_ISSUE(i + 2, wC); P9_CONSUME8(i, wA, CONS); P9_ISSUE(i + 3, wA); P9_CONSUME8(i + 1, wB, CONS); P9_ISSUE(i + 4, wB); P9_CONSUME8(i + 2, wC, CONS); } } while (0)
template <int TPS> __device__ __forceinline__ int p9_build_desc(const int* BST, int tb, int lane, LAS int* DS) {
    const int tkg = lane & (TPS - 1), bg = (lane / TPS) & 7; const int s0 = BST[(size_t)(tb + tkg) * 16 + bg], s1 = BST[(size_t)(tb + tkg) * 16 + bg + 1], cnt = lane < 8 * TPS ? s1 - s0 : 0, nb = (cnt + 7) >> 3;
    int inc = nb;
#pragma unroll
    for (int o = 1; o < 64; o <<= 1) { const int v = __shfl_up(inc, o); inc += (lane >= o) ? v : 0; }
    const int off = inc - nb, NBT = __builtin_amdgcn_readlane(inc, 63);
    for (int i = 0; i < nb; ++i) DS[off + i] = tkg | ((s0 + 8 * i) << 3) | (imin(8, cnt - 8 * i) << 10);
    const int NBP = ((NBT + 2) / 3) * 3;
    if (lane < NBP + 2 - NBT) DS[NBT + lane] = 0;
    LDS_WAIT();
    return NBP;
}
__device__ __forceinline__ void p9a_peer_u(Frame& F) {
    if (F.G % 8 != 0) return;
    const int lane = F.lane, sl = (blockIdx.x & 7) >> 1, rk = (blockIdx.x >> 3) * 2 + (blockIdx.x & 1), NR = F.G >> 2, TPR = T_ / NR;
    const bf16* XN = (const bf16*)(F.ws + WS_XN); const unsigned char* TB = (const unsigned char*)(F.ws + WS_UB) + (size_t)sl * NEXP * P9_SLD + lane * 16;
    const int* ES = (const int*)(F.ws + WS_ES); const int* BST = (const int*)(F.ws + WS_BST); float* PART = (float*)(F.ws + WS_PART) + (size_t)sl * T_ * NSEL;
    LAS int* EL = (LAS int*)(F.lds + RING_OFF + F.wave * P9_WLDS); LAS float* HL = (LAS float*)(EL + 1024); LAS int* DS = EL + 2048;
    const int qmap = 4 * ((lane >> 3) & 1) + 2 * ((lane >> 4) & 1) + (lane >> 5);
    for (int tb = rk * TPR + F.wave * P9_TPU; tb < (rk + 1) * TPR; tb += NWAVES * P9_TPU) {
        typedef int i32x4 __attribute__((ext_vector_type(4))); i32x4 xs[P9_TPU];
#pragma unroll
        for (int tk = 0; tk < P9_TPU; ++tk) { const size_t t = (size_t)(tb + tk);
            if (SCORES_INT8) { const v4u x8 = *(const GAS v4u*)((const unsigned char*)XN + t * (2 * LDP8) + sl * P9_SLD + lane * 16); xs[tk].x = (int)x8.x; xs[tk].y = (int)x8.y; xs[tk].z = (int)x8.z; xs[tk].w = (int)x8.w; }
            else { const bf16* xp = XN + t * LDP + sl * P9_SLD + lane * 16; const v4u x0 = *(const GAS v4u*)xp, x1 = *(const GAS v4u*)(xp + 8);
            xs[tk].x = pk_i8(bflo(x0.x) * PEER_XSCALE, bfhi(x0.x) * PEER_XSCALE, bflo(x0.y) * PEER_XSCALE, bfhi(x0.y) * PEER_XSCALE); xs[tk].y = pk_i8(bflo(x0.z) * PEER_XSCALE, bfhi(x0.z) * PEER_XSCALE, bflo(x0.w) * PEER_XSCALE, bfhi(x0.w) * PEER_XSCALE);
            xs[tk].z = pk_i8(bflo(x1.x) * PEER_XSCALE, bfhi(x1.x) * PEER_XSCALE, bflo(x1.y) * PEER_XSCALE, bfhi(x1.y) * PEER_XSCALE); xs[tk].w = pk_i8(bflo(x1.z) * PEER_XSCALE, bfhi(x1.z) * PEER_XSCALE, bflo(x1.w) * PEER_XSCALE, bfhi(x1.w) * PEER_XSCALE);
            }
            EL[tk * 128 + lane] = ES[t * NSEL + lane]; EL[tk * 128 + 64 + lane] = ES[t * NSEL + 64 + lane]; }
        const int NBP = p9_build_desc<P9_TPU>(BST, tb, lane, DS);
        P9_PIPELINE8(P9_CONS_U_TK);
        LDS_WAIT();
#pragma unroll
        for (int tk = 0; tk < P9_TPU; ++tk) { const size_t t = (size_t)(tb + tk); PART[t * NSEL + lane] = HL[tk * 128 + lane]; PART[t * NSEL + 64 + lane] = HL[tk * 128 + 64 + lane]; }
        LDS_WAIT();
    }
}
__device__ __forceinline__ void p9b_peer_v(Frame& F, float* yout, unsigned* ssqx) {
    if (F.G % 8 != 0) return;
    int lane_o = F.lane; asm volatile("" : "+v"(lane_o));
    const int lane = lane_o, sl = (blockIdx.x & 7) >> 1, rk = (blockIdx.x >> 3) * 2 + (blockIdx.x & 1), NR = F.G >> 2, TPR = T_ / NR;
    const unsigned char* TB = (const unsigned char*)(F.ws + WS_VB) + (size_t)sl * NEXP * P9_SLD + lane * 16;
    const int* ES = (const int*)(F.ws + WS_ES); const float* GS = (const float*)(F.ws + WS_GS); const int* BST = (const int*)(F.ws + WS_BST);
    const float* PART = (const float*)(F.ws + WS_PART); const float* nf = F.in[I_NFIN] + sl * P9_SLD + lane * 16;
    LAS int* EL = (LAS int*)(F.lds + RING_OFF + F.wave * P9_WLDS); LAS float* HL = (LAS float*)(EL + 1024); LAS int* DS = EL + 2048;
#define P9B_SETUP(TB) do { _Pragma("unroll") for (int tk = 0; tk < P9_TPS; ++tk) { const size_t t = (size_t)((TB) + tk); \
            EL[tk * 128 + lane] = ES[t * NSEL + lane]; EL[tk * 128 + 64 + lane] = ES[t * NSEL + 64 + lane]; \
            float a0 = 0.f, a1 = 0.f; \
            _Pragma("unroll") for (int s = 0; s < P9_NSL; ++s) { a0 += PART[((size_t)s * T_ + t) * NSEL + lane]; a1 += PART[((size_t)s * T_ + t) * NSEL + 64 + lane]; } \
            if (DEFER_FFN_NORM) { const float rs_ = ((const float*)(F.ws + WS_RS))[t]; a0 *= rs_; a1 *= rs_; } \
            HL[tk * 128 + lane] = 0.5f * a0 * (1.0f + erff(a0 * 0.70710678118654752f)) * GS[t * NSEL + lane]; HL[tk * 128 + 64 + lane] = 0.5f * a1 * (1.0f + erff(a1 * 0.70710678118654752f)) * GS[t * NSEL + 64 + lane]; } \
        NBP = p9_build_desc<P9_TPS>(BST, (TB), lane, DS); } while (0)
    const int tb0 = rk * TPR + F.wave * P9_TPS, tbe = (rk + 1) * TPR; int NBP = 0;
    f32x2 acc[P9_TPS][8];
    v4u wA[8], wB[8], wC[8];
    if (tb0 < tbe) { P9B_SETUP(tb0); P9_ISSUE(0, wA); P9_ISSUE(1, wB); }
    for (int tb = tb0; tb < tbe; tb += NWAVES * P9_TPS) {
#pragma unroll
        for (int tk = 0; tk < P9_TPS; ++tk)
#pragma unroll
            for (int k = 0; k < 8; ++k) acc[tk][k] = (f32x2){0.f, 0.f};
        for (int i = 0; i < NBP; i += 3) { P9_ISSUE(i + 2, wC); P9_CONSUME(i, wA, P9_CONS_V_TK); P9_ISSUE(i + 3, wA); P9_CONSUME(i + 1, wB, P9_CONS_V_TK); P9_ISSUE(i + 4, wB); P9_CONSUME(i + 2, wC, P9_CONS_V_TK); }
        float ssl[P9_TPS];
        v4u hva[P9_TPS], hvb[P9_TPS];
#pragma unroll
        for (int tk = 0; tk < P9_TPS; ++tk) { const bf16* hrow = (const bf16*)(F.ws + WS_HB) + (size_t)(tb + tk) * DM + sl * P9_SLD + lane * 16; hva[tk] = *(const GAS v4u*)hrow; hvb[tk] = *(const GAS v4u*)(hrow + 8); }
        asm volatile("" ::: "memory");
#pragma unroll
        for (int tk = 0; tk < P9_TPS; ++tk) { const size_t t = (size_t)(tb + tk); float ss = 0.f;
            const v4u hv0 = hva[tk], hv1 = hvb[tk];
#pragma unroll
            for (int c = 0; c < 4; ++c) { const unsigned ha = c == 0 ? hv0.x : c == 1 ? hv0.z : c == 2 ? hv1.x : hv1.z, hb2 = c == 0 ? hv0.y : c == 1 ? hv0.w : c == 2 ? hv1.y : hv1.w; const f32x4 x0 = {bflo(ha), bfhi(ha), bflo(hb2), bfhi(hb2)};
                acc[tk][2 * c].x = x0.x + acc[tk][2 * c].x * (1.0f / PEER_VSCALE); acc[tk][2 * c].y = x0.y + acc[tk][2 * c].y * (1.0f / PEER_VSCALE);
                acc[tk][2 * c + 1].x = x0.z + acc[tk][2 * c + 1].x * (1.0f / PEER_VSCALE); acc[tk][2 * c + 1].y = x0.w + acc[tk][2 * c + 1].y * (1.0f / PEER_VSCALE);
                ss += (acc[tk][2 * c].x * acc[tk][2 * c].x + acc[tk][2 * c].y * acc[tk][2 * c].y) + (acc[tk][2 * c + 1].x * acc[tk][2 * c + 1].x + acc[tk][2 * c + 1].y * acc[tk][2 * c + 1].y); }
            ss = fmaxf(wave_sum(ss), 1e-30f); ssl[tk] = ss;
            if (lane == 0) __hip_atomic_store(ssqx + t * P9_NSL + sl, __float_as_uint(ss), __ATOMIC_RELAXED, __HIP_MEMORY_SCOPE_AGENT); }
        LDS_WAIT();
        if (tb + NWAVES * P9_TPS < tbe) P9B_SETUP(tb + NWAVES * P9_TPS);
        unsigned wv = 1u;
        for (unsigned spin = 0; spin < (1u << 22); ++spin) {
            if (lane < P9_TPS * P9_NSL) wv = __hip_atomic_load(ssqx + (size_t)tb * P9_NSL + lane, __ATOMIC_RELAXED, __HIP_MEMORY_SCOPE_AGENT);
            if (__all(wv != 0u)) break;
            __builtin_amdgcn_s_sleep(2);
        }
        const float wf = (lane < P9_TPS * P9_NSL) ? __uint_as_float(wv) : 0.f;
        if (tb + NWAVES * P9_TPS < tbe) { P9_ISSUE(0, wA); P9_ISSUE(1, wB); }
        f32x4 gq[4];
#pragma unroll
        for (int c = 0; c < 4; ++c) gq[c] = *(const GAS f32x4*)(nf + 4 * c);
        asm volatile("" ::: "memory");
#pragma unroll
        for (int tk = 0; tk < P9_TPS; ++tk) { const size_t t = (size_t)(tb + tk); float* orow = yout + t * DM + sl * P9_SLD + lane * 16;
            float tot = 0.f;
#pragma unroll
            for (int s2 = 0; s2 < P9_NSL; ++s2) tot += (s2 == sl) ? ssl[tk] : __builtin_bit_cast(float, __builtin_amdgcn_readlane(__builtin_bit_cast(int, wf), tk * P9_NSL + s2));
            const float rs = 1.0f / sqrtf(tot * (1.0f / DM) + EPS);
#pragma unroll
            for (int c = 0; c < 4; ++c) { const f32x4 g = gq[c]; f32x4 y;
                y.x = acc[tk][2 * c].x * rs * g.x; y.y = acc[tk][2 * c].y * rs * g.y; y.z = acc[tk][2 * c + 1].x * rs * g.z; y.w = acc[tk][2 * c + 1].y * rs * g.w;
                *(GAS f32x4*)(orow + 4 * c) = y; } }
    }
#undef P9B_SETUP
}

struct Args { const float* in[N_IN]; float* out; unsigned char* ws; int ph_lo, ph_hi; };
static_assert(sizeof(Args) == N_IN * 8 + 8 + 8 + 8, "Args has no padding");
constexpr int N_PHASES = 11;
#ifndef MK_PER_PHASE
#define MK_PER_PHASE 0
#endif
__global__ void __launch_bounds__(NWAVES * 64, 2) fwd(Args args) {
    extern __shared__ __attribute__((aligned(16))) unsigned char lds[];
    Frame F;
    F.lds = (LAS unsigned char*)lds;
    F.MISC = (volatile LAS unsigned*)(F.lds + MISC_OFF);
    F.tid = threadIdx.x; F.lane = F.tid & 63; F.wave = __builtin_amdgcn_readfirstlane(F.tid >> 6);
    F.G = gridDim.x; { const int bx = blockIdx.x; F.vcu = (F.G % 8 == 0) ? (bx % 8) * (F.G / 8) + bx / 8 : bx; }
    F.ws = args.ws; F.out = args.out; F.ctl = (gu32*)(args.ws + WS_CTL);
#pragma unroll
    for (int i = 0; i < N_IN; ++i) F.in[i] = args.in[i];
    for (int u = F.tid; u < (LDS_BYTES - LDSCTL_OFF) / 4; u += NWAVES * 64) ((LAS unsigned*)(F.lds + LDSCTL_OFF))[u] = 0u;
    __syncthreads();
    XcdBarrier bar; bar.bar = (unsigned*)(F.ctl + CW_BAR); bar.x = 0; bar.st = nullptr;
    if (!MK_PER_PHASE) bar = xcd_barrier_post((unsigned*)(F.ctl + CW_BAR), F.MISC + 8);
    const int lo = args.ph_lo, hi = args.ph_hi;
#define IN(k) (lo <= (k) && (k) < hi)
#define SEAM(k) do { if (IN(k) && IN((k) + 1)) xcd_barrier(bar); } while (0)
    bf16* const HN = (bf16*)(F.ws + WS_HN); bf16* const Z = (bf16*)(F.ws + WS_Z); bf16* const BZ = (bf16*)(F.ws + WS_BZ); bf16* const ATT = (bf16*)(F.ws + WS_ATT);
    bf16* const MRG = (bf16*)(F.ws + WS_MRG); bf16* const XN = (bf16*)(F.ws + WS_XN); float* const ST = (float*)(F.ws + WS_ST);

#ifndef REPEAT_PHASE
#define REPEAT_PHASE -1
#endif
#define RUN(k, BODY) do { if (IN(k)) { BODY; if (REPEAT_PHASE == (k)) { xcd_barrier(bar); BODY; } } } while (0)
#define PH_GEMM1 { if (Z8_COL0 > 0) { pg8::Gemm g{HN, (const bf16*)(F.ws + WS_WINT), T_, Z8_COL0, DM, LDP}; pg8::StaticOrder S; S.init(T_, Z8_COL0, F.G, (int)blockIdx.x); pg8::EpiZ E{Z, F.in[I_BGATE], 0, 1.0f}; \
          pg8::gemm_phase<pg8::EpiZ, pg8::StaticOrder, true, true, false>(F.lds + RING_OFF, g, S, E); \
        __syncthreads(); } \
        { pg8::Gemm g{(const bf16*)(F.ws + WS_HN8), (const bf16*)(F.ws + WS_WIN8), T_, INC - Z8_COL0, DM / 2, LDP8}; pg8::StaticOrder S; S.init(T_, INC - Z8_COL0, F.G, (int)blockIdx.x); \
          pg8::EpiZ E{Z, F.in[I_BGATE], Z8_COL0, 1.0f / (HN8_SCALE * WIN8_SCALE)}; \
          pg8::TblHook hk{F.in[I_UEMB], F.in[I_VEMB], (unsigned char*)(F.ws + WS_UB), (unsigned char*)(F.ws + WS_KMEAN), F.vcu * NWAVES + F.wave, F.G * NWAVES}; \
          pg8::gemm_phase<pg8::EpiZ, pg8::StaticOrder, true, true, LOWP, UV_IN_GEMM1>(F.lds + RING_OFF, g, S, E, hk); } }
#define PH_GEMM2_FUSED { pg8::Gemm g{(const bf16*)(F.ws + WS_AC), (const bf16*)(F.ws + WS_WC), T_, DM, DM / 2, LDP8}; pg8::StaticOrder S; S.init(T_, DM, F.G, (int)blockIdx.x); \
        pg8::EpiMerge E{Z + ZC_GC, (unsigned char*)(F.ws + WS_MRG8)}; static_assert(CONVOUT_FP8 && GEMM3_FP8 && PROJ_INT8 && BZ8_SCALE * WCO8_SCALE * 4.f == ATT8_SCALE * WAO8_SCALE && ATT8_SCALE * WAO8_SCALE == 32768.f && MRG8_SCALE == 32.f && ZC_GA - ZC_GC == 4096, "EpiMerge constants"); \
        pg8::gemm_phase<pg8::EpiMerge, pg8::StaticOrder, true, true, 1>(F.lds + RING_OFF, g, S, E); }
#define PH_GEMM2_SPLIT { { pg8::Gemm g{BZ, (const bf16*)(F.ws + WS_WCOT), T_, DM, (CONVOUT_INT8 || CONVOUT_FP8) ? CD / 2 : CD, (CONVOUT_INT8 || CONVOUT_FP8) ? LDH8 : LDH}; pg8::StaticOrder S; S.init(T_, DM, F.G, (int)blockIdx.x); \
          typedef pg8::EpiGate<0, LDP, 2 * LDP8, (CONVOUT_INT8 || CONVOUT_FP8) ? 13 : 0, 0> EG0; EG0 E{MRG, Z + ZC_GC, nullptr}; static_assert(BZ8_SCALE * WCO8_SCALE == 8192.f, "EpiGate shift"); \
          pg8::gemm_phase<EG0, pg8::StaticOrder, true, true, CONVOUT_FP8 ? 1 : (CONVOUT_INT8 ? 2 : 0)>(F.lds + RING_OFF, g, S, E); } \
        __syncthreads(); \
        { pg8::Gemm g{ATT, (const bf16*)(F.ws + WS_WAO8), T_, DM, AD / 2, LDH8}; pg8::StaticOrder S; S.init(T_, DM, F.G, (int)blockIdx.x); typedef pg8::EpiGate<GEMM3_FP8 ? (PROJ_INT8 ? 3 : 2) : 1, LDP, 2 * LDP8, 15, 5> EG1; EG1 E{MRG, Z + ZC_GA, (unsigned char*)(F.ws + WS_MRG8)}; static_assert(ATT8_SCALE * WAO8_SCALE == 32768.f && MRG8_SCALE == 32.f, "EpiGate shifts"); \
          pg8::gemm_phase<EG1, pg8::StaticOrder, true, true, true>(F.lds + RING_OFF, g, S, E); } }
#define PH_GEMM3 { pg8::Gemm g{GEMM3_FP8 ? (const bf16*)(F.ws + WS_MRG8) : MRG, (const bf16*)(F.ws + WS_WOT), T_, DM, GEMM3_FP8 ? DM / 2 : DM, GEMM3_FP8 ? LDP8 : LDP}; pg8::StaticOrder S; S.init(T_, DM, F.G, (int)blockIdx.x); \
        if constexpr (DEFER_FFN_NORM) { typedef pg8::EpiHQ<HQ_SCALE, 2 * LDP8, WS_XN, WS_SSQP> EHQ; EHQ E{(bf16*)(F.ws + WS_HB), F.in[I_X], F.in[I_NFFN], F.ws, GEMM3_FP8 ? 1.0f / (MRG8_SCALE * WO8_SCALE) : 1.0f}; \
            pg8::gemm_phase<EHQ, pg8::StaticOrder, true, true, GEMM3_FP8 ? LOWP : 0>(F.lds + RING_OFF, g, S, E); } \
        else { pg8::EpiHB E{(bf16*)(F.ws + WS_HB), F.in[I_X], GEMM3_FP8 ? 1.0f / (MRG8_SCALE * WO8_SCALE) : 1.0f}; \
        pg8::gemm_phase<pg8::EpiHB, pg8::StaticOrder, true, true, GEMM3_FP8 ? LOWP : 0>(F.lds + RING_OFF, g, S, E); } }
#define PH_GEMM4 { pg8::Gemm g{(const bf16*)(F.ws + WS_WPQF), XN, 2048, T_, SCORES_INT8 ? DM / 2 : DM, SCORES_INT8 ? LDP8 : LDP}; pg8::StaticOrder S; S.init(2048, T_, F.G, (int)blockIdx.x); \
        pg8::EpiF32R E{ST, T_, nullptr, SCORES_INT8 ? 1.0f / (XN8_SCALE * WPQ8_SCALE) : 1.0f}; \
        pg8::gemm_phase<pg8::EpiF32R, pg8::StaticOrder, true, true, SCORES_INT8 ? 2 : 0>(F.lds + RING_OFF, g, S, E); }
    RUN(0, p0_prologue(F)); SEAM(0);
    RUN(1, PH_GEMM1); SEAM(1);
    RUN(2, p2_conv_kmean(F)); SEAM(2);
    RUN(3, p3_attention(F, (char*)lds + RING_OFF)); SEAM(3);
#if GEMM2_FUSED
    RUN(4, PH_GEMM2_FUSED); SEAM(4);
#else
    RUN(4, PH_GEMM2_SPLIT); SEAM(4);
#endif
    RUN(5, PH_GEMM3); SEAM(5);
#if !DEFER_FFN_NORM
    RUN(6, p6_rms(F)); SEAM(6);
#endif
    RUN(7, PH_GEMM4); SEAM(7);
    RUN(8, p8_topk(F)); SEAM(8);
    RUN(9, p9a_peer_u(F)); SEAM(9);
    if (IN(10)) {
        if (REPEAT_PHASE == 10) { p9b_peer_v(F, (float*)(F.ws + WS_WINT), (unsigned*)(F.ctl + CW_SSQX)); xcd_barrier(bar); }
        p9b_peer_v(F, F.out, (unsigned*)(F.ctl + CW_SSQX));
    }
#undef IN
#undef SEAM
}

extern "C" void kernel_launch(void* const* d_in, const int* in_sizes, int n_in, void* d_out, int out_size, void* d_ws, size_t ws_size, hipStream_t stream) {
    static int grid = 0;
    if (grid == 0) {
        if (n_in != N_IN || in_sizes[0] != T_ * DM || out_size != T_ * DM || ws_size < WS_END) { fprintf(stderr, "kernel_launch: shape mismatch (n_in %d in0 %d out %d ws %zu)\n", n_in, n_in > 0 ? in_sizes[0] : -1, out_size, ws_size); grid = -1; return; }
        int dev = 0, cus = 0, per_cu = 0;
        if (hipGetDevice(&dev) != hipSuccess || hipDeviceGetAttribute(&cus, hipDeviceAttributeMultiprocessorCount, dev) != hipSuccess) { grid = -1; return; }
        if (hipFuncSetAttribute((const void*)fwd, hipFuncAttributeMaxDynamicSharedMemorySize, LDS_BYTES) != hipSuccess) { fprintf(stderr, "kernel_launch: hipFuncSetAttribute failed\n"); grid = -1; return; }
        if (hipOccupancyMaxActiveBlocksPerMultiprocessor(&per_cu, (const void*)fwd, NWAVES * 64, LDS_BYTES) != hipSuccess || per_cu < 1)
            fprintf(stderr, "kernel_launch: note: occupancy query reports %d workgroups per CU\n", per_cu);
        (void)hipGetLastError();
        grid = cus;
    }
    if (grid < 0) return;
    if (hipMemsetAsync((char*)d_ws + WS_CTL, 0, CTL_ZERO_BYTES, stream) != hipSuccess) return;
    Args a{};
    for (int i = 0; i < N_IN; ++i) a.in[i] = (const float*)d_in[i];
    a.out = (float*)d_out; a.ws = (unsigned char*)d_ws;
#if MK_PER_PHASE
    for (int p = 0; p < N_PHASES; ++p) { a.ph_lo = p; a.ph_hi = p + 1; hipLaunchKernelGGL(fwd, dim3(grid), dim3(NWAVES * 64), LDS_BYTES, stream, a); }
#else
    a.ph_lo = 0; a.ph_hi = N_PHASES;
    hipLaunchKernelGGL(fwd, dim3(grid), dim3(NWAVES * 64), LDS_BYTES, stream, a);
#endif
    const hipError_t le = hipPeekAtLastError();
    if (le != hipSuccess) fprintf(stderr, "kernel_launch: launch failed: %s\n", hipGetErrorName(le));
}
```
